# Optimizing an MI355X kernel written in HIP

```python
import math
import jax, jax.numpy as jnp
from jax import lax
import numpy as np


D_MODEL = 2048
BATCH = 4
SEQ = 4096
DEPTH = 2

MEM_LEN = 256
RWKV_WIDTH = D_MODEL // 2
RWKV_HEAD = 64
RWKV_HEADS = RWKV_WIDTH // RWKV_HEAD
DECAY_LORA = 64
AAA_LORA = 64
GATE_LORA = 160
RWKV_COLS = 3 * RWKV_WIDTH + DECAY_LORA + AAA_LORA + GATE_LORA
DIFF_WIDTH = D_MODEL - RWKV_WIDTH
DIFF_VHEAD = 128
DIFF_HEADS = DIFF_WIDTH // DIFF_VHEAD
DIFF_QK = DIFF_VHEAD // 2
ROT_DIMS = DIFF_QK // 4
ROPE_THETA = 500000.0
N_IN = RWKV_COLS + 3 * DIFF_WIDTH
BLOCK_Q = 128
XATTN_HEADS = 4
XATTN_HEAD = 128
XATTN_WIDTH = XATTN_HEADS * XATTN_HEAD
PEER_HEADS = 8
PEER_KEYS = 128
PEER_EXPERTS = PEER_KEYS * PEER_KEYS
PEER_HALF = 128
PEER_TOPK = 16
PEER_CHUNK = 64
LN_EPS = 1e-5
GN_EPS = 64e-5
DEEPNORM_ALPHA = (2.0 * DEPTH) ** 0.25
DEEPNORM_BETA = (8.0 * DEPTH) ** -0.25

kernel_name = 'hybrid_rwkv7_diffattn_peer_block'

F32 = jnp.float32


def _f(t):
    return t.astype(F32)


def layer_norm(x, w, b):
    xf = _f(x)
    mu = xf.mean(-1, keepdims=True)
    var = jnp.mean(jnp.square(xf - mu), -1, keepdims=True)
    return ((xf - mu) * lax.rsqrt(var + LN_EPS) * _f(w) + _f(b)).astype(x.dtype)


def rwkv7_scan(r, w, k, v, a, b):
    def step(state, inp):
        r_t, w_t, k_t, v_t, a_t, b_t = inp
        sa = jnp.einsum('bhij,bhj->bhi', state, a_t)
        state = (state * w_t[:, :, None, :] + sa[..., None] * b_t[:, :, None, :]
                 + v_t[..., None] * k_t[:, :, None, :])
        y = jnp.einsum('bhij,bhj->bhi', state, r_t)
        return state, y
    B, S, H, N = r.shape
    xs = tuple(jnp.moveaxis(t, 1, 0) for t in (r, w, k, v, a, b))
    s0 = jnp.zeros((B, H, N, N), F32)
    _, ys = lax.scan(step, s0, xs)
    return jnp.moveaxis(ys, 0, 1)


def rwkv7_time_mix(p, shift_mu, w0, w_up, a0, a_up, g_up, k_k, k_a, r_k, lnx_w, lnx_b):
    B, S, _ = p.shape
    H, N, C = RWKV_HEADS, RWKV_HEAD, RWKV_WIDTH
    pf = _f(p)
    p_prev = jnp.pad(pf, ((0, 0), (1, 0), (0, 0)))[:, :-1]
    pf = pf + (p_prev - pf) * _f(shift_mu)
    r = pf[..., :C]
    k = pf[..., C:2 * C]
    v = pf[..., 2 * C:3 * C]
    o = 3 * C
    wd = pf[..., o:o + DECAY_LORA]
    o += DECAY_LORA
    ad = pf[..., o:o + AAA_LORA]
    o += AAA_LORA
    gd = pf[..., o:o + GATE_LORA]
    w_log = -jax.nn.softplus(-(_f(w0) + jnp.tanh(wd) @ _f(w_up))) - 0.5
    decay = jnp.exp(-jnp.exp(w_log))
    iclr = jax.nn.sigmoid(_f(a0) + ad @ _f(a_up))
    g = jax.nn.sigmoid(gd) @ _f(g_up)
    heads = lambda t: t.reshape(B, S, H, N)
    kk = heads(k * _f(k_k))
    kk = kk / jnp.maximum(jnp.linalg.norm(kk, axis=-1, keepdims=True), 1e-12)
    k = k * (1.0 + (iclr - 1.0) * _f(k_a))
    rh, kh, vh, ih = heads(r), heads(k), heads(v), heads(iclr)
    y = rwkv7_scan(rh, heads(decay), kh, vh, -kk, kk * ih)
    mu = y.mean(-1, keepdims=True)
    var = jnp.mean(jnp.square(y - mu), -1, keepdims=True)
    y = ((y - mu) * lax.rsqrt(var + GN_EPS)).reshape(B, S, C) * _f(lnx_w) + _f(lnx_b)
    bonus = jnp.sum(rh * kh * _f(r_k), -1, keepdims=True) * vh
    return (y + bonus.reshape(B, S, C)) * g


def partial_rope(t, cos, sin):
    half = ROT_DIMS // 2
    t1 = t[..., :half]
    t2 = t[..., half:ROT_DIMS]
    return jnp.concatenate([t1 * cos - t2 * sin, t2 * cos + t1 * sin, t[..., ROT_DIMS:]], -1)


def diff_attention(q, k, v, positions, lam_q1, lam_k1, lam_q2, lam_k2, subln_w, layer_idx):
    B, S, _ = q.shape
    H = DIFF_HEADS
    q = q.reshape(B, S, H, 2, DIFF_QK)
    k = k.reshape(B, S, H, 2, DIFF_QK)
    v = v.reshape(B, S, H, DIFF_VHEAD).transpose(0, 2, 1, 3)
    inv_freq = ROPE_THETA ** (-(jnp.arange(0, ROT_DIMS, 2, dtype=F32) / ROT_DIMS))
    ang = _f(positions)[..., None] * inv_freq
    cos = jnp.cos(ang)[:, :, None, None, :].astype(q.dtype)
    sin = jnp.sin(ang)[:, :, None, None, :].astype(q.dtype)
    q = partial_rope(q, cos, sin).transpose(0, 2, 3, 1, 4)
    k = partial_rope(k, cos, sin).transpose(0, 2, 3, 1, 4)
    lam_init = 0.8 - 0.6 * math.exp(-0.3 * layer_idx)
    lam = (jnp.exp(jnp.sum(_f(lam_q1) * _f(lam_k1))) - jnp.exp(jnp.sum(_f(lam_q2) * _f(lam_k2)))
           + lam_init)
    scale = DIFF_QK ** -0.5
    outs = []
    for i in range(S // BLOCK_Q):
        start, end = i * BLOCK_Q, (i + 1) * BLOCK_Q
        qb = q[:, :, :, start:end]
        kb = k[:, :, :, :end]
        vb = v[:, :, :end]
        s = jnp.einsum('bhcqd,bhckd->bhcqk', qb, kb, preferred_element_type=F32) * scale
        qpos = start + jnp.arange(BLOCK_Q)
        kpos = jnp.arange(end)
        s = jnp.where(kpos[None, :] <= qpos[:, None], s, -jnp.inf)
        pr = jax.nn.softmax(s, axis=-1)
        attn = pr[:, :, 0] - lam * pr[:, :, 1]
        outs.append(jnp.einsum('bhqk,bhkd->bhqd', attn.astype(vb.dtype), vb,
                               preferred_element_type=F32))
    o = jnp.concatenate(outs, axis=2)
    o = o * lax.rsqrt(jnp.mean(jnp.square(o), -1, keepdims=True) + LN_EPS) * _f(subln_w)
    o = o * (1.0 - lam_init)
    return o.transpose(0, 2, 1, 3).reshape(B, S, DIFF_WIDTH)


def memory_cross_attention(x, mem, wq, wk, wv, wo):
    B, S, _ = x.shape
    M = mem.shape[1]
    q = (x @ wq).reshape(B, S, XATTN_HEADS, XATTN_HEAD)
    k = (mem @ wk).reshape(B, M, XATTN_HEADS, XATTN_HEAD)
    v = (mem @ wv).reshape(B, M, XATTN_HEADS, XATTN_HEAD)
    s = jnp.einsum('bshd,bmhd->bhsm', q, k, preferred_element_type=F32) * (XATTN_HEAD ** -0.5)
    pr = jax.nn.softmax(s, axis=-1).astype(v.dtype)
    o = jnp.einsum('bhsm,bmhd->bshd', pr, v).reshape(B, S, XATTN_WIDTH)
    return o @ wo


def peer_ffn(x, pq, subkeys, peer_u, peer_v):
    B, S, D = x.shape
    T = B * S
    K = PEER_TOPK
    xt = x.reshape(T, D)
    q = (xt @ pq).reshape(T, PEER_HEADS, 2, PEER_HALF)
    s = jnp.einsum('thcd,ckd->thck', q, subkeys, preferred_element_type=F32)
    sv, si = lax.top_k(s, K)
    cand = (sv[:, :, 0, :, None] + sv[:, :, 1, None, :]).reshape(T, PEER_HEADS, K * K)
    fv, fi = lax.top_k(cand, K)
    i1 = jnp.take_along_axis(si[:, :, 0], fi // K, axis=-1)
    i2 = jnp.take_along_axis(si[:, :, 1], fi % K, axis=-1)
    experts = (i1 * PEER_KEYS + i2).reshape(T, PEER_HEADS * K)
    gates = jax.nn.softmax(fv, axis=-1).reshape(T, PEER_HEADS * K)
    n_chunks = T // PEER_CHUNK

    def chunk(args):
        xc, ec, gc = args
        hc = jnp.einsum('cd,ced->ce', xc, peer_u[ec], preferred_element_type=F32)
        ac = jax.nn.gelu(hc, approximate=False) * gc
        return jnp.einsum('ce,ced->cd', ac.astype(xc.dtype), peer_v[ec])

    y = lax.map(chunk, (xt.reshape(n_chunks, PEER_CHUNK, D),
                        experts.reshape(n_chunks, PEER_CHUNK, -1),
                        gates.reshape(n_chunks, PEER_CHUNK, -1)))
    return y.reshape(B, S, D).astype(x.dtype)


def setup_inputs(seed: int = 0) -> dict:
    key = jax.random.key(seed)
    ks = jax.random.split(key, 40)
    L = DEPTH
    nrm = lambda k, shape, sc: jax.random.normal(k, shape, F32) * sc
    gain = lambda k, shape: 1.0 + 0.05 * jax.random.normal(k, shape, F32)
    positions = (jnp.arange(SEQ, dtype=jnp.int32)[None, :]
                 + jax.random.randint(ks[2], (BATCH, 1), 0, 1024, dtype=jnp.int32))
    return {
        'x': nrm(ks[0], (BATCH, SEQ, D_MODEL), 1.0),
        'mem': nrm(ks[1], (BATCH, MEM_LEN, D_MODEL), 1.0),
        'positions': positions,
        'w_in': nrm(ks[3], (L, D_MODEL, N_IN), D_MODEL ** -0.5),
        'shift_mu': jax.random.uniform(ks[4], (L, RWKV_COLS), F32),
        'w0': jax.random.uniform(ks[5], (L, RWKV_WIDTH), F32, -6.0, 1.0),
        'w_up': nrm(ks[6], (L, DECAY_LORA, RWKV_WIDTH), 0.5 * DECAY_LORA ** -0.5),
        'a0': nrm(ks[7], (L, RWKV_WIDTH), 0.5),
        'a_up': nrm(ks[8], (L, AAA_LORA, RWKV_WIDTH), AAA_LORA ** -0.5),
        'g_up': nrm(ks[9], (L, GATE_LORA, RWKV_WIDTH), GATE_LORA ** -0.5),
        'k_k': 0.85 + 0.05 * jax.random.normal(ks[10], (L, RWKV_WIDTH), F32),
        'k_a': gain(ks[11], (L, RWKV_WIDTH)),
        'r_k': nrm(ks[12], (L, RWKV_HEADS, RWKV_HEAD), 0.1),
        'lnx_w': gain(ks[13], (L, RWKV_WIDTH)),
        'lnx_b': nrm(ks[14], (L, RWKV_WIDTH), 0.01),
        'lam_q1': nrm(ks[15], (L, DIFF_QK), 0.1),
        'lam_k1': nrm(ks[16], (L, DIFF_QK), 0.1),
        'lam_q2': nrm(ks[17], (L, DIFF_QK), 0.1),
        'lam_k2': nrm(ks[18], (L, DIFF_QK), 0.1),
        'subln_w': gain(ks[19], (L, DIFF_VHEAD)),
        'w_out': nrm(ks[20], (L, D_MODEL, D_MODEL), DEEPNORM_BETA * D_MODEL ** -0.5),
        'ln1_w': gain(ks[21], (L, D_MODEL)),
        'ln1_b': nrm(ks[22], (L, D_MODEL), 0.01),
        'xq': nrm(ks[23], (L, D_MODEL, XATTN_WIDTH), D_MODEL ** -0.5),
        'xk': nrm(ks[24], (L, D_MODEL, XATTN_WIDTH), D_MODEL ** -0.5),
        'xv': nrm(ks[25], (L, D_MODEL, XATTN_WIDTH), D_MODEL ** -0.5),
        'xo': nrm(ks[26], (L, XATTN_WIDTH, D_MODEL), DEEPNORM_BETA * XATTN_WIDTH ** -0.5),
        'ln2_w': gain(ks[27], (L, D_MODEL)),
        'ln2_b': nrm(ks[28], (L, D_MODEL), 0.01),
        'pq': nrm(ks[29], (L, D_MODEL, PEER_HEADS * 2 * PEER_HALF), D_MODEL ** -0.5),
        'subkeys': nrm(ks[30], (L, 2, PEER_KEYS, PEER_HALF), PEER_HALF ** -0.5),
        'peer_u': nrm(ks[31], (L, PEER_EXPERTS, D_MODEL), D_MODEL ** -0.5),
        'peer_v': nrm(ks[32], (L, PEER_EXPERTS, D_MODEL), DEEPNORM_BETA * PEER_HEADS ** -0.5),
        'ln3_w': gain(ks[33], (L, D_MODEL)),
        'ln3_b': nrm(ks[34], (L, D_MODEL), 0.01),
    }


def reference(x, mem, positions, w_in, shift_mu, w0, w_up, a0, a_up, g_up, k_k, k_a, r_k,
              lnx_w, lnx_b, lam_q1, lam_k1, lam_q2, lam_k2, subln_w, w_out, ln1_w, ln1_b,
              xq, xk, xv, xo, ln2_w, ln2_b, pq, subkeys, peer_u, peer_v, ln3_w, ln3_b):
    for l in range(DEPTH):
        proj = x @ w_in[l]
        p_rwkv = proj[..., :RWKV_COLS]
        o = RWKV_COLS
        q = proj[..., o:o + DIFF_WIDTH]
        k = proj[..., o + DIFF_WIDTH:o + 2 * DIFF_WIDTH]
        v = proj[..., o + 2 * DIFF_WIDTH:o + 3 * DIFF_WIDTH]
        y_a = rwkv7_time_mix(p_rwkv, shift_mu[l], w0[l], w_up[l], a0[l], a_up[l], g_up[l],
                             k_k[l], k_a[l], r_k[l], lnx_w[l], lnx_b[l])
        y_b = diff_attention(q, k, v, positions, lam_q1[l], lam_k1[l], lam_q2[l], lam_k2[l],
                             subln_w[l], l)
        mix = jnp.concatenate([y_a, y_b], axis=-1).astype(x.dtype) @ w_out[l]
        x = layer_norm(DEEPNORM_ALPHA * x + mix, ln1_w[l], ln1_b[l])
        xa = memory_cross_attention(x, mem, xq[l], xk[l], xv[l], xo[l])
        x = layer_norm(DEEPNORM_ALPHA * x + xa, ln2_w[l], ln2_b[l])
        xf = peer_ffn(x, pq[l], subkeys[l], peer_u[l], peer_v[l])
        x = layer_norm(DEEPNORM_ALPHA * x + xf, ln3_w[l], ln3_b[l])
    return x
```

```cpp
#include <hip/hip_runtime.h>
#include <hip/hip_bf16.h>
#include <stdint.h>

typedef unsigned short u16;
typedef __attribute__((ext_vector_type(8))) short bf16x8;
typedef __attribute__((ext_vector_type(4))) float f32x4;
typedef __attribute__((ext_vector_type(4))) unsigned int u32x4;

#define D_MODEL 2048
#define BATCH 4
#define SEQ 4096
#define NTOK (BATCH * SEQ)
#define DEPTH 2
#define MEM_LEN 256
#define RW 1024
#define RH 16
#define RCOLS 3360
#define N_IN 6432
#define DIFF_W 1024
#define XW 512
#define LORA_LD 320
#define REC 384
#define ALPHA 1.4142135623730951f

__device__ __forceinline__ u16 f2bf(float f) {
  uint32_t u = __float_as_uint(f);
  u += 0x7fffu + ((u >> 16) & 1u);
  return (u16)(u >> 16);
}
__device__ __forceinline__ float bf2f(u16 h) { return __uint_as_float(((uint32_t)h) << 16); }
__device__ __forceinline__ uint32_t pack2(float a, float b) { return (uint32_t)f2bf(a) | ((uint32_t)f2bf(b) << 16); }

template <int CTRL>
__device__ __forceinline__ float dpp_f(float x) {
  return __int_as_float(__builtin_amdgcn_update_dpp(0, __float_as_int(x), CTRL, 0xf, 0xf, true));
}
__device__ __forceinline__ float row16_sum(float x) {
  x += dpp_f<0xB1>(x);
  x += dpp_f<0x4E>(x);
  x += dpp_f<0x141>(x);
  x += dpp_f<0x140>(x);
  return x;
}
__device__ __forceinline__ float row16_max(float x) {
  x = fmaxf(x, dpp_f<0xB1>(x));
  x = fmaxf(x, dpp_f<0x4E>(x));
  x = fmaxf(x, dpp_f<0x141>(x));
  x = fmaxf(x, dpp_f<0x140>(x));
  return x;
}
__device__ __forceinline__ float wave_sum(float x) {
  x = row16_sum(x);
  x += __shfl_xor(x, 16);
  x += __shfl_xor(x, 32);
  return x;
}
__device__ __forceinline__ float wave_max(float x) {
  x = row16_max(x);
  x = fmaxf(x, __shfl_xor(x, 16));
  x = fmaxf(x, __shfl_xor(x, 32));
  return x;
}

__global__ __launch_bounds__(256) void k_cvt(const float* __restrict__ src, u16* __restrict__ dst, size_t n8) {
  for (size_t i = (size_t)blockIdx.x * 256 + threadIdx.x; i < n8; i += (size_t)gridDim.x * 256) {
    float4 a = ((const float4*)src)[2 * i], b = ((const float4*)src)[2 * i + 1];
    uint4 o;
    o.x = pack2(a.x, a.y); o.y = pack2(a.z, a.w); o.z = pack2(b.x, b.y); o.w = pack2(b.z, b.w);
    ((uint4*)dst)[i] = o;
  }
}
__global__ __launch_bounds__(256) void k_cvt_t(const float* __restrict__ src, u16* __restrict__ dst, int K, int N, int ldd) {
  __shared__ float tile[32][33];
  int tx = threadIdx.x & 31, ty = threadIdx.x >> 5;
  int ntn = N / 32, ntk = K / 32;
  for (int t = blockIdx.x; t < ntn * ntk; t += gridDim.x) {
    int tk = t / ntn, tn = t % ntn;
    __syncthreads();
    for (int r = ty; r < 32; r += 8) tile[r][tx] = src[(size_t)(tk * 32 + r) * N + tn * 32 + tx];
    __syncthreads();
    for (int r = ty; r < 32; r += 8) dst[(size_t)(tn * 32 + r) * ldd + tk * 32 + tx] = f2bf(tile[tx][r]);
  }
}
__global__ __launch_bounds__(256) void k_zero16(u16* p, size_t n) {
  for (size_t i = (size_t)blockIdx.x * 256 + threadIdx.x; i < n; i += (size_t)gridDim.x * 256) p[i] = 0;
}

#define GBM 128
#define GBN 128
#define GBK 64
#define GLS 72
struct GemmArgs {
  const u16* A; const u16* Bt; int lda, ldb; int M, N, K;
  float* Cf; u16* Cb; int ldc; const float* res; float alpha;
};
template <int EPI>
__device__ __forceinline__ void gemm_tile(const GemmArgs& g, int tm, int tn, u16* sA, u16* sB) {
  const int tid = threadIdx.x, lane = tid & 63, wave = tid >> 6;
  const int wm = wave >> 1, wn = wave & 1;
  const int m0 = tm * GBM, n0 = tn * GBN;
  const int KT = g.K / GBK;
  u32x4 ra[4], rb[4];
  f32x4 acc[4][4];
#pragma unroll
  for (int i = 0; i < 4; ++i)
#pragma unroll
    for (int j = 0; j < 4; ++j) acc[i][j] = (f32x4){0.f, 0.f, 0.f, 0.f};

  auto gload = [&](int kt) {
#pragma unroll
    for (int i = 0; i < 4; ++i) {
      int c = tid + 256 * i, row = c >> 3, kc = c & 7;
      int ar = min(m0 + row, g.M - 1);
      ra[i] = *(const u32x4*)(g.A + (size_t)ar * g.lda + kt * GBK + kc * 8);
      int br = min(n0 + row, g.N - 1);
      rb[i] = *(const u32x4*)(g.Bt + (size_t)br * g.ldb + kt * GBK + kc * 8);
    }
  };
  auto swrite = [&]() {
#pragma unroll
    for (int i = 0; i < 4; ++i) {
      int c = tid + 256 * i, row = c >> 3, kc = c & 7;
      *(u32x4*)(sA + row * GLS + kc * 8) = ra[i];
      *(u32x4*)(sB + row * GLS + kc * 8) = rb[i];
    }
  };
  gload(0);
  __syncthreads();
  swrite();
  __syncthreads();
  for (int kt = 0; kt < KT; ++kt) {
    if (kt + 1 < KT) gload(kt + 1);
#pragma unroll
    for (int ks = 0; ks < 2; ++ks) {
      bf16x8 a[4], b[4];
#pragma unroll
      for (int i = 0; i < 4; ++i)
        a[i] = *(const bf16x8*)(sA + (wm * 64 + i * 16 + (lane & 15)) * GLS + ks * 32 + (lane >> 4) * 8);
#pragma unroll
      for (int j = 0; j < 4; ++j)
        b[j] = *(const bf16x8*)(sB + (wn * 64 + j * 16 + (lane & 15)) * GLS + ks * 32 + (lane >> 4) * 8);
#pragma unroll
      for (int i = 0; i < 4; ++i)
#pragma unroll
        for (int j = 0; j < 4; ++j) acc[i][j] = __builtin_amdgcn_mfma_f32_16x16x32_bf16(a[i], b[j], acc[i][j], 0, 0, 0);
    }
    __syncthreads();
    if (kt + 1 < KT) {
      swrite();
      __syncthreads();
    }
  }
#pragma unroll
  for (int i = 0; i < 4; ++i)
#pragma unroll
    for (int j = 0; j < 4; ++j) {
      int col = n0 + wn * 64 + j * 16 + (lane & 15);
#pragma unroll
      for (int r = 0; r < 4; ++r) {
        int row = m0 + wm * 64 + i * 16 + (lane >> 4) * 4 + r;
        if (col < g.N && row < g.M) {
          size_t o = (size_t)row * g.ldc + col;
          float v = acc[i][j][r];
          if (EPI == 0) g.Cf[o] = v;
          else if (EPI == 1) g.Cb[o] = f2bf(v);
          else g.Cf[o] = g.alpha * g.res[o] + v;
        }
      }
    }
}
template <int EPI>
__global__ __launch_bounds__(256) void k_gemm(GemmArgs g) {
  __shared__ __attribute__((aligned(16))) u16 sA[GBM * GLS];
  __shared__ __attribute__((aligned(16))) u16 sB[GBN * GLS];
  int ntm = (g.M + GBM - 1) / GBM, ntn = (g.N + GBN - 1) / GBN;
  for (int t = blockIdx.x; t < ntm * ntn; t += gridDim.x) gemm_tile<EPI>(g, t / ntn, t % ntn, sA, sB);
}

__global__ __launch_bounds__(256) void k_ln(const float* pre, const float* __restrict__ w, const float* __restrict__ b,
                                            float* outf, u16* __restrict__ outb, int rows) {
  int lane = threadIdx.x & 63, wave = threadIdx.x >> 6;
  for (int row = blockIdx.x * 4 + wave; row < rows; row += gridDim.x * 4) {
    const float4* p = (const float4*)(pre + (size_t)row * D_MODEL);
    float4 v[8];
    float s = 0.f;
#pragma unroll
    for (int i = 0; i < 8; ++i) { v[i] = p[lane + 64 * i]; s += v[i].x + v[i].y + v[i].z + v[i].w; }
    float mu = wave_sum(s) * (1.0f / D_MODEL);
    float q = 0.f;
#pragma unroll
    for (int i = 0; i < 8; ++i) {
      float a = v[i].x - mu, b2 = v[i].y - mu, c = v[i].z - mu, d = v[i].w - mu;
      q += a * a + b2 * b2 + c * c + d * d;
    }
    float rs = rsqrtf(wave_sum(q) * (1.0f / D_MODEL) + 1e-5f);
#pragma unroll
    for (int i = 0; i < 8; ++i) {
      float4 ww = ((const float4*)w)[lane + 64 * i], bb = ((const float4*)b)[lane + 64 * i];
      float4 o;
      o.x = (v[i].x - mu) * rs * ww.x + bb.x; o.y = (v[i].y - mu) * rs * ww.y + bb.y;
      o.z = (v[i].z - mu) * rs * ww.z + bb.z; o.w = (v[i].w - mu) * rs * ww.w + bb.w;
      ((float4*)(outf + (size_t)row * D_MODEL))[lane + 64 * i] = o;
      uint2 ob; ob.x = pack2(o.x, o.y); ob.y = pack2(o.z, o.w);
      ((uint2*)(outb + (size_t)row * D_MODEL))[lane + 64 * i] = ob;
    }
  }
}

__global__ __launch_bounds__(256) void k_rwkv_prep1(const float* __restrict__ proj, const float* __restrict__ mu, u16* __restrict__ lin) {
  size_t total = (size_t)NTOK * LORA_LD;
  for (size_t i = (size_t)blockIdx.x * 256 + threadIdx.x; i < total; i += (size_t)gridDim.x * 256) {
    int t = (int)(i / LORA_LD), c = (int)(i % LORA_LD);
    float out = 0.f;
    if (c < 288) {
      int col = 3072 + c;
      float p = proj[(size_t)t * RCOLS + col];
      float pp = ((t % SEQ) == 0) ? 0.f : proj[(size_t)(t - 1) * RCOLS + col];
      float x = p + (pp - p) * mu[col];
      if (c < 64) out = tanhf(x);
      else if (c < 128) out = x;
      else out = 1.f / (1.f + __expf(-x));
    }
    lin[i] = f2bf(out);
  }
}

struct Prep2Args {
  const float* proj; const float* mu; const float* lw; const float* la;
  const float* w0; const float* a0; const float* k_k; const float* k_a; const float* r_k;
  float* wrec; u16* prec; float* bon;
};
__global__ __launch_bounds__(256) void k_rwkv_prep2(Prep2Args a) {
  int lane = threadIdx.x & 63, wave = threadIdx.x >> 6;
  for (int it = blockIdx.x * 4 + wave; it < NTOK * RH; it += gridDim.x * 4) {
    int t = it / RH, h = it % RH;
    int b = t / SEQ, s = t % SEQ;
    int c = h * 64 + lane;
    const float* p = a.proj + (size_t)t * RCOLS;
    const float* pp = p - RCOLS;
    bool first = (s == 0);
    float pr = p[c], pk = p[RW + c], pv = p[2 * RW + c];
    float qr = 0.f, qk = 0.f, qv = 0.f;
    if (!first) { qr = pp[c]; qk = pp[RW + c]; qv = pp[2 * RW + c]; }
    float r = pr + (qr - pr) * a.mu[c];
    float k = pk + (qk - pk) * a.mu[RW + c];
    float v = pv + (qv - pv) * a.mu[2 * RW + c];
    float zw = a.w0[c] + a.lw[(size_t)t * RW + c];
    float nz = -zw;
    float sp = fmaxf(nz, 0.f) + log1pf(expf(-fabsf(nz)));
    float wlog = -sp - 0.5f;
    float decay = expf(-expf(wlog));
    float iclr = 1.f / (1.f + expf(-(a.a0[c] + a.la[(size_t)t * RW + c])));
    float kk = k * a.k_k[c];
    float nrm = sqrtf(wave_sum(kk * kk));
    kk = kk / fmaxf(nrm, 1e-12f);
    float k2 = k * (1.f + (iclr - 1.f) * a.k_a[c]);
    float bonus = wave_sum(r * k2 * a.r_k[c]);
    size_t ri = (size_t)(b * RH + h) * SEQ + s;
    a.wrec[ri * 64 + lane] = decay;
    u16* pr16 = a.prec + ri * 320;
    pr16[lane] = f2bf(k2);
    pr16[64 + lane] = f2bf(-kk);
    pr16[128 + lane] = f2bf(kk * iclr);
    pr16[192 + lane] = f2bf(r);
    pr16[256 + lane] = f2bf(v);
    if (lane == 0) a.bon[it] = bonus;
  }
}

#define SC_TC 16
__device__ __forceinline__ void scan_store_p(float* sRec, int c, u32x4 v) {
  int step = c / 40, within = c % 40;
  int arr = within >> 3, col8 = (within & 7) * 8;
  float* d = sRec + step * REC + 64 + arr * 64 + col8;
  f32x4 lo, hi;
  lo[0] = __uint_as_float(v[0] << 16); lo[1] = __uint_as_float(v[0] & 0xffff0000u);
  lo[2] = __uint_as_float(v[1] << 16); lo[3] = __uint_as_float(v[1] & 0xffff0000u);
  hi[0] = __uint_as_float(v[2] << 16); hi[1] = __uint_as_float(v[2] & 0xffff0000u);
  hi[2] = __uint_as_float(v[3] << 16); hi[3] = __uint_as_float(v[3] & 0xffff0000u);
  *(f32x4*)d = lo;
  *(f32x4*)(d + 4) = hi;
}
__global__ __launch_bounds__(256) void k_rwkv_scan(const float* __restrict__ wrec, const u16* __restrict__ prec, float* __restrict__ yraw) {
  __shared__ __attribute__((aligned(16))) float sRec[SC_TC * REC];
  __shared__ float sY[SC_TC * 16];
  const int tid = threadIdx.x, lane = tid & 63, wave = tid >> 6;
  const int cg = lane & 15, rg = lane >> 4;
  for (int item = blockIdx.x; item < BATCH * RH * 4; item += gridDim.x) {
    int bh = item >> 2, rb = item & 3;
    int b = bh / RH, h = bh % RH;
    const f32x4* wsrc = (const f32x4*)(wrec + (size_t)bh * SEQ * 64);
    const u32x4* psrc = (const u32x4*)(prec + (size_t)bh * SEQ * 320);
    const int rowl = wave * 4 + rg;
    const int row = rb * 16 + rowl;
    float S0 = 0.f, S1 = 0.f, S2 = 0.f, S3 = 0.f;
    f32x4 pw = wsrc[tid];
    u32x4 p0 = psrc[tid], p1 = psrc[tid + 256], p2 = (u32x4){0u, 0u, 0u, 0u};
    if (tid < 128) p2 = psrc[tid + 512];
    for (int ch = 0; ch < SEQ / SC_TC; ++ch) {
      __syncthreads();
      *(f32x4*)(sRec + (tid >> 4) * REC + (tid & 15) * 4) = pw;
      scan_store_p(sRec, tid, p0);
      scan_store_p(sRec, tid + 256, p1);
      if (tid < 128) scan_store_p(sRec, tid + 512, p2);
      __syncthreads();
      if (ch + 1 < SEQ / SC_TC) {
        pw = wsrc[(size_t)(ch + 1) * 256 + tid];
        const u32x4* ps = psrc + (size_t)(ch + 1) * 640;
        p0 = ps[tid]; p1 = ps[tid + 256];
        if (tid < 128) p2 = ps[tid + 512];
      }
#pragma unroll 4
      for (int st = 0; st < SC_TC; ++st) {
        const float* rc = sRec + st * REC;
        f32x4 W = *(const f32x4*)(rc + 4 * cg);
        f32x4 K = *(const f32x4*)(rc + 64 + 4 * cg);
        f32x4 A = *(const f32x4*)(rc + 128 + 4 * cg);
        f32x4 Bv = *(const f32x4*)(rc + 192 + 4 * cg);
        f32x4 R = *(const f32x4*)(rc + 256 + 4 * cg);
        float v = rc[320 + row];
        float sa = S0 * A[0] + S1 * A[1] + S2 * A[2] + S3 * A[3];
        sa = row16_sum(sa);
        S0 = S0 * W[0] + (sa * Bv[0] + v * K[0]);
        S1 = S1 * W[1] + (sa * Bv[1] + v * K[1]);
        S2 = S2 * W[2] + (sa * Bv[2] + v * K[2]);
        S3 = S3 * W[3] + (sa * Bv[3] + v * K[3]);
        float y = S0 * R[0] + S1 * R[1] + S2 * R[2] + S3 * R[3];
        y = row16_sum(y);
        if (cg == 0) sY[st * 16 + rowl] = y;
      }
      __syncthreads();
      {
        int st = tid >> 4, r = tid & 15;
        int s = ch * SC_TC + st;
        yraw[((size_t)b * SEQ + s) * RW + h * 64 + rb * 16 + r] = sY[st * 16 + r];
      }
    }
  }
}

__global__ __launch_bounds__(256) void k_rwkv_post(const float* __restrict__ yraw, const float* __restrict__ proj, const float* __restrict__ mu,
                                                   const float* __restrict__ bon, const float* __restrict__ gate, const float* __restrict__ lnw,
                                                   const float* __restrict__ lnb, u16* __restrict__ cat) {
  int lane = threadIdx.x & 63, wave = threadIdx.x >> 6;
  for (int it = blockIdx.x * 4 + wave; it < NTOK * RH; it += gridDim.x * 4) {
    int t = it / RH, h = it % RH;
    int s = t % SEQ;
    int c = h * 64 + lane;
    float y = yraw[(size_t)t * RW + c];
    float mean = wave_sum(y) * (1.f / 64.f);
    float d = y - mean;
    float var = wave_sum(d * d) * (1.f / 64.f);
    float yn = d * rsqrtf(var + 64e-5f) * lnw[c] + lnb[c];
    float pv = proj[(size_t)t * RCOLS + 2 * RW + c];
    float qv = 0.f;
    if (s != 0) qv = proj[(size_t)(t - 1) * RCOLS + 2 * RW + c];
    float v = pv + (qv - pv) * mu[2 * RW + c];
    float o = (yn + bon[it] * v) * gate[(size_t)t * RW + c];
    cat[(size_t)t * D_MODEL + c] = f2bf(o);
  }
}

__global__ __launch_bounds__(256) void k_rope(const float* __restrict__ qk, const int* __restrict__ pos, u16* __restrict__ Qb, u16* __restrict__ Kb) {
  size_t total = (size_t)NTOK * 2048;
  for (size_t i = (size_t)blockIdx.x * 256 + threadIdx.x; i < total; i += (size_t)gridDim.x * 256) {
    int t = (int)(i >> 11), c = (int)(i & 2047);
    int which = c >> 10, cc = c & 1023, d = cc & 63;
    float x = qk[i];
    float out = x;
    if (d < 16) {
      int dd = d & 7;
      double inv = pow(500000.0, -(double)dd / 8.0);
      float ang = (float)pos[t] * (float)inv;
      float cs = (float)cos((double)ang), sn = (float)sin((double)ang);
      if (d < 8) { float x2 = qk[i + 8]; out = x * cs - x2 * sn; }
      else { float x1 = qk[i - 8]; out = x * cs + x1 * sn; }
    }
    (which ? Kb : Qb)[(size_t)t * 1024 + cc] = f2bf(out);
  }
}

struct AttnArgs {
  const u16* Q; int ldq;
  const u16* K; int ldk;
  const u16* Vt; int ldv;
  u16* O; int ldo; int ocol0;
  int nb, nh, sq, sk;
  float scale;
  const float* lq1; const float* lk1; const float* lq2; const float* lk2; const float* subw; float lam_init;
};
template <int DQK, int NCOMP, bool CAUSAL>
__device__ __forceinline__ void attn_item(const AttnArgs& a, int b, int h, int qt, u16* smem) {
  constexpr int KS = DQK + 8;
  constexpr int KST = DQK / 32;
  u16* sK = smem;
  u16* sV = sK + NCOMP * 64 * KS;
  u16* sP = sV + 128 * 72;
  const int tid = threadIdx.x, lane = tid & 63, wave = tid >> 6;
  const int l15 = lane & 15, l4 = lane >> 4;
  const int hq = h * (NCOMP * DQK);
  const size_t qrow0 = (size_t)b * a.sq + qt * 64 + wave * 16;
  const float sc = a.scale * 1.4426950408889634f;

  bf16x8 qf[NCOMP][KST];
#pragma unroll
  for (int c = 0; c < NCOMP; ++c)
#pragma unroll
    for (int ks = 0; ks < KST; ++ks)
      qf[c][ks] = *(const bf16x8*)(a.Q + (qrow0 + l15) * a.ldq + hq + c * DQK + ks * 32 + l4 * 8);

  f32x4 O[NCOMP][8];
  float m[NCOMP][4], l[NCOMP][4];
#pragma unroll
  for (int c = 0; c < NCOMP; ++c) {
#pragma unroll
    for (int d = 0; d < 8; ++d) O[c][d] = (f32x4){0.f, 0.f, 0.f, 0.f};
#pragma unroll
    for (int i = 0; i < 4; ++i) { m[c][i] = -INFINITY; l[c][i] = 0.f; }
  }
  const int nkt = CAUSAL ? (qt + 1) : (a.sk / 64);
  constexpr int KCH = NCOMP * 64 * (DQK / 8) / 256;
  u32x4 rk[KCH], rv[4];
  auto gload = [&](int kt) {
#pragma unroll
    for (int i = 0; i < KCH; ++i) {
      int cidx = tid + 256 * i;
      int kc = cidx % (DQK / 8), rowc = cidx / (DQK / 8);
      int c = rowc / 64, key = rowc % 64;
      rk[i] = *(const u32x4*)(a.K + ((size_t)b * a.sk + kt * 64 + key) * a.ldk + hq + c * DQK + kc * 8);
    }
#pragma unroll
    for (int i = 0; i < 4; ++i) {
      int cidx = tid + 256 * i;
      int kc = cidx & 7, dv = cidx >> 3;
      rv[i] = *(const u32x4*)(a.Vt + (size_t)(h * 128 + dv) * a.ldv + (size_t)b * a.sk + kt * 64 + kc * 8);
    }
  };
  auto swrite = [&]() {
#pragma unroll
    for (int i = 0; i < KCH; ++i) {
      int cidx = tid + 256 * i;
      int kc = cidx % (DQK / 8), rowc = cidx / (DQK / 8);
      *(u32x4*)(sK + rowc * KS + kc * 8) = rk[i];
    }
#pragma unroll
    for (int i = 0; i < 4; ++i) {
      int cidx = tid + 256 * i;
      int kc = cidx & 7, dv = cidx >> 3;
      *(u32x4*)(sV + dv * 72 + kc * 8) = rv[i];
    }
  };
  gload(0);
  for (int kt = 0; kt < nkt; ++kt) {
    __syncthreads();
    swrite();
    __syncthreads();
    if (kt + 1 < nkt) gload(kt + 1);
    f32x4 S[NCOMP][4];
#pragma unroll
    for (int c = 0; c < NCOMP; ++c)
#pragma unroll
      for (int sub = 0; sub < 4; ++sub) {
        f32x4 acc = (f32x4){0.f, 0.f, 0.f, 0.f};
#pragma unroll
        for (int ks = 0; ks < KST; ++ks) {
          bf16x8 kf = *(const bf16x8*)(sK + (c * 64 + sub * 16 + l15) * KS + ks * 32 + l4 * 8);
          acc = __builtin_amdgcn_mfma_f32_16x16x32_bf16(qf[c][ks], kf, acc, 0, 0, 0);
        }
        S[c][sub] = acc;
      }
#pragma unroll
    for (int c = 0; c < NCOMP; ++c)
#pragma unroll
      for (int sub = 0; sub < 4; ++sub)
#pragma unroll
        for (int i = 0; i < 4; ++i) {
          float s = S[c][sub][i] * sc;
          if (CAUSAL && kt == qt) {
            int keyl = sub * 16 + l15, rowl = wave * 16 + l4 * 4 + i;
            if (keyl > rowl) s = -INFINITY;
          }
          S[c][sub][i] = s;
        }
#pragma unroll
    for (int c = 0; c < NCOMP; ++c) {
#pragma unroll
      for (int i = 0; i < 4; ++i) {
        float mx = fmaxf(fmaxf(S[c][0][i], S[c][1][i]), fmaxf(S[c][2][i], S[c][3][i]));
        mx = row16_max(mx);
        float mn = fmaxf(m[c][i], mx);
        float alpha = exp2f(m[c][i] - mn);
        m[c][i] = mn;
        float ps = 0.f;
#pragma unroll
        for (int sub = 0; sub < 4; ++sub) {
          float p = exp2f(S[c][sub][i] - mn);
          S[c][sub][i] = p;
          ps += p;
        }
        l[c][i] = l[c][i] * alpha + ps;
#pragma unroll
        for (int d = 0; d < 8; ++d) O[c][d][i] *= alpha;
      }
      u16* pw = sP + wave * 16 * 72;
      __syncthreads();
#pragma unroll
      for (int sub = 0; sub < 4; ++sub)
#pragma unroll
        for (int i = 0; i < 4; ++i) pw[(l4 * 4 + i) * 72 + sub * 16 + l15] = f2bf(S[c][sub][i]);
      __syncthreads();
#pragma unroll
      for (int ks = 0; ks < 2; ++ks) {
        bf16x8 pf = *(const bf16x8*)(pw + l15 * 72 + ks * 32 + l4 * 8);
#pragma unroll
        for (int d = 0; d < 8; ++d) {
          bf16x8 vf = *(const bf16x8*)(sV + (d * 16 + l15) * 72 + ks * 32 + l4 * 8);
          O[c][d] = __builtin_amdgcn_mfma_f32_16x16x32_bf16(pf, vf, O[c][d], 0, 0, 0);
        }
      }
    }
  }
  float inv[NCOMP][4];
#pragma unroll
  for (int c = 0; c < NCOMP; ++c)
#pragma unroll
    for (int i = 0; i < 4; ++i) inv[c][i] = 1.f / row16_sum(l[c][i]);
  if (NCOMP == 2) {
    float s1 = 0.f, s2 = 0.f;
    for (int j = 0; j < 64; ++j) { s1 += a.lq1[j] * a.lk1[j]; s2 += a.lq2[j] * a.lk2[j]; }
    float lam = expf(s1) - expf(s2) + a.lam_init;
    float ss[4] = {0.f, 0.f, 0.f, 0.f};
#pragma unroll
    for (int d = 0; d < 8; ++d)
#pragma unroll
      for (int i = 0; i < 4; ++i) {
        float o = O[0][d][i] * inv[0][i] - lam * (O[NCOMP - 1][d][i] * inv[NCOMP - 1][i]);
        O[0][d][i] = o;
        ss[i] += o * o;
      }
#pragma unroll
    for (int i = 0; i < 4; ++i) ss[i] = rsqrtf(row16_sum(ss[i]) * (1.f / 128.f) + 1e-5f) * (1.f - a.lam_init);
#pragma unroll
    for (int d = 0; d < 8; ++d) {
      float sw = a.subw[d * 16 + l15];
#pragma unroll
      for (int i = 0; i < 4; ++i)
        a.O[(qrow0 + l4 * 4 + i) * a.ldo + a.ocol0 + h * 128 + d * 16 + l15] = f2bf(O[0][d][i] * ss[i] * sw);
    }
  } else {
#pragma unroll
    for (int d = 0; d < 8; ++d)
#pragma unroll
      for (int i = 0; i < 4; ++i)
        a.O[(qrow0 + l4 * 4 + i) * a.ldo + a.ocol0 + h * 128 + d * 16 + l15] = f2bf(O[0][d][i] * inv[0][i]);
  }
}
template <int DQK, int NCOMP, bool CAUSAL>
__global__ __launch_bounds__(256) void k_attn(AttnArgs a) {
  __shared__ __attribute__((aligned(16))) u16 smem[NCOMP * 64 * (DQK + 8) + 128 * 72 + 4 * 16 * 72];
  int nqt = a.sq / 64;
  int nitems = a.nb * a.nh * nqt;
  for (int it = blockIdx.x; it < nitems; it += gridDim.x) {
    int qt = nqt - 1 - it / (a.nb * a.nh);
    int bh = it % (a.nb * a.nh);
    attn_item<DQK, NCOMP, CAUSAL>(a, bh / a.nh, bh % a.nh, qt, smem);
  }
}

__device__ __forceinline__ uint32_t fkey(float f) {
  uint32_t u = __float_as_uint(f);
  return (u & 0x80000000u) ? ~u : (u | 0x80000000u);
}
template <int E>
__device__ __forceinline__ void top16_select(const uint32_t (&key)[E], bool (&sel)[E], int lane) {
  uint32_t prefix = 0;
  int k = 16;
  for (int b = 31; b >= 0; --b) {
    uint32_t cand = prefix | (1u << b);
    int cnt = 0;
#pragma unroll
    for (int e = 0; e < E; ++e) cnt += __popcll(__ballot((key[e] >> b) == (cand >> b)));
    if (cnt >= k) prefix = cand; else k -= cnt;
  }
  int taken = 0;
  uint64_t lt = (lane == 0) ? 0ull : (~0ull >> (64 - lane));
#pragma unroll
  for (int e = 0; e < E; ++e) {
    bool eq = key[e] == prefix;
    uint64_t bm = __ballot(eq);
    int rank = taken + __popcll(bm & lt);
    sel[e] = (key[e] > prefix) || (eq && rank < k);
    taken += __popcll(bm);
  }
}
__global__ __launch_bounds__(256) void k_peer_topk(const float* __restrict__ scores, int* __restrict__ experts, float* __restrict__ gates) {
  __shared__ float sv[4][2][16];
  __shared__ int si[4][2][16];
  int lane = threadIdx.x & 63, wave = threadIdx.x >> 6;
  uint64_t lt = (lane == 0) ? 0ull : (~0ull >> (64 - lane));
  for (int it = blockIdx.x * 4 + wave; it < NTOK * 8; it += gridDim.x * 4) {
    int t = it >> 3, h = it & 7;
    const float* sp = scores + (size_t)t * 2048 + h * 256;
#pragma unroll
    for (int c = 0; c < 2; ++c) {
      float s[2]; uint32_t key[2]; bool sel[2];
      s[0] = sp[c * 128 + lane]; s[1] = sp[c * 128 + 64 + lane];
      key[0] = fkey(s[0]); key[1] = fkey(s[1]);
      top16_select<2>(key, sel, lane);
      int base = 0;
#pragma unroll
      for (int e = 0; e < 2; ++e) {
        uint64_t bm = __ballot(sel[e]);
        if (sel[e]) {
          int p = base + __popcll(bm & lt);
          sv[wave][c][p] = s[e];
          si[wave][c][p] = lane + 64 * e;
        }
        base += __popcll(bm);
      }
    }
    __builtin_amdgcn_wave_barrier();
    __threadfence_block();
    float cv[4]; uint32_t ck[4]; bool csel[4];
#pragma unroll
    for (int e = 0; e < 4; ++e) {
      int ci = e * 64 + lane;
      cv[e] = sv[wave][0][ci >> 4] + sv[wave][1][ci & 15];
      ck[e] = fkey(cv[e]);
    }
    top16_select<4>(ck, csel, lane);
    float mx = -INFINITY;
#pragma unroll
    for (int e = 0; e < 4; ++e) if (csel[e]) mx = fmaxf(mx, cv[e]);
    mx = wave_max(mx);
    float ex[4], sum = 0.f;
#pragma unroll
    for (int e = 0; e < 4; ++e) { ex[e] = csel[e] ? expf(cv[e] - mx) : 0.f; sum += ex[e]; }
    sum = wave_sum(sum);
    float rinv = 1.f / sum;
    int base = 0;
#pragma unroll
    for (int e = 0; e < 4; ++e) {
      uint64_t bm = __ballot(csel[e]);
      if (csel[e]) {
        int p = base + __popcll(bm & lt);
        int ci = e * 64 + lane;
        experts[(size_t)t * 128 + h * 16 + p] = si[wave][0][ci >> 4] * 128 + si[wave][1][ci & 15];
        gates[(size_t)t * 128 + h * 16 + p] = ex[e] * rinv;
      }
      base += __popcll(bm);
    }
    __builtin_amdgcn_wave_barrier();
    __threadfence_block();
  }
}

struct PeerArgs {
  const float* x;
  const u16* xb;
  const int* experts; const float* gates;
  const u16* U; const u16* V;
  const float* lnw; const float* lnb;
  float* outf; u16* outb;
};
__global__ __launch_bounds__(256) void k_peer(PeerArgs a) {
  __shared__ __attribute__((aligned(16))) float sAcc[4][D_MODEL];
  __shared__ float sRed[8];
  const int tid = threadIdx.x, lane = tid & 63, wave = tid >> 6;
  for (int t = blockIdx.x; t < NTOK; t += gridDim.x) {
    float xr[32];
#pragma unroll
    for (int q = 0; q < 4; ++q) {
      uint4 xv = *(const uint4*)(a.xb + (size_t)t * D_MODEL + q * 512 + lane * 8);
      uint32_t w[4] = {xv.x, xv.y, xv.z, xv.w};
#pragma unroll
      for (int j = 0; j < 4; ++j) {
        xr[q * 8 + 2 * j] = __uint_as_float(w[j] << 16);
        xr[q * 8 + 2 * j + 1] = __uint_as_float(w[j] & 0xffff0000u);
      }
    }
    float acc[32];
#pragma unroll
    for (int i = 0; i < 32; ++i) acc[i] = 0.f;
    for (int e = 0; e < 32; ++e) {
      int ei = wave * 32 + e;
      int ex = a.experts[(size_t)t * 128 + ei];
      float gt = a.gates[(size_t)t * 128 + ei];
      const u16* up = a.U + (size_t)ex * D_MODEL;
      const u16* vp = a.V + (size_t)ex * D_MODEL;
      uint4 uu[4], vv[4];
#pragma unroll
      for (int q = 0; q < 4; ++q) {
        uu[q] = *(const uint4*)(up + q * 512 + lane * 8);
        vv[q] = *(const uint4*)(vp + q * 512 + lane * 8);
      }
      float dot = 0.f;
#pragma unroll
      for (int q = 0; q < 4; ++q) {
        uint32_t w[4] = {uu[q].x, uu[q].y, uu[q].z, uu[q].w};
#pragma unroll
        for (int j = 0; j < 4; ++j) {
          dot += xr[q * 8 + 2 * j] * __uint_as_float(w[j] << 16);
          dot += xr[q * 8 + 2 * j + 1] * __uint_as_float(w[j] & 0xffff0000u);
        }
      }
      dot = wave_sum(dot);
      float ac = 0.5f * dot * (1.f + erff(dot * 0.70710678118654752f)) * gt;
#pragma unroll
      for (int q = 0; q < 4; ++q) {
        uint32_t w[4] = {vv[q].x, vv[q].y, vv[q].z, vv[q].w};
#pragma unroll
        for (int j = 0; j < 4; ++j) {
          acc[q * 8 + 2 * j] += ac * __uint_as_float(w[j] << 16);
          acc[q * 8 + 2 * j + 1] += ac * __uint_as_float(w[j] & 0xffff0000u);
        }
      }
    }
    __syncthreads();
#pragma unroll
    for (int q = 0; q < 4; ++q) {
      *(float4*)(&sAcc[wave][q * 512 + lane * 8]) = make_float4(acc[q * 8], acc[q * 8 + 1], acc[q * 8 + 2], acc[q * 8 + 3]);
      *(float4*)(&sAcc[wave][q * 512 + lane * 8 + 4]) = make_float4(acc[q * 8 + 4], acc[q * 8 + 5], acc[q * 8 + 6], acc[q * 8 + 7]);
    }
    __syncthreads();
    float pre[8];
    {
      const float* xp = a.x + (size_t)t * D_MODEL + tid * 8;
      float4 x0 = *(const float4*)xp, x1 = *(const float4*)(xp + 4);
      float xs[8] = {x0.x, x0.y, x0.z, x0.w, x1.x, x1.y, x1.z, x1.w};
#pragma unroll
      for (int j = 0; j < 8; ++j)
        pre[j] = ALPHA * xs[j] + sAcc[0][tid * 8 + j] + sAcc[1][tid * 8 + j] + sAcc[2][tid * 8 + j] + sAcc[3][tid * 8 + j];
    }
    float s = 0.f;
#pragma unroll
    for (int j = 0; j < 8; ++j) s += pre[j];
    s = wave_sum(s);
    if (lane == 0) sRed[wave] = s;
    __syncthreads();
    float mu = (sRed[0] + sRed[1] + sRed[2] + sRed[3]) * (1.f / D_MODEL);
    float q2 = 0.f;
#pragma unroll
    for (int j = 0; j < 8; ++j) { float d = pre[j] - mu; q2 += d * d; }
    q2 = wave_sum(q2);
    if (lane == 0) sRed[4 + wave] = q2;
    __syncthreads();
    float rs = rsqrtf((sRed[4] + sRed[5] + sRed[6] + sRed[7]) * (1.f / D_MODEL) + 1e-5f);
    float o[8];
#pragma unroll
    for (int j = 0; j < 8; ++j) o[j] = (pre[j] - mu) * rs * a.lnw[tid * 8 + j] + a.lnb[tid * 8 + j];
    float* op = a.outf + (size_t)t * D_MODEL + tid * 8;
    *(float4*)op = make_float4(o[0], o[1], o[2], o[3]);
    *(float4*)(op + 4) = make_float4(o[4], o[5], o[6], o[7]);
    if (a.outb) {
      uint4 ob; ob.x = pack2(o[0], o[1]); ob.y = pack2(o[2], o[3]); ob.z = pack2(o[4], o[5]); ob.w = pack2(o[6], o[7]);
      *(uint4*)(a.outb + (size_t)t * D_MODEL + tid * 8) = ob;
    }
  }
}

static inline size_t al(size_t x) { return (x + 255) & ~(size_t)255; }

template <int EPI>
static void launch_gemm(hipStream_t st, const u16* A, int lda, const u16* Bt, int ldb, int M, int N, int K,
                        float* Cf, u16* Cb, int ldc, const float* res = nullptr, float alpha = 0.f) {
  GemmArgs g{};
  g.A = A; g.Bt = Bt; g.lda = lda; g.ldb = ldb; g.M = M; g.N = N; g.K = K;
  g.Cf = Cf; g.Cb = Cb; g.ldc = ldc; g.res = res; g.alpha = alpha;
  int tiles = ((M + GBM - 1) / GBM) * ((N + GBN - 1) / GBN);
  int grid = tiles < 2048 ? tiles : 2048;
  hipLaunchKernelGGL(k_gemm<EPI>, dim3(grid), dim3(256), 0, st, g);
}

extern "C" void kernel_launch(void* const* d_in, const int* in_sizes, int n_in, void* d_out, int out_size, void* d_ws, size_t ws_size,
                              hipStream_t stream) {
  const float* x_in = (const float*)d_in[0];
  const float* mem = (const float*)d_in[1];
  const int* positions = (const int*)d_in[2];
  const float* w_in = (const float*)d_in[3];
  const float* shift_mu = (const float*)d_in[4];
  const float* w0 = (const float*)d_in[5];
  const float* w_up = (const float*)d_in[6];
  const float* a0 = (const float*)d_in[7];
  const float* a_up = (const float*)d_in[8];
  const float* g_up = (const float*)d_in[9];
  const float* k_k = (const float*)d_in[10];
  const float* k_a = (const float*)d_in[11];
  const float* r_k = (const float*)d_in[12];
  const float* lnx_w = (const float*)d_in[13];
  const float* lnx_b = (const float*)d_in[14];
  const float* lam_q1 = (const float*)d_in[15];
  const float* lam_k1 = (const float*)d_in[16];
  const float* lam_q2 = (const float*)d_in[17];
  const float* lam_k2 = (const float*)d_in[18];
  const float* subln_w = (const float*)d_in[19];
  const float* w_out = (const float*)d_in[20];
  const float* ln1_w = (const float*)d_in[21];
  const float* ln1_b = (const float*)d_in[22];
  const float* xq = (const float*)d_in[23];
  const float* xk = (const float*)d_in[24];
  const float* xv = (const float*)d_in[25];
  const float* xo = (const float*)d_in[26];
  const float* ln2_w = (const float*)d_in[27];
  const float* ln2_b = (const float*)d_in[28];
  const float* pq = (const float*)d_in[29];
  const float* subkeys = (const float*)d_in[30];
  const float* peer_u = (const float*)d_in[31];
  const float* peer_v = (const float*)d_in[32];
  const float* ln3_w = (const float*)d_in[33];
  const float* ln3_b = (const float*)d_in[34];
  float* out = (float*)d_out;

  char* ws = (char*)d_ws;
  size_t off = 0;
  auto carve = [&](size_t bytes) { char* p = ws + off; off += al(bytes); return p; };
  const size_t T = NTOK;
  float* X = (float*)carve(T * 2048 * 4);
  u16* xb = (u16*)carve(T * 2048 * 2);
  u16* memb = (u16*)carve((size_t)BATCH * MEM_LEN * 2048 * 2);
  u16* WinT = (u16*)carve((size_t)N_IN * 2048 * 2);
  u16* WoutT = (u16*)carve((size_t)2048 * 2048 * 2);
  u16* xqT = (u16*)carve((size_t)512 * 2048 * 2);
  u16* xkT = (u16*)carve((size_t)512 * 2048 * 2);
  u16* xvT = (u16*)carve((size_t)512 * 2048 * 2);
  u16* xoT = (u16*)carve((size_t)2048 * 512 * 2);
  u16* pqT = (u16*)carve((size_t)2048 * 2048 * 2);
  u16* loraT = (u16*)carve((size_t)3 * 1024 * 192 * 2);
  u16* skb = (u16*)carve((size_t)2 * 128 * 128 * 2);
  u16* cat = (u16*)carve(T * 2048 * 2);
  const size_t S0 = off;
  float* qkf = (float*)carve(T * 2048 * 4);
  u16* Qb = (u16*)carve(T * 1024 * 2);
  u16* Kb = (u16*)carve(T * 1024 * 2);
  u16* Vt = (u16*)carve((size_t)1024 * T * 2);
  size_t peak = off;
  off = S0;
  float* proj = (float*)carve(T * RCOLS * 4);
  u16* lin = (u16*)carve(T * LORA_LD * 2);
  float* lw = (float*)carve(T * 1024 * 4);
  float* la = (float*)carve(T * 1024 * 4);
  float* gate = (float*)carve(T * 1024 * 4);
  float* wrec = (float*)carve(T * RH * 64 * 4);
  u16* prec = (u16*)carve(T * RH * 320 * 2);
  float* bon = (float*)carve(T * RH * 4);
  float* yraw = lw;
  if (off > peak) peak = off;
  off = S0;
  u16* qx = (u16*)carve(T * 512 * 2);
  u16* Kx = (u16*)carve((size_t)1024 * 512 * 2);
  u16* Vxt = (u16*)carve((size_t)512 * 1024 * 2);
  u16* ox = (u16*)carve(T * 512 * 2);
  if (off > peak) peak = off;
  off = S0;
  u16* Ub = (u16*)carve((size_t)16384 * 2048 * 2);
  u16* Vb = (u16*)carve((size_t)16384 * 2048 * 2);
  u16* qp = (u16*)carve(T * 2048 * 2);
  float* scores = (float*)carve(T * 2048 * 4);
  int* experts = (int*)carve(T * 128 * 4);
  float* gates = (float*)carve(T * 128 * 4);
  if (off > peak) peak = off;
  if (peak > ws_size) {
    hipLaunchKernelGGL(k_zero16, dim3(1), dim3(256), 0, stream, (u16*)d_ws, (size_t)256);
    return;
  }

  hipStream_t st = stream;
  const int CG = 2048;
  hipLaunchKernelGGL(k_cvt, dim3(CG), dim3(256), 0, st, x_in, xb, T * 2048 / 8);
  hipLaunchKernelGGL(k_cvt, dim3(CG), dim3(256), 0, st, mem, memb, (size_t)BATCH * MEM_LEN * 2048 / 8);

  for (int l = 0; l < DEPTH; ++l) {
    const float* xres = (l == 0) ? x_in : X;
    hipLaunchKernelGGL(k_cvt_t, dim3(CG), dim3(256), 0, st, w_in + (size_t)l * 2048 * N_IN, WinT, 2048, N_IN, 2048);
    hipLaunchKernelGGL(k_cvt_t, dim3(CG), dim3(256), 0, st, w_out + (size_t)l * 2048 * 2048, WoutT, 2048, 2048, 2048);
    hipLaunchKernelGGL(k_cvt_t, dim3(CG), dim3(256), 0, st, xq + (size_t)l * 2048 * 512, xqT, 2048, 512, 2048);
    hipLaunchKernelGGL(k_cvt_t, dim3(CG), dim3(256), 0, st, xk + (size_t)l * 2048 * 512, xkT, 2048, 512, 2048);
    hipLaunchKernelGGL(k_cvt_t, dim3(CG), dim3(256), 0, st, xv + (size_t)l * 2048 * 512, xvT, 2048, 512, 2048);
    hipLaunchKernelGGL(k_cvt_t, dim3(CG), dim3(256), 0, st, xo + (size_t)l * 512 * 2048, xoT, 512, 2048, 512);
    hipLaunchKernelGGL(k_cvt_t, dim3(CG), dim3(256), 0, st, pq + (size_t)l * 2048 * 2048, pqT, 2048, 2048, 2048);
    u16* wupT = loraT; u16* aupT = loraT + 1024 * 64; u16* gupT = loraT + 2 * 1024 * 64;
    hipLaunchKernelGGL(k_zero16, dim3(256), dim3(256), 0, st, gupT, (size_t)1024 * 192);
    hipLaunchKernelGGL(k_cvt_t, dim3(CG), dim3(256), 0, st, w_up + (size_t)l * 64 * 1024, wupT, 64, 1024, 64);
    hipLaunchKernelGGL(k_cvt_t, dim3(CG), dim3(256), 0, st, a_up + (size_t)l * 64 * 1024, aupT, 64, 1024, 64);
    hipLaunchKernelGGL(k_cvt_t, dim3(CG), dim3(256), 0, st, g_up + (size_t)l * 160 * 1024, gupT, 160, 1024, 192);
    hipLaunchKernelGGL(k_cvt, dim3(64), dim3(256), 0, st, subkeys + (size_t)l * 2 * 128 * 128, skb, (size_t)2 * 128 * 128 / 8);

    launch_gemm<0>(st, xb, 2048, WinT + (size_t)RCOLS * 2048, 2048, NTOK, 2048, 2048, qkf, nullptr, 2048);
    launch_gemm<1>(st, WinT + (size_t)(RCOLS + 2048) * 2048, 2048, xb, 2048, 1024, NTOK, 2048, nullptr, Vt, NTOK);
    hipLaunchKernelGGL(k_rope, dim3(CG), dim3(256), 0, st, qkf, positions, Qb, Kb);
    {
      AttnArgs a{};
      a.Q = Qb; a.ldq = 1024; a.K = Kb; a.ldk = 1024; a.Vt = Vt; a.ldv = NTOK; a.O = cat; a.ldo = 2048; a.ocol0 = 1024;
      a.nb = BATCH; a.nh = 8; a.sq = SEQ; a.sk = SEQ; a.scale = 0.125f;
      a.lq1 = lam_q1 + l * 64; a.lk1 = lam_k1 + l * 64; a.lq2 = lam_q2 + l * 64; a.lk2 = lam_k2 + l * 64;
      a.subw = subln_w + l * 128; a.lam_init = (float)(0.8 - 0.6 * exp(-0.3 * (double)l));
      hipLaunchKernelGGL((k_attn<64, 2, true>), dim3(2048), dim3(256), 0, st, a);
    }

    const float* mu_l = shift_mu + (size_t)l * RCOLS;
    launch_gemm<0>(st, xb, 2048, WinT, 2048, NTOK, RCOLS, 2048, proj, nullptr, RCOLS);
    hipLaunchKernelGGL(k_rwkv_prep1, dim3(CG), dim3(256), 0, st, proj, mu_l, lin);
    launch_gemm<0>(st, lin, LORA_LD, wupT, 64, NTOK, 1024, 64, lw, nullptr, 1024);
    launch_gemm<0>(st, lin + 64, LORA_LD, aupT, 64, NTOK, 1024, 64, la, nullptr, 1024);
    launch_gemm<0>(st, lin + 128, LORA_LD, gupT, 192, NTOK, 1024, 192, gate, nullptr, 1024);
    {
      Prep2Args p{};
      p.proj = proj; p.mu = mu_l; p.lw = lw; p.la = la;
      p.w0 = w0 + l * RW; p.a0 = a0 + l * RW; p.k_k = k_k + l * RW; p.k_a = k_a + l * RW; p.r_k = r_k + l * RW;
      p.wrec = wrec; p.prec = prec; p.bon = bon;
      hipLaunchKernelGGL(k_rwkv_prep2, dim3(CG), dim3(256), 0, st, p);
    }
    hipLaunchKernelGGL(k_rwkv_scan, dim3(256), dim3(256), 0, st, wrec, prec, yraw);
    hipLaunchKernelGGL(k_rwkv_post, dim3(CG), dim3(256), 0, st, yraw, proj, mu_l, bon, gate, lnx_w + l * RW, lnx_b + l * RW, cat);

    launch_gemm<2>(st, cat, 2048, WoutT, 2048, NTOK, 2048, 2048, X, nullptr, 2048, xres, ALPHA);
    hipLaunchKernelGGL(k_ln, dim3(CG), dim3(256), 0, st, X, ln1_w + l * 2048, ln1_b + l * 2048, X, xb, NTOK);

    launch_gemm<1>(st, xb, 2048, xqT, 2048, NTOK, 512, 2048, nullptr, qx, 512);
    launch_gemm<1>(st, memb, 2048, xkT, 2048, BATCH * MEM_LEN, 512, 2048, nullptr, Kx, 512);
    launch_gemm<1>(st, xvT, 2048, memb, 2048, 512, BATCH * MEM_LEN, 2048, nullptr, Vxt, BATCH * MEM_LEN);
    {
      AttnArgs a{};
      a.Q = qx; a.ldq = 512; a.K = Kx; a.ldk = 512; a.Vt = Vxt; a.ldv = BATCH * MEM_LEN; a.O = ox; a.ldo = 512; a.ocol0 = 0;
      a.nb = BATCH; a.nh = 4; a.sq = SEQ; a.sk = MEM_LEN; a.scale = 0.08838834764831845f;
      hipLaunchKernelGGL((k_attn<128, 1, false>), dim3(1024), dim3(256), 0, st, a);
    }
    launch_gemm<2>(st, ox, 512, xoT, 512, NTOK, 2048, 512, X, nullptr, 2048, X, ALPHA);
    hipLaunchKernelGGL(k_ln, dim3(CG), dim3(256), 0, st, X, ln2_w + l * 2048, ln2_b + l * 2048, X, xb, NTOK);

    hipLaunchKernelGGL(k_cvt, dim3(CG), dim3(256), 0, st, peer_u + (size_t)l * 16384 * 2048, Ub, (size_t)16384 * 2048 / 8);
    hipLaunchKernelGGL(k_cvt, dim3(CG), dim3(256), 0, st, peer_v + (size_t)l * 16384 * 2048, Vb, (size_t)16384 * 2048 / 8);
    launch_gemm<1>(st, xb, 2048, pqT, 2048, NTOK, 2048, 2048, nullptr, qp, 2048);
    for (int hc = 0; hc < 16; ++hc)
      launch_gemm<0>(st, qp + hc * 128, 2048, skb + (size_t)(hc & 1) * 128 * 128, 128, NTOK, 128, 128, scores + hc * 128, nullptr, 2048);
    hipLaunchKernelGGL(k_peer_topk, dim3(CG), dim3(256), 0, st, scores, experts, gates);
    {
      PeerArgs p{};
      p.x = X; p.xb = xb; p.experts = experts; p.gates = gates; p.U = Ub; p.V = Vb;
      p.lnw = ln3_w + l * 2048; p.lnb = ln3_b + l * 2048;
      bool last = (l == DEPTH - 1);
      p.outf = last ? out : X;
      p.outb = last ? nullptr : xb;
      hipLaunchKernelGGL(k_peer, dim3(4096), dim3(256), 0, st, p);
    }
  }
}
```

```cpp
#include <hip/hip_runtime.h>
#include <hip/hip_bf16.h>
#include <hip/hip_cooperative_groups.h>
#include <stdint.h>
#include <stdio.h>
#include <string.h>
#include <stddef.h>
namespace cg = cooperative_groups;

typedef unsigned short u16;
typedef __attribute__((ext_vector_type(8))) short bf16x8;
typedef __attribute__((ext_vector_type(4))) float f32x4;
typedef __attribute__((ext_vector_type(2))) float f32x2;
typedef __attribute__((ext_vector_type(4))) unsigned int u32x4;

#define D_MODEL 2048
#define BATCH 4
#define SEQ 4096
#define NTOK (BATCH * SEQ)
#define DEPTH 2
#define MEM_LEN 256
#define RW 1024
#define RH 16
#define RCOLS 3360
#define N_IN 6432
#define DIFF_W 1024
#define XW 512
#define LORA_LD 320
#define REC 384
#define ALPHA 1.4142135623730951f
#define NT 512
#define NWV 8

typedef __attribute__((ext_vector_type(2))) __bf16 bf16x2_t;
typedef __attribute__((ext_vector_type(2))) float f32x2_t;
__device__ __forceinline__ uint32_t pack2(float a, float b) {
  bf16x2_t v = __builtin_convertvector((f32x2_t){a, b}, bf16x2_t);
  return __builtin_bit_cast(uint32_t, v);
}
__device__ __forceinline__ u16 f2bf(float f) { return (u16)(pack2(f, 0.f) & 0xffffu); }
__device__ __forceinline__ float bf2f(u16 h) { return __uint_as_float(((uint32_t)h) << 16); }

template <int CTRL>
__device__ __forceinline__ float dpp_f(float x) {
  return __int_as_float(__builtin_amdgcn_update_dpp(0, __float_as_int(x), CTRL, 0xf, 0xf, true));
}
__device__ __forceinline__ float row16_sum(float x) {
  x += dpp_f<0xB1>(x);
  x += dpp_f<0x4E>(x);
  x += dpp_f<0x141>(x);
  x += dpp_f<0x140>(x);
  return x;
}
__device__ __forceinline__ float row16_max(float x) {
  x = fmaxf(x, dpp_f<0xB1>(x));
  x = fmaxf(x, dpp_f<0x4E>(x));
  x = fmaxf(x, dpp_f<0x141>(x));
  x = fmaxf(x, dpp_f<0x140>(x));
  return x;
}
__device__ __forceinline__ float wave_sum(float x) {
  x = row16_sum(x);
  x += __shfl_xor(x, 16);
  x += __shfl_xor(x, 32);
  return x;
}
__device__ __forceinline__ float wave_max(float x) {
  x = row16_max(x);
  x = fmaxf(x, __shfl_xor(x, 16));
  x = fmaxf(x, __shfl_xor(x, 32));
  return x;
}


__device__ __forceinline__ int tid_fresh() { int t = threadIdx.x; asm volatile("" : "+v"(t)); return t; }
__device__ __forceinline__ int sfresh(int x) { asm volatile("" : "+s"(x)); return x; }

__device__ __forceinline__ void d_cvt(const float* __restrict__ src, u16* __restrict__ dst, size_t n8, const int bid0, const int nb0, unsigned char* smem) {
  const int bid = sfresh(bid0), nb = sfresh(nb0);
  const int tidf = tid_fresh();
  for (size_t i = (size_t)bid * NT + tidf; i < n8; i += (size_t)nb * NT) {
    float4 a = ((const float4*)src)[2 * i], b = ((const float4*)src)[2 * i + 1];
    uint4 o;
    o.x = pack2(a.x, a.y); o.y = pack2(a.z, a.w); o.z = pack2(b.x, b.y); o.w = pack2(b.z, b.w);
    ((uint4*)dst)[i] = o;
  }
}
__device__ __forceinline__ void d_cvt_t(const float* __restrict__ src, u16* __restrict__ dst, int K, int N, int ldd, const int bid0, const int nb0, unsigned char* smem) {
  const int bid = sfresh(bid0), nb = sfresh(nb0);
  const int tidf = tid_fresh();
  float (*tile)[65] = (float (*)[65])smem;
  const int ntn = (N + 63) / 64, ntk = (K + 63) / 64;
  const int r16 = tidf >> 4, c4 = (tidf & 15) * 4;
  for (int t = bid; t < ntn * ntk; t += nb) {
    const int tk = t / ntn, tn = t % ntn;
    __syncthreads();
#pragma unroll
    for (int i = 0; i < 2; ++i) {
      const int k = tk * 64 + r16 + 32 * i, n = tn * 64 + c4;
      f32x4 v = (f32x4){0.f, 0.f, 0.f, 0.f};
      if (k < K && n < N) v = *(const f32x4*)(src + (size_t)k * N + n);
      tile[r16 + 32 * i][c4] = v[0]; tile[r16 + 32 * i][c4 + 1] = v[1]; tile[r16 + 32 * i][c4 + 2] = v[2]; tile[r16 + 32 * i][c4 + 3] = v[3];
    }
    __syncthreads();
#pragma unroll
    for (int i = 0; i < 2; ++i) {
      const int n = tn * 64 + r16 + 32 * i, k = tk * 64 + c4;
      if (n < N && k < K) {
        uint2 o;
        o.x = pack2(tile[c4][r16 + 32 * i], tile[c4 + 1][r16 + 32 * i]);
        o.y = pack2(tile[c4 + 2][r16 + 32 * i], tile[c4 + 3][r16 + 32 * i]);
        *(uint2*)(dst + (size_t)n * ldd + k) = o;
      }
    }
  }
}
__device__ __forceinline__ void d_zero16(u16* p, size_t n, const int bid0, const int nb0, unsigned char* smem) {
  const int bid = sfresh(bid0), nb = sfresh(nb0);
  const int tidf = tid_fresh();
  for (size_t i = (size_t)bid * NT + tidf; i < n; i += (size_t)nb * NT) p[i] = 0;
}

#define GBM 128
#define GBN 128
#define GBK 64
#define GLS 72
struct GemmArgs {
  const u16* A; const u16* Bt; int lda, ldb; int M, N, K;
  float* Cf; u16* Cb; int ldc; const float* res; float alpha;
  const float* tab; u16* Cb2;
};
#undef GBM
#undef GBN
#undef GBK
#define GBM 256
#define GBN 256
#define GBK 32
__device__ __forceinline__ int lds_byte(int r, int c) {
  int ob = (r & 15) * 64 + c * 2;
  return (r >> 4) * 1024 + (ob ^ (((ob >> 9) & 1) << 5));
}
__device__ __forceinline__ void stage_rc(int b, int& R, int& C) {
  int st = b >> 10, sb = b & 1023, swz = sb ^ (((sb >> 9) & 1) << 5);
  R = st * 16 + swz / 64;
  C = (swz % 64) / 2;
}
#define G_A_B 16384
#define G_STAGE_B 32768
template <int EPI>
__device__ __forceinline__ void gemm_tile(const GemmArgs& g, int tm, int tn, unsigned char* shm) {
  const int tid = tid_fresh(), lane = tid & 63, wave = tid >> 6;
  const int wm = wave >> 2, wn = wave & 3;
  const int m0 = tm * GBM, n0 = tn * GBN;
  const int KT = g.K / GBK;
  f32x4 acc[8][4];
#pragma unroll
  for (int i = 0; i < 8; ++i)
#pragma unroll
    for (int j = 0; j < 4; ++j) acc[i][j] = (f32x4){0.f, 0.f, 0.f, 0.f};
  const u16* aptr[2]; const u16* bptr[2];
#pragma unroll
  for (int i = 0; i < 2; ++i) {
    int R, C;
    stage_rc((wave * 2 + i) * 1024 + lane * 16, R, C);
    aptr[i] = g.A + (size_t)min(m0 + R, g.M - 1) * g.lda + C;
    bptr[i] = g.Bt + (size_t)min(n0 + R, g.N - 1) * g.ldb + C;
  }
  const int aoff = lds_byte(wm * 128 + (lane & 15), (lane >> 4) * 8);
  const int boff = G_A_B + lds_byte(wn * 64 + (lane & 15), (lane >> 4) * 8);
#define GSTAGE(BUF, KTI) { \
    _Pragma("unroll") for (int i = 0; i < 2; ++i) { \
      __builtin_amdgcn_global_load_lds((const unsigned*)(aptr[i] + (KTI) * GBK), (unsigned*)(shm + (BUF) * G_STAGE_B + (wave * 2 + i) * 1024), 16, 0, 0); \
      __builtin_amdgcn_global_load_lds((const unsigned*)(bptr[i] + (KTI) * GBK), (unsigned*)(shm + (BUF) * G_STAGE_B + G_A_B + (wave * 2 + i) * 1024), 16, 0, 0); } }
#define GCOMPUTE(BUF) { const unsigned char* sb_ = shm + (BUF) * G_STAGE_B; bf16x8 af[8], bfr[4]; \
    _Pragma("unroll") for (int i = 0; i < 8; ++i) af[i] = *(const bf16x8*)(sb_ + aoff + i * 1024); \
    _Pragma("unroll") for (int j = 0; j < 4; ++j) bfr[j] = *(const bf16x8*)(sb_ + boff + j * 1024); \
    _Pragma("unroll") for (int i = 0; i < 8; ++i) _Pragma("unroll") for (int j = 0; j < 4; ++j) \
      acc[i][j] = __builtin_amdgcn_mfma_f32_16x16x32_bf16(af[i], bfr[j], acc[i][j], 0, 0, 0); }
#define GWAIT(NAFTER) { if ((NAFTER) >= 2) asm volatile("s_waitcnt vmcnt(8)" ::: "memory"); \
    else if ((NAFTER) == 1) asm volatile("s_waitcnt vmcnt(4)" ::: "memory"); else asm volatile("s_waitcnt vmcnt(0)" ::: "memory"); }
  __syncthreads();
  GSTAGE(0, 0);
  if (KT > 1) GSTAGE(1, 1);
  if (KT > 2) GSTAGE(2, 2);
  GWAIT(min(KT - 1, 2));
  asm volatile("s_waitcnt lgkmcnt(0)" ::: "memory");
  __builtin_amdgcn_s_barrier();
  {
    int buf = 0;
    for (int kt = 0; kt < KT; ++kt) {
      if (kt + 3 < KT) GSTAGE((buf + 3) & 3, kt + 3);
      GCOMPUTE(buf);
      GWAIT(min(KT - 1, kt + 3) - (kt + 1));
      asm volatile("s_waitcnt lgkmcnt(0)" ::: "memory");
      __builtin_amdgcn_s_barrier();
      buf = (buf + 1) & 3;
    }
  }
#undef GSTAGE
#undef GCOMPUTE
#undef GWAIT
#pragma unroll
  for (int i = 0; i < 8; ++i)
#pragma unroll
    for (int j = 0; j < 4; ++j) {
      int col = n0 + wn * 64 + j * 16 + (lane & 15);
#pragma unroll
      for (int r = 0; r < 4; ++r) {
        int row = m0 + wm * 128 + i * 16 + (lane >> 4) * 4 + r;
        if (EPI == 3) {
          float v = acc[i][j][r];
          if (j == 0) {
            float pv = dpp_f<0x128>(v);
            float cs = g.tab[(size_t)row * 16 + (lane & 7)], sn = g.tab[(size_t)row * 16 + 8 + (lane & 7)];
            v = (lane & 8) ? (v * cs + pv * sn) : (v * cs - pv * sn);
          }
          u16* dst = (col & 1024) ? g.Cb2 : g.Cb;
          dst[(size_t)row * 1024 + (col & 1023)] = f2bf(v);
        } else
        if (col < g.N && row < g.M) {
          size_t o = (size_t)row * g.ldc + col;
          float v = acc[i][j][r];
          if (EPI == 0) g.Cf[o] = v;
          else if (EPI == 1) g.Cb[o] = f2bf(v);
          else if (EPI == 4) { int oc = col & 15; g.Cb[(size_t)row * g.ldc + ((col & ~15) | (oc & 3) | ((oc & 8) >> 1) | ((oc & 4) << 1))] = f2bf(v); }
          else g.Cf[o] = g.alpha * g.res[o] + v;
        }
      }
    }
}
template <int EPI>
__device__ __forceinline__ int gemm_run(const GemmArgs& g, int base, const int bid0, const int nb0, unsigned char* smem) {
  const int bid = sfresh(bid0), nb = sfresh(nb0);
  int ntm = (g.M + GBM - 1) / GBM, ntn = (g.N + GBN - 1) / GBN;
  int nt = ntm * ntn;
  const int per = nb >> 3;
  const int mine = (bid & 7) * per + (bid >> 3);
  for (int idx = (base / nb) * nb + mine; idx < base + nt; idx += nb) {
    if (idx < base) continue;
    int t = idx - base;
    gemm_tile<EPI>(g, t / ntn, t % ntn, smem);
  }
  return base + nt;
}

#define G8_LAS __attribute__((address_space(3)))
struct G8Unit { int pm, pn; };
struct G8Gemm { const u16* A; const u16* Bt; int lda, ldb; int M, N, K; int a_pn_off; int b_shared; };
__device__ __forceinline__ int g8_lds_byte(int r, int c) { const int st = (r >> 4) * 2 + (c >> 5), rr = r & 15, cc = c & 31, ob = rr * 64 + cc * 2; return st * 1024 + (ob ^ (((ob >> 9) & 1) << 5)); }
__device__ __forceinline__ void g8_stage_rc(int b, int& R, int& C) { const int st = b / 1024, sb = b % 1024, swz = sb ^ (((sb >> 9) & 1) << 5); R = (st >> 1) * 16 + swz / 64; C = (st & 1) * 32 + (swz % 64) / 2; }
struct G8Order {
  int nM, nN, nwg, G, c;
  __device__ __forceinline__ void init(int M, int N, int G_, int c_) { nM = M / 256; nN = (N + 255) / 256; nwg = nM * nN; G = G_; c = c_; }
  __device__ __forceinline__ bool next(int i, G8Unit& u) const {
    const long L = (long)i * G + c; if (L >= nwg) return false;
    int wgid = (int)L; { const int q = nwg / 8, r = nwg % 8, xcd = wgid % 8, off = wgid / 8; wgid = (xcd < r ? xcd * (q + 1) : r * (q + 1) + (xcd - r) * q) + off; }
    const int nig = 8 * nN, gid = wgid / nig, fm = gid * 8, gsz = (nM - fm) < 8 ? (nM - fm) : 8;
    u.pm = fm + ((wgid % nig) % gsz); u.pn = (wgid % nig) / gsz; return true;
  }
};
struct G8EpiF32 { float* C; int ldc; int N;
  __device__ __forceinline__ void operator()(const f32x4 (&acc)[2][2][4][2], const G8Unit& u, int wr, int wc, int fr, int fq) const {
#pragma unroll
    for (int ai = 0; ai < 2; ++ai)
#pragma unroll
      for (int m = 0; m < 4; ++m) { float* rowp = C + (size_t)(u.pm * 256 + ai * 128 + wr * 64 + m * 16 + fr) * ldc;
#pragma unroll
        for (int bj = 0; bj < 2; ++bj)
#pragma unroll
          for (int n = 0; n < 2; ++n) { const int c0 = u.pn * 256 + bj * 128 + wc * 32 + n * 16 + 4 * fq; if (c0 < N) *(f32x4*)(rowp + c0) = acc[ai][bj][m][n]; } }
  } };
struct G8EpiResLn { float* C; const float* stats; const float* lnw; const float* lnb; int ldc; float alpha;
  __device__ __forceinline__ void operator()(const f32x4 (&acc)[2][2][4][2], const G8Unit& u, int wr, int wc, int fr, int fq) const {
#pragma unroll
    for (int bj = 0; bj < 2; ++bj)
#pragma unroll
      for (int n = 0; n < 2; ++n) { const int c0 = u.pn * 256 + bj * 128 + wc * 32 + n * 16 + 4 * fq;
        const f32x4 w4 = *(const f32x4*)(lnw + c0), b4 = *(const f32x4*)(lnb + c0);
#pragma unroll
        for (int ai = 0; ai < 2; ++ai)
#pragma unroll
          for (int m = 0; m < 4; ++m) { const size_t row = (size_t)(u.pm * 256 + ai * 128 + wr * 64 + m * 16 + fr); const size_t ro = row * ldc;
            const float2 st = *(const float2*)(stats + row * 2);
            f32x4 r4 = *(const f32x4*)(C + ro + c0);
#pragma unroll
            for (int j = 0; j < 4; ++j) r4[j] = (r4[j] - st.x) * st.y * w4[j] + b4[j];
            *(f32x4*)(C + ro + c0) = r4 * alpha + acc[ai][bj][m][n]; } }
  } };
struct G8EpiRes { float* C; const float* res; int ldc; float alpha;
  __device__ __forceinline__ void operator()(const f32x4 (&acc)[2][2][4][2], const G8Unit& u, int wr, int wc, int fr, int fq) const {
#pragma unroll
    for (int ai = 0; ai < 2; ++ai)
#pragma unroll
      for (int m = 0; m < 4; ++m) { const size_t ro = (size_t)(u.pm * 256 + ai * 128 + wr * 64 + m * 16 + fr) * ldc;
#pragma unroll
        for (int bj = 0; bj < 2; ++bj)
#pragma unroll
          for (int n = 0; n < 2; ++n) { const int c0 = u.pn * 256 + bj * 128 + wc * 32 + n * 16 + 4 * fq;
            f32x4 r4 = *(const f32x4*)(res + ro + c0); *(f32x4*)(C + ro + c0) = r4 * alpha + acc[ai][bj][m][n]; } }
  } };
struct G8EpiBf16 { u16* C; int ldc; int vperm;
  __device__ __forceinline__ void operator()(const f32x4 (&acc)[2][2][4][2], const G8Unit& u, int wr, int wc, int fr, int fq) const {
    const int pos = vperm ? (4 * (fq >> 1) + 8 * (fq & 1)) : 4 * fq;
#pragma unroll
    for (int ai = 0; ai < 2; ++ai)
#pragma unroll
      for (int m = 0; m < 4; ++m) { u16* rowp = C + (size_t)(u.pm * 256 + ai * 128 + wr * 64 + m * 16 + fr) * ldc;
#pragma unroll
        for (int bj = 0; bj < 2; ++bj)
#pragma unroll
          for (int n = 0; n < 2; ++n) { const int c0 = u.pn * 256 + bj * 128 + wc * 32 + n * 16 + pos; const f32x4 v = acc[ai][bj][m][n];
            uint2 o; o.x = pack2(v[0], v[1]); o.y = pack2(v[2], v[3]); *(uint2*)(rowp + c0) = o; } }
  } };
struct G8EpiRope { const float* tab; u16* Q; u16* Kb;
  __device__ __forceinline__ void operator()(const f32x4 (&acc)[2][2][4][2], const G8Unit& u, int wr, int wc, int fr, int fq) const {
#pragma unroll
    for (int ai = 0; ai < 2; ++ai)
#pragma unroll
      for (int m = 0; m < 4; ++m) { const size_t row = (size_t)(u.pm * 256 + ai * 128 + wr * 64 + m * 16 + fr);
#pragma unroll
        for (int bj = 0; bj < 2; ++bj)
#pragma unroll
          for (int n = 0; n < 2; ++n) { const int c0 = u.pn * 256 + bj * 128 + wc * 32 + n * 16 + 4 * fq; f32x4 v = acc[ai][bj][m][n];
            if (n == 0 && (wc & 1) == 0) {
#pragma unroll
              for (int j = 0; j < 4; ++j) {
                const float pv = __shfl_xor(v[j], 32);
                const int dd = (4 * fq + j) & 7;
                const float cs = tab[row * 16 + dd], sn = tab[row * 16 + 8 + dd];
                v[j] = (fq & 2) ? (v[j] * cs + pv * sn) : (v[j] * cs - pv * sn);
              }
            }
            u16* dst = (c0 & 1024) ? Kb : Q;
            if (!(c0 & 1024)) v *= (0.125f * 1.4426950408889634f);
            uint2 o; o.x = pack2(v[0], v[1]); o.y = pack2(v[2], v[3]); *(uint2*)(dst + row * 1024 + (c0 & 1023)) = o; } }
  } };

template <class Epi>
__device__ __forceinline__ void gemm8(unsigned char* smem, const G8Gemm g, const Epi& E, const int bid0, const int nb0) {
  constexpr int BK = 64, HALF = 128, HTB = HALF * BK * 2;
  G8_LAS unsigned char* lds = (G8_LAS unsigned char*)smem;
  G8Order S; S.init(g.M, g.N, sfresh(nb0), sfresh(bid0));
  const int tid = tid_fresh(), wid = __builtin_amdgcn_readfirstlane(tid >> 6), lane = tid & 63, wr = wid >> 2, wc = wid & 3, fr = lane & 15, fq = lane >> 4;
  const int nt = g.K / BK;
  unsigned voffA[2], voffB[2];
#pragma unroll
  for (int i = 0; i < 2; ++i) { int R, C; g8_stage_rc(tid * 16 + i * 8192, R, C); voffA[i] = (unsigned)(R * g.lda + C) * 2u; voffB[i] = (unsigned)(R * g.ldb + C) * 2u; }
  const size_t kstep = (size_t)(BK * 2);
  const size_t hstepA = (size_t)HALF * g.lda * 2, hstepB = (size_t)HALF * g.ldb * 2;
  const size_t tstepA = 2 * hstepA, tstepB = 2 * hstepB;
  const unsigned ldsw = (unsigned)wid * 1024u;
  const int aoff = g8_lds_byte(wr * 64 + fr, fq * 8), boff = g8_lds_byte(wc * 32 + fr, fq * 8);
#define PG8_SA(b, h) (((b) * 2 + (h)) * HTB)
#define PG8_SB(b, h) ((4 + (b) * 2 + (h)) * HTB)
#define PG8_STAGE(bufoff, gbase, voff) do { _Pragma("unroll") for (int _i = 0; _i < 2; ++_i) \
        __builtin_amdgcn_global_load_lds((const unsigned*)((const char*)(gbase) + (voff)[_i]), (G8_LAS unsigned*)(lds + (bufoff) + ldsw + _i * 8192), 16, 0, 0); } while (0)
#define PG8_LDA(dst, b, h) do { _Pragma("unroll") for (int m = 0; m < 4; ++m) _Pragma("unroll") for (int k = 0; k < 2; ++k) dst[m][k] = *(const G8_LAS bf16x8*)(lds + PG8_SA(b, h) + aoff + m * 2048 + k * 1024); } while (0)
#define PG8_LDB(dst, b, h) do { _Pragma("unroll") for (int n = 0; n < 2; ++n) _Pragma("unroll") for (int k = 0; k < 2; ++k) dst[n][k] = *(const G8_LAS bf16x8*)(lds + PG8_SB(b, h) + boff + n * 2048 + k * 1024); } while (0)
#define PG8_MMA(ai, bj, At, Bt) do { __builtin_amdgcn_s_setprio(1); _Pragma("unroll") for (int m = 0; m < 4; ++m) _Pragma("unroll") for (int n = 0; n < 2; ++n) _Pragma("unroll") for (int k = 0; k < 2; ++k) \
        acc[ai][bj][m][n] = __builtin_amdgcn_mfma_f32_16x16x32_bf16(Bt[n][k], At[m][k], acc[ai][bj][m][n], 0, 0, 0); __builtin_amdgcn_s_setprio(0); } while (0)
#define PG8_WAIT_V(n) asm volatile("s_waitcnt vmcnt(" #n ")" ::: "memory")
#define PG8_WAIT_L(n) asm volatile("s_waitcnt lgkmcnt(" #n ")" ::: "memory")
#define PG8_BAR __builtin_amdgcn_s_barrier()
#define PG8_SCHED __builtin_amdgcn_sched_barrier(0)
  __syncthreads();
  G8Unit cur, nxt; int ui = 0;
  if (S.next(0, cur)) {
  f32x4 acc[2][2][4][2];
#pragma unroll
  for (int a = 0; a < 2; ++a)
#pragma unroll
    for (int b = 0; b < 2; ++b)
#pragma unroll
      for (int m = 0; m < 4; ++m)
#pragma unroll
        for (int n = 0; n < 2; ++n) acc[a][b][m][n] = (f32x4){0.f, 0.f, 0.f, 0.f};
  bf16x8 At[4][2], B0[2][2], B1[2][2];
  const char* cA = (const char*)g.A + (size_t)cur.pm * tstepA + (size_t)cur.pn * g.a_pn_off; const char* cB = (const char*)g.Bt + (g.b_shared ? (size_t)0 : (size_t)cur.pn * tstepB);
  PG8_STAGE(PG8_SB(0, 0), cB, voffB); PG8_STAGE(PG8_SA(0, 0), cA, voffA); PG8_STAGE(PG8_SB(0, 1), cB + hstepB, voffB); PG8_STAGE(PG8_SA(0, 1), cA + hstepA, voffA);
  if (wr == 1) PG8_BAR;
  PG8_WAIT_V(4); PG8_BAR;
  PG8_STAGE(PG8_SB(1, 0), cB + kstep, voffB); PG8_STAGE(PG8_SA(1, 0), cA + kstep, voffA); PG8_STAGE(PG8_SB(1, 1), cB + hstepB + kstep, voffB);
  PG8_WAIT_V(6); PG8_BAR;
  for (;;) {
    const bool has_next = S.next(ui + 1, nxt);
    const char* nA = has_next ? (const char*)g.A + (size_t)nxt.pm * tstepA + (size_t)nxt.pn * g.a_pn_off : cA; const char* nB = has_next ? (const char*)g.Bt + (g.b_shared ? (size_t)0 : (size_t)nxt.pn * tstepB) : cB;
    for (int t = 0; t < nt; t += 2) {
      const bool last = (t == nt - 2);
      const char* a1 = cA + (size_t)(t + 1) * kstep;
      const char* a2 = last ? nA : cA + (size_t)(t + 2) * kstep; const char* b2 = last ? nB : cB + (size_t)(t + 2) * kstep;
      const char* a3 = a2 + kstep; const char* b3 = b2 + kstep;
      PG8_LDB(B0, 0, 0); PG8_SCHED; PG8_LDA(At, 0, 0); PG8_STAGE(PG8_SA(1, 1), a1 + hstepA, voffA);
      PG8_WAIT_L(8); PG8_BAR; PG8_WAIT_L(0); PG8_MMA(0, 0, At, B0); PG8_BAR; PG8_SCHED;
      PG8_LDB(B1, 0, 1); PG8_STAGE(PG8_SB(0, 0), b2, voffB);
      PG8_BAR; PG8_WAIT_L(0); PG8_MMA(0, 1, At, B1); PG8_BAR;
      PG8_LDA(At, 0, 1); PG8_STAGE(PG8_SA(0, 0), a2, voffA);
      PG8_BAR; PG8_WAIT_L(0); PG8_MMA(1, 0, At, B0); PG8_BAR; PG8_SCHED;
      PG8_STAGE(PG8_SB(0, 1), b2 + hstepB, voffB);
      PG8_WAIT_V(6); PG8_BAR; PG8_MMA(1, 1, At, B1); PG8_BAR;
      PG8_LDB(B0, 1, 0); PG8_SCHED; PG8_LDA(At, 1, 0); PG8_STAGE(PG8_SA(0, 1), a2 + hstepA, voffA);
      PG8_WAIT_L(8); PG8_BAR; PG8_WAIT_L(0); PG8_MMA(0, 0, At, B0); PG8_BAR; PG8_SCHED;
      PG8_LDB(B1, 1, 1); PG8_STAGE(PG8_SB(1, 0), b3, voffB);
      PG8_BAR; PG8_WAIT_L(0); PG8_MMA(0, 1, At, B1); PG8_BAR;
      PG8_LDA(At, 1, 1); PG8_STAGE(PG8_SA(1, 0), a3, voffA);
      PG8_BAR; PG8_WAIT_L(0); PG8_MMA(1, 0, At, B0); PG8_BAR; PG8_SCHED;
      PG8_STAGE(PG8_SB(1, 1), b3 + hstepB, voffB);
      PG8_WAIT_V(6); PG8_BAR; PG8_MMA(1, 1, At, B1); PG8_BAR;
    }
    E(acc, cur, wr, wc, fr, fq);
    if (!has_next) break;
#pragma unroll
    for (int a = 0; a < 2; ++a)
#pragma unroll
      for (int b = 0; b < 2; ++b)
#pragma unroll
        for (int m = 0; m < 4; ++m)
#pragma unroll
          for (int n = 0; n < 2; ++n) acc[a][b][m][n] = (f32x4){0.f, 0.f, 0.f, 0.f};
    cur = nxt; cA = nA; cB = nB; ++ui;
  }
  PG8_WAIT_V(0);
  if (wr == 0) PG8_BAR;
  PG8_BAR;
  }
#undef PG8_SA
#undef PG8_SB
#undef PG8_STAGE
#undef PG8_LDA
#undef PG8_LDB
#undef PG8_MMA
#undef PG8_WAIT_V
#undef PG8_WAIT_L
#undef PG8_BAR
#undef PG8_SCHED
  __syncthreads();
}

__device__ __forceinline__ void d_ln(const float* pre, const float* __restrict__ w, const float* __restrict__ b,
                                            float* outf, u16* __restrict__ outb, float* __restrict__ stats, int rows, const int bid0, const int nb0, unsigned char* smem) {
  const int bid = sfresh(bid0), nb = sfresh(nb0);
  const int tidf = tid_fresh();
  int lane = tidf & 63, wave = tidf >> 6;
  for (int row0 = (bid * NWV + wave) * 2; row0 < rows; row0 += nb * NWV * 2) {
    f32x4 v[2][8];
    float s[2] = {0.f, 0.f};
#pragma unroll
    for (int u = 0; u < 2; ++u) {
      const f32x4* p = (const f32x4*)(pre + (size_t)(row0 + u) * D_MODEL);
#pragma unroll
      for (int i = 0; i < 8; ++i) v[u][i] = p[lane + 64 * i];
    }
#pragma unroll
    for (int u = 0; u < 2; ++u) {
#pragma unroll
      for (int i = 0; i < 8; ++i) s[u] += (v[u][i][0] + v[u][i][1]) + (v[u][i][2] + v[u][i][3]);
    }
    float mu[2], rs[2];
#pragma unroll
    for (int u = 0; u < 2; ++u) mu[u] = wave_sum(s[u]) * (1.0f / D_MODEL);
#pragma unroll
    for (int u = 0; u < 2; ++u) {
      float q = 0.f;
#pragma unroll
      for (int i = 0; i < 8; ++i)
#pragma unroll
        for (int j = 0; j < 4; ++j) { float d = v[u][i][j] - mu[u]; q += d * d; }
      rs[u] = q;
    }
#pragma unroll
    for (int u = 0; u < 2; ++u) rs[u] = rsqrtf(wave_sum(rs[u]) * (1.0f / D_MODEL) + 1e-5f);
    if (stats && lane < 2) { float2 st; st.x = lane ? mu[1] : mu[0]; st.y = lane ? rs[1] : rs[0]; *(float2*)(stats + (size_t)(row0 + lane) * 2) = st; }
#pragma unroll
    for (int i = 0; i < 8; ++i) {
      f32x4 ww = ((const f32x4*)w)[lane + 64 * i], bb = ((const f32x4*)b)[lane + 64 * i];
#pragma unroll
      for (int u = 0; u < 2; ++u) {
        f32x4 o;
#pragma unroll
        for (int j = 0; j < 4; ++j) o[j] = (v[u][i][j] - mu[u]) * rs[u] * ww[j] + bb[j];
        if (outf) ((f32x4*)(outf + (size_t)(row0 + u) * D_MODEL))[lane + 64 * i] = o;
        uint2 ob; ob.x = pack2(o[0], o[1]); ob.y = pack2(o[2], o[3]);
        ((uint2*)(outb + (size_t)(row0 + u) * D_MODEL))[lane + 64 * i] = ob;
      }
    }
  }
}

__device__ __forceinline__ void d_rwkv_prep1(const float* __restrict__ proj, const float* __restrict__ mu, u16* __restrict__ lin, const int bid0, const int nb0, unsigned char* smem) {
  const int bid = sfresh(bid0), nb = sfresh(nb0);
  const int tidf = tid_fresh();
  const unsigned total = (unsigned)NTOK * LORA_LD;
  for (unsigned i = (unsigned)bid * NT + (unsigned)tidf; i < total; i += (unsigned)nb * NT) {
    const int t = (int)(i / (unsigned)LORA_LD), c = (int)(i % (unsigned)LORA_LD);
    float out = 0.f;
    if (c < 288) {
      int col = 3072 + c;
      float p = proj[(size_t)t * RCOLS + col];
      float pp = ((t % SEQ) == 0) ? 0.f : proj[(size_t)(t - 1) * RCOLS + col];
      float x = p + (pp - p) * mu[col];
      if (c < 64) out = 1.f - 2.f * __builtin_amdgcn_rcpf(1.f + __expf(2.f * x));
      else if (c < 128) out = x;
      else out = __builtin_amdgcn_rcpf(1.f + __expf(-x));
    }
    lin[i] = f2bf(out);
  }
}

struct Prep2Args {
  const float* proj; const float* mu; const float* lw; const float* la;
  const float* w0; const float* a0; const float* k_k; const float* k_a; const float* r_k;
  float* wrec; u16* prec; float* bon;
};
__device__ __forceinline__ void prep2_load(const Prep2Args& a, int it, int lane, float (&pr)[5], float (&pk)[5], float (&pv)[5], float (&lw)[4], float (&la)[4]) {
  const int h = it & (RH - 1), t0 = (it >> 4) * 4;
  const int s0 = t0 % SEQ;
  const int c = h * 64 + lane;
  const float* p0 = a.proj + (size_t)t0 * RCOLS;
  pr[0] = pk[0] = pv[0] = 0.f;
  if (s0 != 0) { pr[0] = p0[c - RCOLS]; pk[0] = p0[RW + c - RCOLS]; pv[0] = p0[2 * RW + c - RCOLS]; }
#pragma unroll
  for (int u = 0; u < 4; ++u) {
    pr[u + 1] = p0[(size_t)u * RCOLS + c]; pk[u + 1] = p0[(size_t)u * RCOLS + RW + c]; pv[u + 1] = p0[(size_t)u * RCOLS + 2 * RW + c];
    lw[u] = a.lw[(size_t)(t0 + u) * RW + c]; la[u] = a.la[(size_t)(t0 + u) * RW + c];
  }
}
__device__ __forceinline__ void d_rwkv_prep2(Prep2Args a, const int bid0, const int nb0, unsigned char* smem) {
  const int bid = sfresh(bid0), nb = sfresh(nb0);
  const int tidf = tid_fresh();
  int lane = tidf & 63, wave = tidf >> 6;
  constexpr int NITEM = (NTOK / 4) * RH;
  const int stride = nb * NWV;
  int it = bid * NWV + wave;
  if (it >= NITEM) return;
  float npr[5], npk[5], npv[5], nlw[4], nla[4];
  prep2_load(a, it, lane, npr, npk, npv, nlw, nla);
  for (; it < NITEM; it += stride) {
    const int h = it & (RH - 1), t0 = (it >> 4) * 4;
    const int b = t0 / SEQ, s0 = t0 % SEQ;
    const int c = h * 64 + lane;
    const float mur = a.mu[c], muk = a.mu[RW + c], muv = a.mu[2 * RW + c];
    const float w0c = a.w0[c], a0c = a.a0[c], kkc = a.k_k[c], kac = a.k_a[c], rkc = a.r_k[c];
    float pr[5], pk[5], pv[5], lw[4], la[4];
#pragma unroll
    for (int u = 0; u < 5; ++u) { pr[u] = npr[u]; pk[u] = npk[u]; pv[u] = npv[u]; }
#pragma unroll
    for (int u = 0; u < 4; ++u) { lw[u] = nlw[u]; la[u] = nla[u]; }
    { const int itn = (it + stride < NITEM) ? it + stride : it; prep2_load(a, itn, lane, npr, npk, npv, nlw, nla); }
    float r[4], k[4], v[4], decay[4], iclr[4], kk[4], nrm[4], k2[4], bonus[4];
#pragma unroll
    for (int u = 0; u < 4; ++u) {
      r[u] = pr[u + 1] + (pr[u] - pr[u + 1]) * mur;
      k[u] = pk[u + 1] + (pk[u] - pk[u + 1]) * muk;
      v[u] = pv[u + 1] + (pv[u] - pv[u + 1]) * muv;
      float nz = -(w0c + lw[u]);
      float sp = fmaxf(nz, 0.f) + __logf(1.f + __expf(-fabsf(nz)));
      decay[u] = __expf(-__expf(-sp - 0.5f));
      iclr[u] = __builtin_amdgcn_rcpf(1.f + __expf(-(a0c + la[u])));
      kk[u] = k[u] * kkc;
      nrm[u] = kk[u] * kk[u];
      k2[u] = k[u] * (1.f + (iclr[u] - 1.f) * kac);
      bonus[u] = r[u] * k2[u] * rkc;
    }
#pragma unroll
    for (int u = 0; u < 4; ++u) { nrm[u] = wave_sum(nrm[u]); bonus[u] = wave_sum(bonus[u]); }
#pragma unroll
    for (int u = 0; u < 4; ++u) {
      float kn = kk[u] * __builtin_amdgcn_rcpf(fmaxf(__builtin_amdgcn_sqrtf(nrm[u]), 1e-12f));
      size_t ri = (size_t)(b * RH + h) * SEQ + s0 + u;
      a.wrec[ri * 64 + lane] = decay[u];
      u16* pr16 = a.prec + ri * 320;
      pr16[lane] = f2bf(k2[u]);
      pr16[64 + lane] = f2bf(-kn);
      pr16[128 + lane] = f2bf(kn * iclr[u]);
      pr16[192 + lane] = f2bf(r[u]);
      pr16[256 + lane] = f2bf(v[u]);
      if (lane == 0) a.bon[(size_t)(t0 + u) * RH + h] = bonus[u];
    }
  }
}

#define SC_TC 16
__device__ __forceinline__ void scan_store_p(float* sRec, int c, u32x4 v) {
  int step = c / 40, within = c % 40;
  int arr = within >> 3, col8 = (within & 7) * 8;
  float* d = sRec + step * REC + 64 + arr * 64 + col8;
  f32x4 lo, hi;
  lo[0] = __uint_as_float(v[0] << 16); lo[1] = __uint_as_float(v[0] & 0xffff0000u);
  lo[2] = __uint_as_float(v[1] << 16); lo[3] = __uint_as_float(v[1] & 0xffff0000u);
  hi[0] = __uint_as_float(v[2] << 16); hi[1] = __uint_as_float(v[2] & 0xffff0000u);
  hi[2] = __uint_as_float(v[3] << 16); hi[3] = __uint_as_float(v[3] & 0xffff0000u);
  *(f32x4*)d = lo;
  *(f32x4*)(d + 4) = hi;
}
#define SCAN_ITEMS (BATCH * RH * 4)
#define SC_BUF (SC_TC * REC)
struct TabCvt { const float* pu; const float* pv; unsigned char* Ub; unsigned char* Vb; float* usinv; float* vsinv; };
__device__ __forceinline__ void tab_row_store(const f32x4 (&v)[8], unsigned char* dst, float* sinv, int row, bool natural, int lane) {
  float amax = 0.f;
#pragma unroll
  for (int i = 0; i < 8; ++i)
#pragma unroll
    for (int j = 0; j < 4; ++j) amax = fmaxf(amax, fabsf(v[i][j]));
  amax = wave_max(amax);
  float scale = 1.f, inv = 1.f;
  if (amax > 0.f) { scale = 6.0f / amax; inv = amax * (1.0f / 6.0f); }
  u32x4 o;
#pragma unroll
  for (int k = 0; k < 4; ++k) {
    unsigned w = 0u;
    w = __builtin_amdgcn_cvt_scalef32_pk_fp4_f32(w, v[2 * k][0] * scale, v[2 * k][1] * scale, 1.0f, 0);
    w = __builtin_amdgcn_cvt_scalef32_pk_fp4_f32(w, v[2 * k][2] * scale, v[2 * k][3] * scale, 1.0f, 1);
    w = __builtin_amdgcn_cvt_scalef32_pk_fp4_f32(w, v[2 * k + 1][0] * scale, v[2 * k + 1][1] * scale, 1.0f, 2);
    w = __builtin_amdgcn_cvt_scalef32_pk_fp4_f32(w, v[2 * k + 1][2] * scale, v[2 * k + 1][3] * scale, 1.0f, 3);
    o[k] = w;
  }
  if (natural) {
    uint2 lo; lo.x = o[0]; lo.y = o[1];
    uint2 hi; hi.x = o[2]; hi.y = o[3];
    *(uint2*)(dst + (size_t)row * (D_MODEL / 2) + lane * 8) = lo;
    *(uint2*)(dst + (size_t)row * (D_MODEL / 2) + 512 + lane * 8) = hi;
  } else {
    *(u32x4*)(dst + (size_t)row * (D_MODEL / 2) + lane * 16) = o;
  }
  if (lane == 0) sinv[row] = inv;
}
__device__ __forceinline__ void d_rwkv_scan(const float* __restrict__ wrec, const u16* __restrict__ prec, float* __restrict__ yraw, const TabCvt tc, const int bid0, const int nb0, unsigned char* smem) {
  const int bid = sfresh(bid0), nb = sfresh(nb0);
  const int tidf = tid_fresh();
  float* sRec0 = (float*)smem;
  float* sY0 = sRec0 + 2 * SC_BUF;
  const int tid = tidf, lane = tid & 63, wave = __builtin_amdgcn_readfirstlane(tid >> 6);
  const int cg = lane & 15, rg = lane >> 4;
  const bool helper = wave >= 4;
  const int ht = tid - 256;
  constexpr int NCH = SEQ / SC_TC;
  for (int item = bid; item < SCAN_ITEMS; item += nb) {
    const int bh = item >> 2, rb = item & 3;
    const int b = bh / RH, h = bh % RH;
    const f32x4* wsrc = (const f32x4*)(wrec + (size_t)bh * SEQ * 64);
    const u32x4* psrc = (const u32x4*)(prec + (size_t)bh * SEQ * 320);
    const int rowl = (wave & 3) * 4 + rg;
    const int row = rb * 16 + rowl;
    f32x2 S01 = (f32x2){0.f, 0.f}, S23 = S01;
    f32x4 pw = (f32x4){0.f, 0.f, 0.f, 0.f};
    u32x4 p0 = (u32x4){0u, 0u, 0u, 0u}, p1 = p0, p2 = p0;
    f32x4 trow[8];
#pragma unroll
    for (int i = 0; i < 8; ++i) trow[i] = (f32x4){0.f, 0.f, 0.f, 0.f};
    __syncthreads();
    if (helper) {
      pw = wsrc[ht]; p0 = psrc[ht]; p1 = psrc[ht + 256]; if (ht < 128) p2 = psrc[ht + 512];
      *(f32x4*)(sRec0 + (ht >> 4) * REC + (ht & 15) * 4) = pw;
      scan_store_p(sRec0, ht, p0); scan_store_p(sRec0, ht + 256, p1); if (ht < 128) scan_store_p(sRec0, ht + 512, p2);
      pw = wsrc[256 + ht]; { const u32x4* ps = psrc + 640; p0 = ps[ht]; p1 = ps[ht + 256]; if (ht < 128) p2 = ps[ht + 512]; }
    }
    __syncthreads();
    for (int ch = 0; ch < NCH; ++ch) {
      float* sRec = sRec0 + (ch & 1) * SC_BUF;
      float* sY = sY0 + (ch & 1) * (SC_TC * 256);
      if (!helper) {
        const float* rc0 = sRec + 4 * cg;
        const float* rv0 = sRec + 320 + row;
        f32x4 Wa[2], Ka[2], Aa[2], Ba[2], Ra[2], Wb[2], Kb[2], Ab[2], Bb[2], Rb[2];
        float va[2], vb[2];
#define SC_LOAD(W, K, A, B, R, V, G) { _Pragma("unroll") for (int u = 0; u < 2; ++u) { const float* rc = rc0 + ((G) * 2 + u) * REC; \
          W[u] = *(const f32x4*)(rc); K[u] = *(const f32x4*)(rc + 64); A[u] = *(const f32x4*)(rc + 128); B[u] = *(const f32x4*)(rc + 192); \
          R[u] = *(const f32x4*)(rc + 256); V[u] = rv0[((G) * 2 + u) * REC]; } }
#define SC_GROUP(W, K, A, B, R, V, G) { float yy[2]; \
          _Pragma("unroll") for (int u = 0; u < 2; ++u) { \
            const f32x2 v2 = (f32x2){V[u], V[u]}; \
            const f32x2 p01 = __builtin_elementwise_fma(S01, W[u].lo, K[u].lo * v2), p23 = __builtin_elementwise_fma(S23, W[u].hi, K[u].hi * v2); \
            const f32x2 t = __builtin_elementwise_fma(S23, A[u].hi, S01 * A[u].lo); \
            float sa = t[0] + t[1]; \
            sa = row16_sum(sa); \
            const f32x2 sa2 = (f32x2){sa, sa}; \
            S01 = __builtin_elementwise_fma(sa2, B[u].lo, p01); S23 = __builtin_elementwise_fma(sa2, B[u].hi, p23); \
            const f32x2 yv = __builtin_elementwise_fma(S23, R[u].hi, S01 * R[u].lo); \
            yy[u] = yv[0] + yv[1]; } \
          _Pragma("unroll") for (int u = 0; u < 2; ++u) sY[(((G) * 2 + u) * 16 + rowl) * 16 + cg] = yy[u]; }
        SC_LOAD(Wa, Ka, Aa, Ba, Ra, va, 0);
        SC_LOAD(Wb, Kb, Ab, Bb, Rb, vb, 1);
        SC_GROUP(Wa, Ka, Aa, Ba, Ra, va, 0);
        SC_LOAD(Wa, Ka, Aa, Ba, Ra, va, 2);
        SC_GROUP(Wb, Kb, Ab, Bb, Rb, vb, 1);
        SC_LOAD(Wb, Kb, Ab, Bb, Rb, vb, 3);
        SC_GROUP(Wa, Ka, Aa, Ba, Ra, va, 2);
        SC_LOAD(Wa, Ka, Aa, Ba, Ra, va, 4);
        SC_GROUP(Wb, Kb, Ab, Bb, Rb, vb, 3);
        SC_LOAD(Wb, Kb, Ab, Bb, Rb, vb, 5);
        SC_GROUP(Wa, Ka, Aa, Ba, Ra, va, 4);
        SC_LOAD(Wa, Ka, Aa, Ba, Ra, va, 6);
        SC_GROUP(Wb, Kb, Ab, Bb, Rb, vb, 5);
        SC_LOAD(Wb, Kb, Ab, Bb, Rb, vb, 7);
        SC_GROUP(Wa, Ka, Aa, Ba, Ra, va, 6);
        SC_GROUP(Wb, Kb, Ab, Bb, Rb, vb, 7);
#undef SC_LOAD
#undef SC_GROUP
      } else {
        if (tc.pu) {
          const int hw = wave - 4;
          if (ch >= 1 && ch <= 32) {
            const int sl = (ch - 1) * 4 + hw;
            const bool isv = sl >= 64;
            tab_row_store(trow, isv ? tc.Vb : tc.Ub, isv ? tc.vsinv : tc.usinv, bid * 64 + (sl & 63), !isv, lane);
          }
          if (ch < 32) {
            const int sl = ch * 4 + hw;
            const bool isv = sl >= 64;
            const f32x4* rp = (const f32x4*)((isv ? tc.pv : tc.pu) + (size_t)(bid * 64 + (sl & 63)) * D_MODEL);
#pragma unroll
            for (int q = 0; q < 2; ++q)
#pragma unroll
              for (int k = 0; k < 4; ++k) trow[q * 4 + k] = rp[q * 256 + lane * 4 + k];
          }
        }
        if (ch + 1 < NCH) {
          float* dR = sRec0 + ((ch + 1) & 1) * SC_BUF;
          *(f32x4*)(dR + (ht >> 4) * REC + (ht & 15) * 4) = pw;
          scan_store_p(dR, ht, p0); scan_store_p(dR, ht + 256, p1); if (ht < 128) scan_store_p(dR, ht + 512, p2);
          if (ch + 2 < NCH) {
            pw = wsrc[(size_t)(ch + 2) * 256 + ht];
            const u32x4* ps = psrc + (size_t)(ch + 2) * 640;
            p0 = ps[ht]; p1 = ps[ht + 256]; if (ht < 128) p2 = ps[ht + 512];
          }
        }
        if (ch >= 1) {
          const float* pY = sY0 + ((ch - 1) & 1) * (SC_TC * 256);
          const int st = ht >> 4, r = ht & 15;
          const f32x4* yp = (const f32x4*)(pY + (st * 16 + r) * 16);
          f32x4 y0 = yp[0], y1 = yp[1], y2 = yp[2], y3 = yp[3];
          yraw[((size_t)b * SEQ + (ch - 1) * SC_TC + st) * RW + h * 64 + rb * 16 + r] =
              ((y0[0] + y0[1]) + (y0[2] + y0[3])) + ((y1[0] + y1[1]) + (y1[2] + y1[3])) + (((y2[0] + y2[1]) + (y2[2] + y2[3])) + ((y3[0] + y3[1]) + (y3[2] + y3[3])));
        }
      }
      __syncthreads();
    }
    if (helper) {
      const float* pY = sY0 + ((NCH - 1) & 1) * (SC_TC * 256);
      const int st = ht >> 4, r = ht & 15;
      const f32x4* yp = (const f32x4*)(pY + (st * 16 + r) * 16);
      f32x4 y0 = yp[0], y1 = yp[1], y2 = yp[2], y3 = yp[3];
      yraw[((size_t)b * SEQ + (NCH - 1) * SC_TC + st) * RW + h * 64 + rb * 16 + r] =
          ((y0[0] + y0[1]) + (y0[2] + y0[3])) + ((y1[0] + y1[1]) + (y1[2] + y1[3])) + (((y2[0] + y2[1]) + (y2[2] + y2[3])) + ((y3[0] + y3[1]) + (y3[2] + y3[3])));
    }
  }
}

__device__ __forceinline__ void d_rwkv_post(const float* __restrict__ yraw, const float* __restrict__ proj, const float* __restrict__ mu,
                                                   const float* __restrict__ bon, const float* __restrict__ gate, const float* __restrict__ lnw,
                                                   const float* __restrict__ lnb, u16* __restrict__ cat, const int bid0, const int nb0, unsigned char* smem) {
  const int bid = sfresh(bid0), nb = sfresh(nb0);
  const int tidf = tid_fresh();
  int lane = tidf & 63, wave = tidf >> 6;
  for (int it = bid * NWV + wave; it < (NTOK / 4) * RH; it += nb * NWV) {
    const int h = it & (RH - 1), t0 = (it >> 4) * 4;
    const int s0 = t0 % SEQ;
    const int c = h * 64 + lane;
    const float muv = mu[2 * RW + c], lw_ = lnw[c], lb_ = lnb[c];
    float y[4], pv[5], g[4], bo[4];
    const float* p0 = proj + (size_t)t0 * RCOLS + 2 * RW + c;
    pv[0] = 0.f;
    if (s0 != 0) pv[0] = p0[-RCOLS];
#pragma unroll
    for (int u = 0; u < 4; ++u) {
      y[u] = yraw[(size_t)(t0 + u) * RW + c];
      pv[u + 1] = p0[(size_t)u * RCOLS];
      g[u] = gate[(size_t)(t0 + u) * RW + c];
      bo[u] = bon[(size_t)(t0 + u) * RH + h];
    }
    float mean[4], var[4];
#pragma unroll
    for (int u = 0; u < 4; ++u) { mean[u] = wave_sum(y[u]) * (1.f / 64.f); var[u] = wave_sum(y[u] * y[u]) * (1.f / 64.f); }
#pragma unroll
    for (int u = 0; u < 4; ++u) var[u] = fmaxf(var[u] - mean[u] * mean[u], 0.f);
#pragma unroll
    for (int u = 0; u < 4; ++u) {
      float yn = (y[u] - mean[u]) * __builtin_amdgcn_rsqf(var[u] + 64e-5f) * lw_ + lb_;
      float v = pv[u + 1] + (pv[u] - pv[u + 1]) * muv;
      cat[(size_t)(t0 + u) * D_MODEL + c] = f2bf((yn + bo[u] * v) * g[u]);
    }
  }
}

__device__ __forceinline__ void d_rope_table(const int* __restrict__ pos, float* __restrict__ tab, const int bid0, const int nb0, unsigned char* smem) {
  const int bid = sfresh(bid0), nb = sfresh(nb0);
  const int tidf = tid_fresh();
  for (int i = bid * NT + tidf; i < NTOK * 8; i += nb * NT) {
    int t = i >> 3, dd = i & 7;
    float inv = (dd & 4) ? ((dd & 2) ? ((dd & 1) ? 1.031338537721246e-05f : 5.3182958969449883e-05f)
                                     : ((dd & 1) ? 0.0002742481756762073f : 0.001414213562373095f))
                         : ((dd & 2) ? ((dd & 1) ? 0.0072926647372171093f : 0.037606030930863933f)
                                     : ((dd & 1) ? 0.19392274474868576f : 1.0f));
    float ang = (float)pos[t] * inv;
    float sn, cs;
    sincosf(ang, &sn, &cs);
    tab[(size_t)t * 16 + dd] = cs;
    tab[(size_t)t * 16 + 8 + dd] = sn;
  }
}

struct AttnArgs {
  const u16* Q; int ldq;
  const u16* K; int ldk;
  const u16* Vt; int ldv;
  u16* O; int ldo; int ocol0;
  int nb, nh, sq, sk;
  float scale;
  const float* lq1; const float* lk1; const float* lq2; const float* lk2; const float* subw; float lam_init;
  const float* Qf0; const float* Qf1;
};
template <int DQK, int NCOMP, bool CAUSAL>
__device__ __forceinline__ void attn_item(const AttnArgs& a, int b, int h, int qt, u16* smem) {
  constexpr int KS = DQK + 8;
  constexpr int KST = DQK / 32;
  u16* sK = smem;
  u16* sV = sK + NCOMP * 64 * KS;
  u16* sP = sV + 128 * 72;
  const int tid = tid_fresh() & 255, lane = tid & 63, wave = tid >> 6;
  const int l15 = lane & 15, l4 = lane >> 4;
  const int hq = h * (NCOMP * DQK);
  const size_t qrow0 = (size_t)b * a.sq + qt * 64 + wave * 16;
  const float sc = a.scale * 1.4426950408889634f;

  bf16x8 qf[NCOMP][KST];
#pragma unroll
  for (int c = 0; c < NCOMP; ++c)
#pragma unroll
    for (int ks = 0; ks < KST; ++ks)
    {
      if (!CAUSAL) {
        const size_t qo = (qrow0 + l15) * a.ldq + hq + c * DQK + ks * 32 + l4 * 8;
        f32x4 x0 = *(const f32x4*)(a.Qf0 + qo), x1 = *(const f32x4*)(a.Qf0 + qo + 4);
        f32x4 y0 = *(const f32x4*)(a.Qf1 + qo), y1 = *(const f32x4*)(a.Qf1 + qo + 4);
        u32x4 pk_ = (u32x4){pack2(x0[0] + y0[0], x0[1] + y0[1]), pack2(x0[2] + y0[2], x0[3] + y0[3]),
                            pack2(x1[0] + y1[0], x1[1] + y1[1]), pack2(x1[2] + y1[2], x1[3] + y1[3])};
        qf[c][ks] = __builtin_bit_cast(bf16x8, pk_);
      } else
      qf[c][ks] = *(const bf16x8*)(a.Q + (qrow0 + l15) * a.ldq + hq + c * DQK + ks * 32 + l4 * 8);
    }

  f32x4 O[NCOMP][8];
  float m[NCOMP][4], l[NCOMP][4];
#pragma unroll
  for (int c = 0; c < NCOMP; ++c) {
#pragma unroll
    for (int d = 0; d < 8; ++d) O[c][d] = (f32x4){0.f, 0.f, 0.f, 0.f};
#pragma unroll
    for (int i = 0; i < 4; ++i) { m[c][i] = -INFINITY; l[c][i] = 0.f; }
  }
  const int nkt = CAUSAL ? (qt + 1) : (a.sk / 64);
  constexpr int KCH = NCOMP * 64 * (DQK / 8) / 256;
  u32x4 rk[KCH], rv[4];
  auto gload = [&](int kt) {
#pragma unroll
    for (int i = 0; i < KCH; ++i) {
      int cidx = tid + 256 * i;
      int kc = cidx % (DQK / 8), rowc = cidx / (DQK / 8);
      int c = rowc / 64, key = rowc % 64;
      rk[i] = *(const u32x4*)(a.K + ((size_t)b * a.sk + kt * 64 + key) * a.ldk + hq + c * DQK + kc * 8);
    }
#pragma unroll
    for (int i = 0; i < 4; ++i) {
      int cidx = tid + 256 * i;
      int kc = cidx & 7, dv = cidx >> 3;
      rv[i] = *(const u32x4*)(a.Vt + (size_t)(h * 128 + dv) * a.ldv + (size_t)b * a.sk + kt * 64 + kc * 8);
    }
  };
  auto swrite = [&]() {
#pragma unroll
    for (int i = 0; i < KCH; ++i) {
      int cidx = tid + 256 * i;
      int kc = cidx % (DQK / 8), rowc = cidx / (DQK / 8);
      *(u32x4*)(sK + rowc * KS + kc * 8) = rk[i];
    }
#pragma unroll
    for (int i = 0; i < 4; ++i) {
      int cidx = tid + 256 * i;
      int kc = cidx & 7, dv = cidx >> 3;
      *(u32x4*)(sV + dv * 72 + kc * 8) = rv[i];
    }
  };
  gload(0);
  for (int kt = 0; kt < nkt; ++kt) {
    __syncthreads();
    swrite();
    __syncthreads();
    if (kt + 1 < nkt) gload(kt + 1);
#pragma unroll
    for (int c = 0; c < NCOMP; ++c) {
      f32x4 S[4];
#pragma unroll
      for (int sub = 0; sub < 4; ++sub) {
        f32x4 acc = (f32x4){0.f, 0.f, 0.f, 0.f};
#pragma unroll
        for (int ks = 0; ks < KST; ++ks) {
          bf16x8 kf = *(const bf16x8*)(sK + (c * 64 + sub * 16 + l15) * KS + ks * 32 + l4 * 8);
          acc = __builtin_amdgcn_mfma_f32_16x16x32_bf16(qf[c][ks], kf, acc, 0, 0, 0);
        }
        S[sub] = acc;
      }
#pragma unroll
      for (int sub = 0; sub < 4; ++sub)
#pragma unroll
        for (int i = 0; i < 4; ++i) {
          float sv_ = S[sub][i] * sc;
          if (CAUSAL && kt == qt) {
            int keyl = sub * 16 + l15, rowl = wave * 16 + l4 * 4 + i;
            if (keyl > rowl) sv_ = -INFINITY;
          }
          S[sub][i] = sv_;
        }
#pragma unroll
      for (int i = 0; i < 4; ++i) {
        float mx = fmaxf(fmaxf(S[0][i], S[1][i]), fmaxf(S[2][i], S[3][i]));
        mx = row16_max(mx);
        float mn = fmaxf(m[c][i], mx);
        float alpha = exp2f(m[c][i] - mn);
        m[c][i] = mn;
        float ps = 0.f;
#pragma unroll
        for (int sub = 0; sub < 4; ++sub) {
          float pe = exp2f(S[sub][i] - mn);
          S[sub][i] = pe;
          ps += pe;
        }
        l[c][i] = l[c][i] * alpha + ps;
#pragma unroll
        for (int d = 0; d < 8; ++d) O[c][d][i] *= alpha;
      }
      u16* pw = sP + wave * 16 * 72;
      __syncthreads();
#pragma unroll
      for (int sub = 0; sub < 4; ++sub)
#pragma unroll
        for (int i = 0; i < 4; ++i) pw[(l4 * 4 + i) * 72 + sub * 16 + l15] = f2bf(S[sub][i]);
      __syncthreads();
#pragma unroll
      for (int ks = 0; ks < 2; ++ks) {
        bf16x8 pf = *(const bf16x8*)(pw + l15 * 72 + ks * 32 + l4 * 8);
#pragma unroll
        for (int d = 0; d < 8; ++d) {
          bf16x8 vf = *(const bf16x8*)(sV + (d * 16 + l15) * 72 + ks * 32 + l4 * 8);
          O[c][d] = __builtin_amdgcn_mfma_f32_16x16x32_bf16(pf, vf, O[c][d], 0, 0, 0);
        }
      }
    }
  }
  float inv[NCOMP][4];
#pragma unroll
  for (int c = 0; c < NCOMP; ++c)
#pragma unroll
    for (int i = 0; i < 4; ++i) inv[c][i] = 1.f / row16_sum(l[c][i]);
  if (NCOMP == 2) {
    float s1 = 0.f, s2 = 0.f;
    for (int j = 0; j < 64; ++j) { s1 += a.lq1[j] * a.lk1[j]; s2 += a.lq2[j] * a.lk2[j]; }
    float lam = expf(s1) - expf(s2) + a.lam_init;
    float ss[4] = {0.f, 0.f, 0.f, 0.f};
#pragma unroll
    for (int d = 0; d < 8; ++d)
#pragma unroll
      for (int i = 0; i < 4; ++i) {
        float o = O[0][d][i] * inv[0][i] - lam * (O[NCOMP - 1][d][i] * inv[NCOMP - 1][i]);
        O[0][d][i] = o;
        ss[i] += o * o;
      }
#pragma unroll
    for (int i = 0; i < 4; ++i) ss[i] = rsqrtf(row16_sum(ss[i]) * (1.f / 128.f) + 1e-5f) * (1.f - a.lam_init);
#pragma unroll
    for (int d = 0; d < 8; ++d) {
      float sw = a.subw[d * 16 + l15];
#pragma unroll
      for (int i = 0; i < 4; ++i)
        a.O[(qrow0 + l4 * 4 + i) * a.ldo + a.ocol0 + h * 128 + d * 16 + l15] = f2bf(O[0][d][i] * ss[i] * sw);
    }
  } else {
#pragma unroll
    for (int d = 0; d < 8; ++d)
#pragma unroll
      for (int i = 0; i < 4; ++i)
        a.O[(qrow0 + l4 * 4 + i) * a.ldo + a.ocol0 + h * 128 + d * 16 + l15] = f2bf(O[0][d][i] * inv[0][i]);
  }
}
typedef __attribute__((ext_vector_type(16))) float f32x16;
__device__ __forceinline__ void attn2_item(const AttnArgs& a, float* u1, int b, int h, int qb, int c, unsigned char* shm) {
  const int tid = tid_fresh(), lane = tid & 63, wave = tid >> 6;
  const int q = lane & 31, hh = lane >> 5;
  const int q0 = qb * 256 + wave * 32;
  const size_t qrow = (size_t)b * SEQ + q0 + q;
  const float sc = 0.125f * 1.4426950408889634f;
  bf16x8 qf[4];
#pragma unroll
  for (int s = 0; s < 4; ++s) qf[s] = *(const bf16x8*)(a.Q + qrow * 1024 + h * 128 + c * 64 + 16 * s + 8 * hh);
  f32x16 O[4];
  float m = -INFINITY, l = 0.f;
#pragma unroll
  for (int t = 0; t < 4; ++t)
#pragma unroll
    for (int r = 0; r < 16; ++r) O[t][r] = 0.f;
  const int nkt = 4 * qb + 4;
  unsigned koff[1], voff[2];
  {
    int row = 8 * wave + (lane >> 3);
    int chunk = (lane & 7) ^ ((row >> 1) & 7);
    koff[0] = (unsigned)(row * 1024 + chunk * 8);
  }
#pragma unroll
  for (int i = 0; i < 2; ++i) {
    int row = 8 * (wave * 2 + i) + (lane >> 3);
    int chunk = (lane & 7) ^ ((row >> 1) & 7);
    voff[i] = (unsigned)(row * NTOK + chunk * 8);
  }
  const u16* kbase = a.K + (size_t)b * SEQ * 1024 + h * 128 + c * 64;
  const u16* vbase = a.Vt + (size_t)h * 128 * NTOK + (size_t)b * SEQ;
#define A2_STAGE(BUF, KT) { \
    __builtin_amdgcn_global_load_lds((const unsigned*)(kbase + (size_t)(KT) * 64 * 1024 + koff[0]), (unsigned*)(shm + (BUF) * 24576 + wave * 1024), 16, 0, 0); \
    _Pragma("unroll") for (int i = 0; i < 2; ++i) \
      __builtin_amdgcn_global_load_lds((const unsigned*)(vbase + (KT) * 64 + voff[i]), (unsigned*)(shm + (BUF) * 24576 + 8192 + (wave * 2 + i) * 1024), 16, 0, 0); }
#define A2_KFRAG(BASE, T_, s_) (*(const bf16x8*)((BASE) + (32 * (T_) + q) * 128 + (((2 * (s_) + hh) ^ (((32 * (T_) + q) >> 1) & 7)) << 4)))
#define A2_VFRAG(BASE, t_, s2_) (*(const bf16x8*)((BASE) + (32 * (t_) + q) * 128 + (((2 * (s2_) + hh) ^ (((32 * (t_) + q) >> 1) & 7)) << 4)))
#define A2_EXPQ(J) { _Pragma("unroll") for (int r_ = 0; r_ < 8; r_ += 2) { \
      float p0 = __builtin_amdgcn_exp2f(S[(J) >> 1][((J) & 1) * 8 + r_]), p1 = __builtin_amdgcn_exp2f(S[(J) >> 1][((J) & 1) * 8 + r_ + 1]); \
      ps += p0 + p1; pk[(J) >> 1][((J) & 1) * 4 + (r_ >> 1)] = pack2(p0, p1); } }
#define A2_PV(VF, J) { u32x4 pw_ = (u32x4){pk[(J) >> 1][((J) & 1) * 4 + 0], pk[(J) >> 1][((J) & 1) * 4 + 1], pk[(J) >> 1][((J) & 1) * 4 + 2], pk[(J) >> 1][((J) & 1) * 4 + 3]}; \
      bf16x8 pf = __builtin_bit_cast(bf16x8, pw_); \
      _Pragma("unroll") for (int t = 0; t < 4; ++t) O[t] = __builtin_amdgcn_mfma_f32_32x32x16_bf16(VF[t], pf, O[t], 0, 0, 0); }
#define A2_TILE(BUF, KT) { \
    const unsigned char* vim = shm + (BUF) * 24576 + 8192; const unsigned char* kimn = shm + (((BUF) + 1) & 3) * 24576; \
      \
      \
    const float negm = ((KT) == 0) ? 0.f : -m; \
    f32x16 S[2]; \
    _Pragma("unroll") for (int T = 0; T < 2; ++T) { \
      _Pragma("unroll") for (int r = 0; r < 16; ++r) S[T][r] = negm; \
      _Pragma("unroll") for (int s = 0; s < 4; ++s) S[T] = __builtin_amdgcn_mfma_f32_32x32x16_bf16(kf[T][s], qf[s], S[T], 0, 0, 0); } \
    bf16x8 vfa[4], vfb[4]; \
    _Pragma("unroll") for (int t = 0; t < 4; ++t) vfa[t] = A2_VFRAG(vim, t, 0); \
    __builtin_amdgcn_sched_barrier(0); \
    if ((KT) * 64 + 63 > q0) {     \
      _Pragma("unroll") for (int T = 0; T < 2; ++T) _Pragma("unroll") for (int r = 0; r < 16; ++r) { \
        int key = (KT) * 64 + 32 * T + 8 * (r >> 2) + 4 * hh + (r & 3); if (key > q0 + q) S[T][r] = -INFINITY; } } \
    float mx = -INFINITY; \
    _Pragma("unroll") for (int T = 0; T < 2; ++T) _Pragma("unroll") for (int r = 0; r < 16; ++r) mx = fmaxf(mx, S[T][r]); \
    mx = fmaxf(mx, __shfl_xor(mx, 32)); \
    if ((KT) == 0) {               \
      m = mx; \
      _Pragma("unroll") for (int T = 0; T < 2; ++T) _Pragma("unroll") for (int r = 0; r < 16; ++r) S[T][r] -= mx; \
    } else if (__any(mx > 6.0f)) {     \
      const float d = fmaxf(mx, 0.f); \
      const float alpha = __builtin_amdgcn_exp2f(-d); \
      m += d; l *= alpha; \
      _Pragma("unroll") for (int t = 0; t < 4; ++t) _Pragma("unroll") for (int r = 0; r < 16; ++r) O[t][r] *= alpha; \
      _Pragma("unroll") for (int T = 0; T < 2; ++T) _Pragma("unroll") for (int r = 0; r < 16; ++r) S[T][r] -= d; } \
    float ps = 0.f; \
    uint32_t pk[2][8]; \
    A2_EXPQ(0); \
    __builtin_amdgcn_sched_barrier(0); \
    _Pragma("unroll") for (int t = 0; t < 4; ++t) vfb[t] = A2_VFRAG(vim, t, 1); \
    kf[0][0] = A2_KFRAG(kimn, 0, 0); kf[0][1] = A2_KFRAG(kimn, 0, 1); \
    A2_EXPQ(1); A2_PV(vfa, 0); \
    __builtin_amdgcn_sched_barrier(0); \
    _Pragma("unroll") for (int t = 0; t < 4; ++t) vfa[t] = A2_VFRAG(vim, t, 2); \
    kf[0][2] = A2_KFRAG(kimn, 0, 2); kf[0][3] = A2_KFRAG(kimn, 0, 3); \
    A2_EXPQ(2); A2_PV(vfb, 1); \
    __builtin_amdgcn_sched_barrier(0); \
    _Pragma("unroll") for (int t = 0; t < 4; ++t) vfb[t] = A2_VFRAG(vim, t, 3); \
    kf[1][0] = A2_KFRAG(kimn, 1, 0); kf[1][1] = A2_KFRAG(kimn, 1, 1); \
    A2_EXPQ(3); A2_PV(vfa, 2); \
    __builtin_amdgcn_sched_barrier(0); \
    kf[1][2] = A2_KFRAG(kimn, 1, 2); kf[1][3] = A2_KFRAG(kimn, 1, 3); \
    A2_PV(vfb, 3); \
    __builtin_amdgcn_sched_barrier(0); \
    l += ps; }
  __syncthreads();
  A2_STAGE(0, 0);
  A2_STAGE(1, 1);
  A2_STAGE(2, 2);
  asm volatile("s_waitcnt vmcnt(3)" ::: "memory");
  asm volatile("s_waitcnt lgkmcnt(0)" ::: "memory");
  __builtin_amdgcn_s_barrier();
  {
    bf16x8 kf[2][4];
#pragma unroll
    for (int T = 0; T < 2; ++T)
#pragma unroll
      for (int s = 0; s < 4; ++s) kf[T][s] = A2_KFRAG(shm, T, s);
    int buf = 0;
    for (int kt = 0; kt < nkt; ++kt) {
      if (kt + 3 < nkt) A2_STAGE((buf + 3) & 3, kt + 3);
      A2_TILE(buf, kt);
      if (kt + 3 < nkt) asm volatile("s_waitcnt vmcnt(3)" ::: "memory"); else asm volatile("s_waitcnt vmcnt(0)" ::: "memory");
      asm volatile("s_waitcnt lgkmcnt(0)" ::: "memory");
      __builtin_amdgcn_s_barrier();
      buf = (buf + 1) & 3;
    }
  }
#undef A2_KFRAG
#undef A2_VFRAG
#undef A2_EXPQ
#undef A2_PV
#undef A2_STAGE
#undef A2_TILE
  const float inv = 1.f / (l + __shfl_xor(l, 32));
  float* urow = u1 + qrow * 1024 + h * 128;
  if (c == 0) {
#pragma unroll
    for (int t = 0; t < 4; ++t)
#pragma unroll
      for (int g = 0; g < 4; ++g) {
        const int dv = 32 * t + 8 * g + 4 * hh;
        *(f32x4*)(urow + dv) = (f32x4){O[t][4 * g] * inv, O[t][4 * g + 1] * inv, O[t][4 * g + 2] * inv, O[t][4 * g + 3] * inv};
      }
    return;
  }
  float s1 = 0.f, s2 = 0.f;
  for (int j = 0; j < 64; ++j) { s1 += a.lq1[j] * a.lk1[j]; s2 += a.lq2[j] * a.lk2[j]; }
  const float lam = expf(s1) - expf(s2) + a.lam_init;
  const float c1 = lam * inv;
  float ss = 0.f;
#pragma unroll
  for (int t = 0; t < 4; ++t)
#pragma unroll
    for (int g = 0; g < 4; ++g) {
      const int dv = 32 * t + 8 * g + 4 * hh;
      f32x4 u4 = *(const f32x4*)(urow + dv);
#pragma unroll
      for (int i = 0; i < 4; ++i) { float o = u4[i] - c1 * O[t][4 * g + i]; O[t][4 * g + i] = o; ss += o * o; }
    }
  ss += __shfl_xor(ss, 32);
  const float rn = rsqrtf(ss * (1.f / 128.f) + 1e-5f) * (1.f - a.lam_init);
  u16* orow = a.O + qrow * a.ldo + a.ocol0 + h * 128;
#pragma unroll
  for (int t = 0; t < 4; ++t)
#pragma unroll
    for (int g = 0; g < 4; ++g) {
      const int dv = 32 * t + 8 * g + 4 * hh;
      f32x4 w4 = *(const f32x4*)(a.subw + dv);
      uint2 ov;
      ov.x = pack2(O[t][4 * g + 0] * rn * w4[0], O[t][4 * g + 1] * rn * w4[1]);
      ov.y = pack2(O[t][4 * g + 2] * rn * w4[2], O[t][4 * g + 3] * rn * w4[3]);
      *(uint2*)(orow + dv) = ov;
    }
}

__device__ __forceinline__ uint32_t fkey(float f) {
  uint32_t u = __float_as_uint(f);
  return (u & 0x80000000u) ? ~u : (u | 0x80000000u);
}
template <int E>
__device__ __forceinline__ void top16_select(const uint32_t (&key)[E], bool (&sel)[E], int lane) {
  uint32_t prefix = 0;
  int k = 16, R = 64 * E, b = 31;
  for (; b >= 0; --b) {
    uint32_t cand = prefix | (1u << b);
    int cnt = 0;
#pragma unroll
    for (int e = 0; e < E; ++e) cnt += __popcll(__ballot((key[e] >> b) == (cand >> b)));
    if (cnt >= k) { prefix = cand; R = cnt; } else { k -= cnt; R -= cnt; }
    if (R == k) break;
  }
  if (R == k) {
    int bb = b < 0 ? 0 : b;
#pragma unroll
    for (int e = 0; e < E; ++e) sel[e] = (key[e] >> bb) >= (prefix >> bb);
    return;
  }
  int taken = 0;
  uint64_t lt = (lane == 0) ? 0ull : (~0ull >> (64 - lane));
#pragma unroll
  for (int e = 0; e < E; ++e) {
    bool eq = key[e] == prefix;
    uint64_t bm = __ballot(eq);
    int rank = taken + __popcll(bm & lt);
    sel[e] = (key[e] > prefix) || (eq && rank < k);
    taken += __popcll(bm);
  }
}
template <int CTRL>
__device__ __forceinline__ uint32_t dpp_u(uint32_t x) { return (uint32_t)__builtin_amdgcn_update_dpp(0, (int)x, CTRL, 0xf, 0xf, true); }
__device__ __forceinline__ uint32_t wave_max_u32(uint32_t x) {
  x = max(x, dpp_u<0xB1>(x));
  x = max(x, dpp_u<0x4E>(x));
  x = max(x, dpp_u<0x141>(x));
  x = max(x, dpp_u<0x140>(x));
  const uint32_t r0 = (uint32_t)__builtin_amdgcn_readlane((int)x, 0), r1 = (uint32_t)__builtin_amdgcn_readlane((int)x, 16);
  const uint32_t r2 = (uint32_t)__builtin_amdgcn_readlane((int)x, 32), r3 = (uint32_t)__builtin_amdgcn_readlane((int)x, 48);
  return max(max(r0, r1), max(r2, r3));
}
template <int NCH, int E>
__device__ __forceinline__ void top16_select_n(const uint32_t (&key)[NCH][E], bool (&sel)[NCH][E], int lane) {
  uint32_t prefix[NCH];
  int cntp[NCH];
#pragma unroll
  for (int c = 0; c < NCH; ++c) {
    uint32_t m = key[c][0];
#pragma unroll
    for (int e = 1; e < E; ++e) m = max(m, key[c][e]);
    prefix[c] = wave_max_u32(m) & 0xFF800000u;
    cntp[c] = 0;
  }
  int need = NCH;
  for (int j = 0; j < 6 && need != 0; ++j) {
    need = 0;
#pragma unroll
    for (int c = 0; c < NCH; ++c) {
      if (cntp[c] < 16) {
        if (j != 0) prefix[c] = prefix[c] >= 0x00800000u ? prefix[c] - 0x00800000u : 0u;
        int cnt = 0;
#pragma unroll
        for (int e = 0; e < E; ++e) cnt += __popcll(__ballot(key[c][e] >= prefix[c]));
        cntp[c] = cnt;
        need += (cnt < 16);
      }
    }
  }
  uint32_t startbit = 0x00400000u;
  if (need != 0) {
#pragma unroll
    for (int c = 0; c < NCH; ++c) { prefix[c] = 0; cntp[c] = 64 * E; }
    startbit = 0x80000000u;
  }
  int tot0 = 0;
#pragma unroll
  for (int c = 0; c < NCH; ++c) tot0 += cntp[c];
  if (tot0 != 16 * NCH)
  for (uint32_t bit = startbit; bit != 0u; bit >>= 1) {
    int tot = 0;
#pragma unroll
    for (int c = 0; c < NCH; ++c) {
      const uint32_t cand = prefix[c] | bit;
      int cnt = 0;
#pragma unroll
      for (int e = 0; e < E; ++e) cnt += __popcll(__ballot(key[c][e] >= cand));
      const bool up = cnt >= 16;
      prefix[c] = up ? cand : prefix[c];
      cntp[c] = up ? cnt : cntp[c];
      tot += cntp[c];
    }
    if (tot == 16 * NCH) break;
  }
  const uint64_t lt = (lane == 0) ? 0ull : (~0ull >> (64 - lane));
#pragma unroll
  for (int c = 0; c < NCH; ++c) {
    if (cntp[c] == 16) {
#pragma unroll
      for (int e = 0; e < E; ++e) sel[c][e] = key[c][e] >= prefix[c];
    } else {
      int ngt = 0;
#pragma unroll
      for (int e = 0; e < E; ++e) ngt += __popcll(__ballot(key[c][e] > prefix[c]));
      const int kk = 16 - ngt;
      int taken = 0;
#pragma unroll
      for (int e = 0; e < E; ++e) {
        bool eq = key[c][e] == prefix[c];
        uint64_t bm = __ballot(eq);
        sel[c][e] = (key[c][e] > prefix[c]) || (eq && taken + __popcll(bm & lt) < kk);
        taken += __popcll(bm);
      }
    }
  }
}
__device__ __forceinline__ void d_peer_topk(const float* __restrict__ scores, int* __restrict__ experts, float* __restrict__ gates, const int bid0, const int nb0, unsigned char* smem) {
  const int bid = sfresh(bid0), nb = sfresh(nb0);
  const int tidf = tid_fresh();
  int lane = tidf & 63, wave = tidf >> 6;
  float (*sv)[2][16] = (float (*)[2][16])(smem + wave * 512);
  int (*si)[2][16] = (int (*)[2][16])(smem + NWV * 512 + wave * 512);
  const uint64_t lt = (lane == 0) ? 0ull : (~0ull >> (64 - lane));
  for (int it0 = (bid * NWV + wave) * 2; it0 < NTOK * 8; it0 += nb * NWV * 2) {
    float s[4][2]; uint32_t key[4][2]; bool sel[4][2];
#pragma unroll
    for (int u = 0; u < 2; ++u) {
      const int it = it0 + u, t = it >> 3, h = it & 7;
      const float* sp = scores + (size_t)t * 2048 + h * 256;
#pragma unroll
      for (int c = 0; c < 2; ++c) { s[u * 2 + c][0] = sp[c * 128 + lane]; s[u * 2 + c][1] = sp[c * 128 + 64 + lane]; }
    }
#pragma unroll
    for (int c = 0; c < 4; ++c) { key[c][0] = fkey(s[c][0]); key[c][1] = fkey(s[c][1]); }
    top16_select_n<4, 2>(key, sel, lane);
#pragma unroll
    for (int c = 0; c < 4; ++c) {
      int base = 0;
#pragma unroll
      for (int e = 0; e < 2; ++e) {
        uint64_t bm = __ballot(sel[c][e]);
        if (sel[c][e]) { int p = base + __popcll(bm & lt); sv[c >> 1][c & 1][p] = s[c][e]; si[c >> 1][c & 1][p] = lane + 64 * e; }
        base += __popcll(bm);
      }
    }
    __builtin_amdgcn_wave_barrier();
    __threadfence_block();
    float cv[2][4]; uint32_t ck[2][4]; bool csel[2][4];
#pragma unroll
    for (int u = 0; u < 2; ++u)
#pragma unroll
      for (int e = 0; e < 4; ++e) {
        int ci = e * 64 + lane;
        cv[u][e] = sv[u][0][ci >> 4] + sv[u][1][ci & 15];
        ck[u][e] = fkey(cv[u][e]);
      }
    top16_select_n<2, 4>(ck, csel, lane);
#pragma unroll
    for (int u = 0; u < 2; ++u) {
      const int it = it0 + u, t = it >> 3, h = it & 7;
      float mx = -INFINITY;
#pragma unroll
      for (int e = 0; e < 4; ++e) if (csel[u][e]) mx = fmaxf(mx, cv[u][e]);
      mx = wave_max(mx);
      float ex[4], sum = 0.f;
#pragma unroll
      for (int e = 0; e < 4; ++e) { ex[e] = csel[u][e] ? expf(cv[u][e] - mx) : 0.f; sum += ex[e]; }
      sum = wave_sum(sum);
      float rinv = 1.f / sum;
      int base = 0;
#pragma unroll
      for (int e = 0; e < 4; ++e) {
        uint64_t bm = __ballot(csel[u][e]);
        if (csel[u][e]) {
          int p = base + __popcll(bm & lt);
          int ci = e * 64 + lane;
          experts[(size_t)t * 128 + h * 16 + p] = si[u][0][ci >> 4] * 128 + si[u][1][ci & 15];
          gates[(size_t)t * 128 + h * 16 + p] = ex[e] * rinv;
        }
        base += __popcll(bm);
      }
    }
    __builtin_amdgcn_wave_barrier();
    __threadfence_block();
  }
}

typedef __attribute__((ext_vector_type(8))) int i32x8;
typedef __attribute__((ext_vector_type(4))) int i32x4;
__device__ __forceinline__ void d_cvt_fp8(const float* __restrict__ src, unsigned char* __restrict__ dst, float* __restrict__ sinv, int rows,
                                          const int bid0, const int nb0, unsigned char* smem) {
  const int bid = sfresh(bid0), nb = sfresh(nb0);
  const int tidf = tid_fresh();
  const int lane = tidf & 63, wave = tidf >> 6;
  for (int row = bid * NWV + wave; row < rows; row += nb * NWV) {
    const f32x4* p = (const f32x4*)(src + (size_t)row * D_MODEL);
    f32x4 v[8];
    float amax = 0.f;
#pragma unroll
    for (int q = 0; q < 2; ++q)
#pragma unroll
      for (int k = 0; k < 4; ++k) {
        v[q * 4 + k] = p[q * 256 + lane * 4 + k];
#pragma unroll
        for (int j = 0; j < 4; ++j) amax = fmaxf(amax, fabsf(v[q * 4 + k][j]));
      }
    amax = wave_max(amax);
    float scale = 1.f, inv = 1.f;
    if (amax > 0.f) {
      int e = 134 - (int)((__float_as_uint(amax) >> 23) & 0xff);
      e = e > 120 ? 120 : (e < -120 ? -120 : e);
      scale = __uint_as_float((uint32_t)(e + 127) << 23);
      inv = __uint_as_float((uint32_t)(127 - e) << 23);
    }
#pragma unroll
    for (int q = 0; q < 2; ++q) {
      u32x4 o;
#pragma unroll
      for (int k = 0; k < 4; ++k) {
        int w = 0;
        w = __builtin_amdgcn_cvt_pk_fp8_f32(v[q * 4 + k][0] * scale, v[q * 4 + k][1] * scale, w, false);
        w = __builtin_amdgcn_cvt_pk_fp8_f32(v[q * 4 + k][2] * scale, v[q * 4 + k][3] * scale, w, true);
        o[k] = (unsigned)w;
      }
      *(u32x4*)(dst + (size_t)row * D_MODEL + q * 1024 + lane * 16) = o;
    }
    if (lane == 0) sinv[row] = inv;
  }
}

template <bool NATURAL>
__device__ __forceinline__ void d_cvt_fp4(const float* __restrict__ src, unsigned char* __restrict__ dst, float* __restrict__ sinv, int rows,
                                          const int bid0, const int nb0, unsigned char* smem) {
  const int bid = sfresh(bid0), nb = sfresh(nb0);
  const int tidf = tid_fresh();
  const int lane = tidf & 63, wave = tidf >> 6;
  for (int row = bid * NWV + wave; row < rows; row += nb * NWV) {
    const f32x4* p = (const f32x4*)(src + (size_t)row * D_MODEL);
    f32x4 v[8];
    float amax = 0.f;
#pragma unroll
    for (int q = 0; q < 2; ++q)
#pragma unroll
      for (int k = 0; k < 4; ++k) {
        v[q * 4 + k] = p[q * 256 + lane * 4 + k];
#pragma unroll
        for (int j = 0; j < 4; ++j) amax = fmaxf(amax, fabsf(v[q * 4 + k][j]));
      }
    amax = wave_max(amax);
    float scale = 1.f, inv = 1.f;
    if (amax > 0.f) { scale = 6.0f / amax; inv = amax * (1.0f / 6.0f); }
    u32x4 o;
#pragma unroll
    for (int k = 0; k < 4; ++k) {
      unsigned w = 0u;
      w = __builtin_amdgcn_cvt_scalef32_pk_fp4_f32(w, v[2 * k][0] * scale, v[2 * k][1] * scale, 1.0f, 0);
      w = __builtin_amdgcn_cvt_scalef32_pk_fp4_f32(w, v[2 * k][2] * scale, v[2 * k][3] * scale, 1.0f, 1);
      w = __builtin_amdgcn_cvt_scalef32_pk_fp4_f32(w, v[2 * k + 1][0] * scale, v[2 * k + 1][1] * scale, 1.0f, 2);
      w = __builtin_amdgcn_cvt_scalef32_pk_fp4_f32(w, v[2 * k + 1][2] * scale, v[2 * k + 1][3] * scale, 1.0f, 3);
      o[k] = w;
    }
    if (NATURAL) {
      uint2 lo; lo.x = o[0]; lo.y = o[1];
      uint2 hi; hi.x = o[2]; hi.y = o[3];
      *(uint2*)(dst + (size_t)row * (D_MODEL / 2) + lane * 8) = lo;
      *(uint2*)(dst + (size_t)row * (D_MODEL / 2) + 512 + lane * 8) = hi;
    } else {
      *(u32x4*)(dst + (size_t)row * (D_MODEL / 2) + lane * 16) = o;
    }
    if (lane == 0) sinv[row] = inv;
  }
}

struct PeerArgs {
  const float* x;
  const u16* xb;
  const float* scores;
  const unsigned char* U; const unsigned char* V;
  const float* usinv; const float* vsinv;
  const float* lnw; const float* lnb;
  float* outf; u16* outb; int exmask;
};
__device__ __forceinline__ float wave_total(float x) {
  x = row16_sum(x);
  float r0 = __int_as_float(__builtin_amdgcn_readlane(__float_as_int(x), 0));
  float r1 = __int_as_float(__builtin_amdgcn_readlane(__float_as_int(x), 16));
  float r2 = __int_as_float(__builtin_amdgcn_readlane(__float_as_int(x), 32));
  float r3 = __int_as_float(__builtin_amdgcn_readlane(__float_as_int(x), 48));
  return (r0 + r1) + (r2 + r3);
}
__device__ __forceinline__ float erf_as(float x) {
  const float ax = fabsf(x);
  const float t = __builtin_amdgcn_rcpf(fmaf(0.3275911f, ax, 1.0f));
  float p = fmaf(1.061405429f, t, -1.453152027f);
  p = fmaf(p, t, 1.421413741f);
  p = fmaf(p, t, -0.284496736f);
  p = fmaf(p, t, 0.254829592f);
  p *= t;
  const float e = __builtin_amdgcn_exp2f(-1.4426950408889634f * ax * ax);
  const float r = fmaf(-p, e, 1.0f);
  return copysignf(r, x);
}
__device__ __forceinline__ void peer_vhalf(f32x2& a0, f32x2& a1, f32x2& a2, f32x2& a3, f32x2& a4, f32x2& a5, f32x2& a6, f32x2& a7,
                                           unsigned w0, unsigned w1, uint64_t acs) {
  f32x2 t0, t1, t2, t3;
  asm("v_cvt_scalef32_pk_f32_fp4 %8, %12, 1.0\n\t"
      "v_cvt_scalef32_pk_f32_fp4 %9, %12, 1.0 op_sel:[1,0,0]\n\t"
      "v_cvt_scalef32_pk_f32_fp4 %10, %12, 1.0 op_sel:[0,1,0]\n\t"
      "v_cvt_scalef32_pk_f32_fp4 %11, %12, 1.0 op_sel:[1,1,0]\n\t"
      "v_pk_fma_f32 %0, %14, %8, %0 op_sel_hi:[0,1,1]\n\t"
      "v_pk_fma_f32 %1, %14, %9, %1 op_sel_hi:[0,1,1]\n\t"
      "v_pk_fma_f32 %2, %14, %10, %2 op_sel_hi:[0,1,1]\n\t"
      "v_pk_fma_f32 %3, %14, %11, %3 op_sel_hi:[0,1,1]\n\t"
      "v_cvt_scalef32_pk_f32_fp4 %8, %13, 1.0\n\t"
      "v_cvt_scalef32_pk_f32_fp4 %9, %13, 1.0 op_sel:[1,0,0]\n\t"
      "v_cvt_scalef32_pk_f32_fp4 %10, %13, 1.0 op_sel:[0,1,0]\n\t"
      "v_cvt_scalef32_pk_f32_fp4 %11, %13, 1.0 op_sel:[1,1,0]\n\t"
      "v_pk_fma_f32 %4, %14, %8, %4 op_sel_hi:[0,1,1]\n\t"
      "v_pk_fma_f32 %5, %14, %9, %5 op_sel_hi:[0,1,1]\n\t"
      "v_pk_fma_f32 %6, %14, %10, %6 op_sel_hi:[0,1,1]\n\t"
      "v_pk_fma_f32 %7, %14, %11, %7 op_sel_hi:[0,1,1]"
      : "+v"(a0), "+v"(a1), "+v"(a2), "+v"(a3), "+v"(a4), "+v"(a5), "+v"(a6), "+v"(a7), "=&v"(t0), "=&v"(t1), "=&v"(t2), "=&v"(t3)
      : "v"(w0), "v"(w1), "s"(acs));
}
__device__ __forceinline__ float wave_max_total(float x) {
  x = row16_max(x);
  float r0 = __int_as_float(__builtin_amdgcn_readlane(__float_as_int(x), 0));
  float r1 = __int_as_float(__builtin_amdgcn_readlane(__float_as_int(x), 16));
  float r2 = __int_as_float(__builtin_amdgcn_readlane(__float_as_int(x), 32));
  float r3 = __int_as_float(__builtin_amdgcn_readlane(__float_as_int(x), 48));
  return fmaxf(fmaxf(r0, r1), fmaxf(r2, r3));
}
#define PEER_G 8
__device__ __forceinline__ void peer_route(const float (&s)[2][2], float* rsv, int* rsi, int* rex, float* rgt, const int lane, const uint64_t ltm, const int exmask = -1) {
  __builtin_amdgcn_wave_barrier();
  uint32_t key[2][2]; bool sel[2][2];
#pragma unroll
  for (int c = 0; c < 2; ++c) { key[c][0] = fkey(s[c][0]); key[c][1] = fkey(s[c][1]); }
  top16_select_n<2, 2>(key, sel, lane);
#pragma unroll
  for (int c = 0; c < 2; ++c) {
    int base = 0;
#pragma unroll
    for (int e = 0; e < 2; ++e) {
      uint64_t bm = __ballot(sel[c][e]);
      if (sel[c][e]) { int p = base + __popcll(bm & ltm); rsv[c * 16 + p] = s[c][e]; rsi[c * 16 + p] = lane + 64 * e; }
      base += __popcll(bm);
    }
  }
  __builtin_amdgcn_wave_barrier();
  __threadfence_block();
  float cv[1][4]; uint32_t ck[1][4]; bool csel[1][4];
#pragma unroll
  for (int e = 0; e < 4; ++e) { int ci = e * 64 + lane; cv[0][e] = rsv[ci >> 4] + rsv[16 + (ci & 15)]; ck[0][e] = fkey(cv[0][e]); }
  top16_select_n<1, 4>(ck, csel, lane);
  int exid[4];
#pragma unroll
  for (int e = 0; e < 4; ++e) { int ci = e * 64 + lane; exid[e] = (rsi[ci >> 4] * 128 + rsi[16 + (ci & 15)]) & exmask; }
  float mx = -INFINITY;
#pragma unroll
  for (int e = 0; e < 4; ++e) if (csel[0][e]) mx = fmaxf(mx, cv[0][e]);
  mx = wave_max_total(mx);
  float exv[4], sum = 0.f;
#pragma unroll
  for (int e = 0; e < 4; ++e) { exv[e] = csel[0][e] ? __expf(cv[0][e] - mx) : 0.f; sum += exv[e]; }
  sum = wave_total(sum);
  const float rinv = __builtin_amdgcn_rcpf(sum);
  int base = 0;
#pragma unroll
  for (int e = 0; e < 4; ++e) {
    uint64_t bm = __ballot(csel[0][e]);
    if (csel[0][e]) { int p = base + __popcll(bm & ltm); rex[p] = exid[e]; rgt[p] = exv[e] * rinv; }
    base += __popcll(bm);
  }
  __builtin_amdgcn_wave_barrier();
  __threadfence_block();
}

__device__ __forceinline__ void d_peer(PeerArgs a, const int bid0, const int nb0, unsigned char* smem) {
  const int bid = sfresh(bid0), nb = sfresh(nb0);
  const int tidf = tid_fresh();
  float (*sAcc)[D_MODEL] = (float (*)[D_MODEL])smem;
  float* sRed = (float*)(smem + NWV * D_MODEL * 4);
  const int tid = tidf, lane = tid & 63, wave = tid >> 6;
  float* rsv = (float*)(smem + NWV * D_MODEL * 4 + 256 + wave * 512);
  int* rsi = (int*)(rsv + 32);
  int* rexb = rsi + 32;
  float* rgtb = (float*)(rexb + 32);
  int* sX8b = (int*)(smem + NWV * D_MODEL * 4 + 256 + NWV * 512);
  const uint64_t ltm = (lane == 0) ? 0ull : (~0ull >> (64 - lane));
  const int er = lane & 15, g4 = lane >> 4;
  if (bid >= NTOK) return;

  int t = bid;
  f32x4 xcur = *(const f32x4*)(a.x + (size_t)t * D_MODEL + tid * 4);
  float sc[2][2];
  {
    const float* sp = a.scores + (size_t)t * 2048 + wave * 256;
#pragma unroll
    for (int c = 0; c < 2; ++c) { sc[c][0] = sp[c * 128 + lane]; sc[c][1] = sp[c * 128 + 64 + lane]; }
  }
  peer_route(sc, rsv, rsi, rexb, rgtb, lane, ltm, a.exmask);
  {
    int w = 0;
    w = __builtin_amdgcn_cvt_pk_fp8_f32(xcur[0], xcur[1], w, false);
    w = __builtin_amdgcn_cvt_pk_fp8_f32(xcur[2], xcur[3], w, true);
    sX8b[tid] = w;
  }
  i32x4 uu[16]; u32x4 vv[16]; f32x4 us4, vs4;
  {
    const unsigned char* up = a.U + (size_t)rexb[er] * (D_MODEL / 2) + g4 * 16;
#pragma unroll
    for (int s = 0; s < 16; ++s) uu[s] = *(const i32x4*)(up + s * 64);
#pragma unroll
    for (int e = 0; e < 16; ++e) vv[e] = *(const u32x4*)(a.V + (size_t)rexb[e] * (D_MODEL / 2) + lane * 16);
    const i32x4 ex4 = *(const i32x4*)(rexb + g4 * 4);
#pragma unroll
    for (int r = 0; r < 4; ++r) { us4[r] = a.usinv[ex4[r]]; vs4[r] = a.vsinv[ex4[r]]; }
  }
  int tn = (t + nb < NTOK) ? t + nb : t;
  f32x4 xnext = *(const f32x4*)(a.x + (size_t)tn * D_MODEL + tid * 4);
  {
    const float* sp = a.scores + (size_t)tn * 2048 + wave * 256;
#pragma unroll
    for (int c = 0; c < 2; ++c) { sc[c][0] = sp[c * 128 + lane]; sc[c][1] = sp[c * 128 + 64 + lane]; }
  }
  __syncthreads();
  int cur = 0;
  for (; t < NTOK; t += nb, cur ^= 1) {
    tn = (t + nb < NTOK) ? t + nb : t;
    const int tnn = (tn + nb < NTOK) ? tn + nb : tn;
    int* rexc = rexb + cur * 16; float* rgtc = rgtb + cur * 16;
    int* rexn = rexb + (cur ^ 1) * 16; float* rgtn = rgtb + (cur ^ 1) * 16;
    peer_route(sc, rsv, rsi, rexn, rgtn, lane, ltm, a.exmask);
    {
      int w = 0;
      w = __builtin_amdgcn_cvt_pk_fp8_f32(xnext[0], xnext[1], w, false);
      w = __builtin_amdgcn_cvt_pk_fp8_f32(xnext[2], xnext[3], w, true);
      sX8b[(cur ^ 1) * 512 + tid] = w;
    }
    {
      const float* sp = a.scores + (size_t)tnn * 2048 + wave * 256;
#pragma unroll
      for (int c = 0; c < 2; ++c) { sc[c][0] = sp[c * 128 + lane]; sc[c][1] = sp[c * 128 + 64 + lane]; }
    }
    f32x4 acv;
    {
      const f32x4 gt4 = *(const f32x4*)(rgtc + g4 * 4);
      f32x4 c0 = (f32x4){0.f, 0.f, 0.f, 0.f}, c1 = c0;
      const i32x4* xp = (const i32x4*)((const unsigned char*)(sX8b + cur * 512) + g4 * 16);
      i32x4 bq[2][4];
#define PB_LOAD(G, S0) { bq[G][0] = xp[(S0) * 8]; bq[G][1] = xp[(S0) * 8 + 4]; bq[G][2] = xp[((S0) + 1) * 8]; bq[G][3] = xp[((S0) + 1) * 8 + 4]; }
#define PB_MMA(G, S0) { \
        { const i32x8 av = (i32x8){uu[S0][0], uu[S0][1], uu[S0][2], uu[S0][3], 0, 0, 0, 0}; \
          const i32x8 bv = (i32x8){bq[G][0][0], bq[G][0][1], bq[G][0][2], bq[G][0][3], bq[G][1][0], bq[G][1][1], bq[G][1][2], bq[G][1][3]}; \
          c0 = __builtin_amdgcn_mfma_scale_f32_16x16x128_f8f6f4(av, bv, c0, 4, 0, 0, 0x7f7f7f7f, 0, 0x7f7f7f7f); } \
        { const i32x8 av = (i32x8){uu[(S0) + 1][0], uu[(S0) + 1][1], uu[(S0) + 1][2], uu[(S0) + 1][3], 0, 0, 0, 0}; \
          const i32x8 bv = (i32x8){bq[G][2][0], bq[G][2][1], bq[G][2][2], bq[G][2][3], bq[G][3][0], bq[G][3][1], bq[G][3][2], bq[G][3][3]}; \
          c1 = __builtin_amdgcn_mfma_scale_f32_16x16x128_f8f6f4(av, bv, c1, 4, 0, 0, 0x7f7f7f7f, 0, 0x7f7f7f7f); } }
      PB_LOAD(0, 0);
      __builtin_amdgcn_sched_barrier(0);
#pragma unroll
      for (int s = 0; s < 16; s += 4) {
        PB_LOAD(1, s + 2);
        PB_MMA(0, s);
        __builtin_amdgcn_sched_barrier(0);
        if (s + 4 < 16) PB_LOAD(0, s + 4);
        PB_MMA(1, s + 2);
        __builtin_amdgcn_sched_barrier(0);
      }
#undef PB_LOAD
#undef PB_MMA
#pragma unroll
      for (int r = 0; r < 4; ++r) {
        float h = (c0[r] + c1[r]) * us4[r];
        acv[r] = 0.5f * h * (1.f + erf_as(h * 0.70710678118654752f)) * gt4[r] * vs4[r];
      }
    }
    f32x2 acc[16];
#pragma unroll
    for (int i = 0; i < 16; ++i) acc[i] = (f32x2){0.f, 0.f};
    {
      __builtin_amdgcn_sched_barrier(0);
      const unsigned char* up = a.U + (size_t)rexn[er] * (D_MODEL / 2) + g4 * 16;
#pragma unroll
      for (int s = 0; s < 16; ++s) uu[s] = *(const i32x4*)(up + s * 64);
      const i32x4 ex4 = *(const i32x4*)(rexn + g4 * 4);
#pragma unroll
      for (int r = 0; r < 4; ++r) { us4[r] = a.usinv[ex4[r]]; vs4[r] = a.vsinv[ex4[r]]; }
      __builtin_amdgcn_sched_barrier(0);
    }
    int exn = rexn[0];
#pragma unroll
    for (int e = 0; e < 16; ++e) {
      const uint64_t acs = (uint64_t)(uint32_t)__builtin_amdgcn_readlane(__float_as_int(acv[e & 3]), 16 * (e >> 2));
      const u32x4 vw = vv[e];
      peer_vhalf(acc[0], acc[1], acc[2], acc[3], acc[4], acc[5], acc[6], acc[7], vw[0], vw[1], acs);
      peer_vhalf(acc[8], acc[9], acc[10], acc[11], acc[12], acc[13], acc[14], acc[15], vw[2], vw[3], acs);
      const uint32_t voff = (uint32_t)exn * (D_MODEL / 2) + (uint32_t)lane * 16u;
      if (e + 1 < 16) exn = rexn[e + 1];
      vv[e] = *(const u32x4*)(a.V + voff);
      __builtin_amdgcn_sched_barrier(0);
    }
#pragma unroll
    for (int q = 0; q < 2; ++q)
#pragma unroll
      for (int k = 0; k < 4; ++k)
        *(f32x4*)(&sAcc[wave][q * 1024 + lane * 16 + k * 4]) = (f32x4){acc[q * 8 + k * 2][0], acc[q * 8 + k * 2][1], acc[q * 8 + k * 2 + 1][0], acc[q * 8 + k * 2 + 1][1]};
    const f32x4 lw4 = *(const f32x4*)(a.lnw + tid * 4), lb4 = *(const f32x4*)(a.lnb + tid * 4);
    __syncthreads();
    float pre[4];
#pragma unroll
    for (int j = 0; j < 4; ++j) {
      float acc8 = 0.f;
#pragma unroll
      for (int w = 0; w < NWV; ++w) acc8 += sAcc[w][tid * 4 + j];
      pre[j] = ALPHA * xcur[j] + acc8;
    }
    xcur = xnext;
    xnext = *(const f32x4*)(a.x + (size_t)tnn * D_MODEL + tid * 4);
    float s = (pre[0] + pre[1]) + (pre[2] + pre[3]);
    s = wave_total(s);
    if (lane == 0) sRed[wave] = s;
    __syncthreads();
    float mu = 0.f;
#pragma unroll
    for (int w = 0; w < NWV; ++w) mu += sRed[w];
    mu *= (1.f / D_MODEL);
    float q2 = 0.f;
#pragma unroll
    for (int j = 0; j < 4; ++j) { float d = pre[j] - mu; q2 += d * d; }
    q2 = wave_total(q2);
    if (lane == 0) sRed[NWV + wave] = q2;
    __syncthreads();
    float var = 0.f;
#pragma unroll
    for (int w = 0; w < NWV; ++w) var += sRed[NWV + w];
    float rs = rsqrtf(var * (1.f / D_MODEL) + 1e-5f);
    f32x4 o;
#pragma unroll
    for (int j = 0; j < 4; ++j) o[j] = (pre[j] - mu) * rs * lw4[j] + lb4[j];
    *(f32x4*)(a.outf + (size_t)t * D_MODEL + tid * 4) = o;
    if (a.outb) {
      uint2 ob; ob.x = pack2(o[0], o[1]); ob.y = pack2(o[2], o[3]);
      *(uint2*)(a.outb + (size_t)t * D_MODEL + tid * 4) = ob;
    }
  }
}

#define XB_TMO      128
#define XB_XCNT(j)  (256  + 64 * (j))
#define XB_XSUB(j)  (1280 + 64 * (j))
#define XB_XGEN(j)  (2304 + 64 * (j))
#define XB_TOP      3328
#define XB_TOPGEN   3392
#define XB_QUEUE(j) (3456 + 64 * (j))
#define XCD_BAR_WORDS 3712
#define XB_SPIN_CAP (1u << 22)
#define LAS __attribute__((address_space(3)))
__device__ __forceinline__ unsigned xb_ld(unsigned* p)              { return __hip_atomic_load(p, __ATOMIC_RELAXED, __HIP_MEMORY_SCOPE_AGENT); }
__device__ __forceinline__ unsigned xb_add(unsigned* p, unsigned v) { return __hip_atomic_fetch_add(p, v, __ATOMIC_RELAXED, __HIP_MEMORY_SCOPE_AGENT); }
__device__ __forceinline__ unsigned xb_xcc_id() { return (unsigned)__builtin_amdgcn_s_getreg((3 << 11) | 20) & 0xFu; }
#define XB_SPIN(cond, bar) do { unsigned _sp = 0; while (cond) { __builtin_amdgcn_s_sleep(1); \
    if ((++_sp & 255u) == 0u) { if (xb_ld(&(bar)[XB_TMO])) break; if (_sp > XB_SPIN_CAP) { atomicAdd(&(bar)[XB_TMO], 1u); break; } } } } while (0)
struct XcdBarrier { unsigned* bar; unsigned x; volatile LAS unsigned* st; };
__device__ __forceinline__ XcdBarrier xcd_barrier_post(unsigned* bar, volatile LAS unsigned* st) {
  XcdBarrier b; b.bar = bar; b.x = xb_xcc_id(); b.st = st;
  if (threadIdx.x == 0) (void)xb_add(&bar[XB_XCNT(b.x)], 1u);
  return b;
}
__device__ __forceinline__ void xcd_barrier_complete(unsigned* bar, unsigned x, unsigned& nloc, unsigned& nx) {
  const unsigned G = gridDim.x * gridDim.y * gridDim.z;
  unsigned sum, cnt, mine, sp = 0u;
  for (;;) {
    sum = 0u; cnt = 0u; mine = 0u;
#pragma unroll
    for (unsigned j = 0; j < 16; ++j) { const unsigned c = xb_ld(&bar[XB_XCNT(j)]); sum += c; cnt += (c > 0u) ? 1u : 0u; mine = (j == x) ? c : mine; }
    if (sum == G) break;
    __builtin_amdgcn_s_sleep(1);
    if ((++sp & 255u) == 0u) { if (xb_ld(&bar[XB_TMO])) break; if (sp > XB_SPIN_CAP) { atomicAdd(&bar[XB_TMO], 1u); break; } }
  }
  nloc = mine > 0u ? mine : 1u; nx = cnt > 0u ? cnt : 1u;
}
__device__ __forceinline__ void xcd_barrier(const XcdBarrier& b) {
  asm volatile("s_waitcnt vmcnt(0)" ::: "memory");
  __syncthreads();
  if (threadIdx.x == 0) {
    unsigned* bar = b.bar;
    __builtin_amdgcn_s_waitcnt(0);
    unsigned nloc = b.st[0], nx = b.st[1];
    if (nloc == 0u) { xcd_barrier_complete(bar, b.x, nloc, nx); b.st[0] = nloc; b.st[1] = nx; }
    const unsigned old = xb_add(&bar[XB_XSUB(b.x)], 1u);
    const unsigned gen = old / nloc;
    if (old + 1u == (gen + 1u) * nloc) {
      __builtin_amdgcn_fence(__ATOMIC_RELEASE, "agent");
      asm volatile("s_waitcnt vmcnt(0)" ::: "memory");
      const unsigned og = xb_add(&bar[XB_TOP], 1u);
      const unsigned tg = og / nx;
      if (og + 1u == (tg + 1u) * nx) xb_add(&bar[XB_TOPGEN], 1u);
      else XB_SPIN(xb_ld(&bar[XB_TOPGEN]) == tg, bar);
      __builtin_amdgcn_fence(__ATOMIC_ACQUIRE, "agent");
      xb_add(&bar[XB_XGEN(b.x)], 1u);
      asm volatile("s_waitcnt vmcnt(0)" ::: "memory");
    } else {
      XB_SPIN(xb_ld(&bar[XB_XGEN(b.x)]) == gen, bar);
      __builtin_amdgcn_fence(__ATOMIC_ACQUIRE, "agent");
      asm volatile("s_waitcnt vmcnt(0)" ::: "memory");
    }
  }
  __syncthreads();
}

struct MegaParams {
  const float* x_in; const float* mem; const int* positions; const float* w_in; const float* shift_mu; const float* w0; const float* w_up;
  const float* a0; const float* a_up; const float* g_up; const float* k_k; const float* k_a; const float* r_k; const float* lnx_w; const float* lnx_b;
  const float* lam_q1; const float* lam_k1; const float* lam_q2; const float* lam_k2; const float* subln_w; const float* w_out;
  const float* ln1_w; const float* ln1_b; const float* xq; const float* xk; const float* xv; const float* xo; const float* ln2_w; const float* ln2_b;
  const float* pq; const float* subkeys; const float* peer_u; const float* peer_v; const float* ln3_w; const float* ln3_b;
  float* out;
  float* X; float* lnstat; u16* xb; u16* memb; u16* WinT; u16* WoutT; u16* xqT; u16* xkT; u16* xvT; u16* xoT; u16* pqT; u16* loraT; u16* skb; u16* cat;
  float* ropetab; u16* Qb; u16* Kb; u16* Vt;
  float* proj; u16* lin; float* lw; float* la; float* gate; float* wrec; u16* prec; float* bon; float* yraw;
  float* qx0; float* qx1; u16* Kx; u16* Vxt; u16* ox;
  unsigned char* Ub; unsigned char* Vb; float* usinv; float* vsinv; u16* qp; float* scores; int* experts; float* gates;
  unsigned* bar;
};

__device__ __forceinline__ GemmArgs mk_gemm(const u16* A, int lda, const u16* Bt, int ldb, int M, int N, int K, float* Cf, u16* Cb, int ldc,
                                            const float* res = nullptr, float alpha = 0.f) {
  GemmArgs g;
  g.A = A; g.Bt = Bt; g.lda = lda; g.ldb = ldb; g.M = M; g.N = N; g.K = K; g.Cf = Cf; g.Cb = Cb; g.ldc = ldc; g.res = res; g.alpha = alpha;
  g.tab = nullptr; g.Cb2 = nullptr;
  return g;
}

template <typename T, unsigned OFF>
__device__ __forceinline__ T ldarg() {
  unsigned long long v;
  asm volatile("s_load_dwordx2 %0, %1, %2\n\ts_waitcnt lgkmcnt(0)" : "=s"(v) : "s"(__builtin_amdgcn_kernarg_segment_ptr()), "i"(OFF) : "memory");
  return (T)(__attribute__((address_space(1))) void*)v;
}
#define LP(field) ldarg<decltype(MegaParams::field), (unsigned)offsetof(MegaParams, field)>()
#ifndef REPEAT_MASK
#define REPEAT_MASK 0
#endif
#ifndef PROBE_EXMASK
#define PROBE_EXMASK -1
#endif
#define REP(bit) for (int rep_ = 0; rep_ < (((REPEAT_MASK) >> (bit)) & 1) + 1; ++rep_)
#define SMEM_BYTES 131072
__global__ __launch_bounds__(NT, 2) void mega(MegaParams p, int ph_lo, int ph_hi) {
  int ph = 0;
  __shared__ __attribute__((aligned(1024))) unsigned char smem_all[SMEM_BYTES + 16];
  unsigned char* smem = smem_all;
  volatile LAS unsigned* st = (volatile LAS unsigned*)(smem_all + SMEM_BYTES);
  const int bid = blockIdx.x, nb = gridDim.x;
  if (threadIdx.x < 4) st[threadIdx.x] = 0u;
  if (bid == 0 && ph_hi - ph_lo > 1) { unsigned* bw = LP(bar); for (int i = threadIdx.x; i < XCD_BAR_WORDS; i += NT) bw[i] = 0u; }
  __syncthreads();
  XcdBarrier xb_;
  const size_t T = NTOK;

  if (ph >= ph_lo && ph < ph_hi) {
  d_cvt(LP(x_in), LP(xb), T * 2048 / 8, bid, nb, smem);
  d_cvt(LP(mem), LP(memb), (size_t)BATCH * MEM_LEN * 2048 / 8, bid, nb, smem);
  d_rope_table(LP(positions), LP(ropetab), bid, nb, smem);
  }

  for (int l = 0; l < DEPTH; ++l) {
    const float* xres = (l == 0) ? LP(x_in) : LP(X);
    u16* wupT = LP(loraT); u16* aupT = LP(loraT) + 1024 * 64; u16* gupT = LP(loraT) + 2 * 1024 * 64;
    if (ph >= ph_lo && ph < ph_hi) {
    REP(6) {
    d_cvt_t(LP(w_in) + (size_t)l * 2048 * N_IN, LP(WinT), 2048, N_IN, 2048, bid, nb, smem);
    d_cvt_t(LP(w_out) + (size_t)l * 2048 * 2048, LP(WoutT), 2048, 2048, 2048, bid, nb, smem);
    d_cvt_t(LP(xq) + (size_t)l * 2048 * 512, LP(xqT), 2048, 512, 2048, bid, nb, smem);
    d_cvt_t(LP(xk) + (size_t)l * 2048 * 512, LP(xkT), 2048, 512, 2048, bid, nb, smem);
    d_cvt_t(LP(xv) + (size_t)l * 2048 * 512, LP(xvT), 2048, 512, 2048, bid, nb, smem);
    d_cvt_t(LP(xo) + (size_t)l * 512 * 2048, LP(xoT), 512, 2048, 512, bid, nb, smem);
    d_cvt_t(LP(pq) + (size_t)l * 2048 * 2048, LP(pqT), 2048, 2048, 2048, bid, nb, smem);
    d_cvt_t(LP(w_up) + (size_t)l * 64 * 1024, wupT, 64, 1024, 64, bid, nb, smem);
    d_cvt_t(LP(a_up) + (size_t)l * 64 * 1024, aupT, 64, 1024, 64, bid, nb, smem);
    d_cvt_t(LP(g_up) + (size_t)l * 160 * 1024, gupT, 160, 1024, 192, bid, nb, smem);
    { const int tz = tid_fresh(); for (int c = sfresh(bid); c < 1024 * 32 / NT; c += nb) { const int i = c * NT + tz; gupT[(size_t)(i >> 5) * 192 + 160 + (i & 31)] = 0; } }
    { const int tz = tid_fresh(); const float* sk = LP(subkeys) + (size_t)l * 2 * 128 * 128; u16* bd = LP(skb);
      for (int c = sfresh(bid); c < 256 * 256 / NT; c += nb) {
        const int i = c * NT + tz;
        int n = i >> 8, k = i & 255;
        bd[i] = ((n >> 7) == (k >> 7)) ? f2bf(sk[(size_t)(n >> 7) * 16384 + (n & 127) * 128 + (k & 127)]) : (u16)0;
      } }
    }
    }
    if (ph >= ph_lo && ph + 1 < ph_hi) { if (l == 0) { cg::this_grid().sync(); xb_ = xcd_barrier_post(LP(bar), st); } else xcd_barrier(xb_); }
    ++ph;

    if (ph >= ph_lo && ph < ph_hi) {
    REP(0) {
      int base = 0;
      (void)base;
      gemm8(smem, G8Gemm{LP(xb), LP(WinT), 2048, 2048, NTOK, RCOLS, 2048}, G8EpiF32{LP(proj), RCOLS, RCOLS}, bid, nb);
      gemm8(smem, G8Gemm{LP(xb), LP(WinT) + (size_t)RCOLS * 2048, 2048, 2048, NTOK, 2048, 2048}, G8EpiRope{LP(ropetab), LP(Qb), LP(Kb)}, bid, nb);
      gemm8(smem, G8Gemm{LP(WinT) + (size_t)(RCOLS + 2048) * 2048, LP(xb), 2048, 2048, 1024, NTOK, 2048}, G8EpiBf16{LP(Vt), NTOK, 1}, bid, nb);
    }
    }
    if (ph >= ph_lo && ph + 1 < ph_hi) xcd_barrier(xb_);
    ++ph;
    if (ph >= ph_lo && ph < ph_hi) {
    REP(7) d_rwkv_prep1(LP(proj), LP(shift_mu) + (size_t)l * RCOLS, LP(lin), bid, nb, smem);
    }
    if (ph >= ph_lo && ph + 1 < ph_hi) xcd_barrier(xb_);
    ++ph;
    if (ph >= ph_lo && ph < ph_hi) {
    REP(0) {
      int base = 0;
      base = gemm_run<0>(mk_gemm(LP(lin), LORA_LD, wupT, 64, NTOK, 1024, 64, LP(lw), nullptr, 1024), base, bid, nb, smem);
      base = gemm_run<0>(mk_gemm(LP(lin) + 64, LORA_LD, aupT, 64, NTOK, 1024, 64, LP(la), nullptr, 1024), base, bid, nb, smem);
      base = gemm_run<0>(mk_gemm(LP(lin) + 128, LORA_LD, gupT, 192, NTOK, 1024, 192, LP(gate), nullptr, 1024), base, bid, nb, smem);
    }
    }
    if (ph >= ph_lo && ph + 1 < ph_hi) xcd_barrier(xb_);
    ++ph;
    if (ph >= ph_lo && ph < ph_hi) {
    {
      Prep2Args a;
      a.proj = LP(proj); a.mu = LP(shift_mu) + (size_t)l * RCOLS; a.lw = LP(lw); a.la = LP(la);
      a.w0 = LP(w0) + l * RW; a.a0 = LP(a0) + l * RW; a.k_k = LP(k_k) + l * RW; a.k_a = LP(k_a) + l * RW; a.r_k = LP(r_k) + l * RW;
      a.wrec = LP(wrec); a.prec = LP(prec); a.bon = LP(bon);
      REP(7) d_rwkv_prep2(a, bid, nb, smem);
    }
    }
    if (ph >= ph_lo && ph + 1 < ph_hi) xcd_barrier(xb_);
    ++ph;
    if (ph >= ph_lo && ph < ph_hi) {
    {
      TabCvt tc; tc.pu = nullptr; tc.pv = nullptr; tc.Ub = LP(Ub); tc.Vb = LP(Vb); tc.usinv = LP(usinv); tc.vsinv = LP(vsinv);
      if (nb == SCAN_ITEMS) { tc.pu = LP(peer_u) + (size_t)l * 16384 * 2048; tc.pv = LP(peer_v) + (size_t)l * 16384 * 2048; }
      REP(3) d_rwkv_scan(LP(wrec), LP(prec), LP(yraw), tc, bid, nb, smem);
    }
    }
    if (ph >= ph_lo && ph < ph_hi) {
    {
      AttnArgs a;
      a.Q = LP(Qb); a.ldq = 1024; a.K = LP(Kb); a.ldk = 1024; a.Vt = LP(Vt); a.ldv = NTOK; a.O = LP(cat); a.ldo = 2048; a.ocol0 = 1024;
      a.nb = BATCH; a.nh = 8; a.sq = SEQ; a.sk = SEQ; a.scale = 0.125f;
      a.lq1 = LP(lam_q1) + l * 64; a.lk1 = LP(lam_k1) + l * 64; a.lq2 = LP(lam_q2) + l * 64; a.lk2 = LP(lam_k2) + l * 64;
      a.subw = LP(subln_w) + l * 128; a.lam_init = (l == 0) ? 0.2f : 0.35550906759096927f; a.Qf0 = a.Qf1 = nullptr;
      if (nb == 256) {
        REP(1) {
          const int xcd = bid & 7, slot = bid >> 3;
          const int bh = xcd * 4 + (slot >> 3), g = slot & 7;
          for (int k = 1; k >= 0; --k) {
            const int qb = k ? (15 - g) : g;
            attn2_item(a, LP(la), bh / 8, bh % 8, qb, 0, smem);
            attn2_item(a, LP(la), bh / 8, bh % 8, qb, 1, smem);
          }
        }
      } else {
        REP(1) for (int i = bid; i < 512; i += nb) {
          const int qb = 15 - (i >> 5), bh = i & 31;
          attn2_item(a, LP(la), bh / 8, bh % 8, qb, 0, smem);
          attn2_item(a, LP(la), bh / 8, bh % 8, qb, 1, smem);
        }
      }
    }
    }
    if (ph >= ph_lo && ph + 1 < ph_hi) xcd_barrier(xb_);
    ++ph;
    if (ph >= ph_lo && ph < ph_hi) {
    REP(7) d_rwkv_post(LP(yraw), LP(proj), LP(shift_mu) + (size_t)l * RCOLS, LP(bon), LP(gate), LP(lnx_w) + l * RW, LP(lnx_b) + l * RW, LP(cat), bid, nb, smem);
    }
    if (ph >= ph_lo && ph + 1 < ph_hi) xcd_barrier(xb_);
    ++ph;
    if (ph >= ph_lo && ph < ph_hi) {
    gemm8(smem, G8Gemm{LP(cat), LP(WoutT), 2048, 2048, NTOK, 2048, 2048}, G8EpiRes{LP(X), xres, 2048, ALPHA}, bid, nb);
    }
    if (ph >= ph_lo && ph + 1 < ph_hi) xcd_barrier(xb_);
    ++ph;
    if (ph >= ph_lo && ph < ph_hi) {
    REP(5) d_ln(LP(X), LP(ln1_w) + l * 2048, LP(ln1_b) + l * 2048, nullptr, LP(xb), LP(lnstat), NTOK, bid, nb, smem);
    }
    if (ph >= ph_lo && ph + 1 < ph_hi) xcd_barrier(xb_);
    ++ph;
    if (ph >= ph_lo && ph < ph_hi) {
    REP(0) {
      int base = 0;
      (void)base;
      gemm8(smem, G8Gemm{LP(xb), LP(xqT), 2048, 2048, NTOK, 512, 1024}, G8EpiF32{LP(qx0), 512, 512}, bid, nb);
      gemm8(smem, G8Gemm{LP(xb) + 1024, LP(xqT) + 1024, 2048, 2048, NTOK, 512, 1024}, G8EpiF32{LP(qx1), 512, 512}, (bid + 128) % nb, nb);
      gemm8(smem, G8Gemm{LP(memb), LP(xkT), 2048, 2048, BATCH * MEM_LEN, 512, 2048}, G8EpiBf16{LP(Kx), 512, 0}, bid, nb);
      gemm8(smem, G8Gemm{LP(xvT), LP(memb), 2048, 2048, 512, BATCH * MEM_LEN, 2048}, G8EpiBf16{LP(Vxt), BATCH * MEM_LEN, 0}, (bid + 8) % nb, nb);
    }
    }
    if (ph >= ph_lo && ph + 1 < ph_hi) xcd_barrier(xb_);
    ++ph;
    if (ph >= ph_lo && ph < ph_hi) {
    {
      AttnArgs a;
      a.Q = nullptr; a.Qf0 = LP(qx0); a.Qf1 = LP(qx1); a.ldq = 512; a.K = LP(Kx); a.ldk = 512; a.Vt = LP(Vxt); a.ldv = BATCH * MEM_LEN; a.O = LP(ox); a.ldo = 512; a.ocol0 = 0;
      a.nb = BATCH; a.nh = 4; a.sq = SEQ; a.sk = MEM_LEN; a.scale = 0.08838834764831845f;
      a.lq1 = a.lk1 = a.lq2 = a.lk2 = a.subw = nullptr; a.lam_init = 0.f;
      const int nitems = BATCH * 4 * (SEQ / 64);
      const int grp = tid_fresh() >> 8;
      REP(2) for (int it0 = bid * 2; it0 < nitems; it0 += nb * 2) {
        int it = it0 + grp;
        int qt = it / 16, bh = it % 16;
        attn_item<128, 1, false>(a, bh / 4, bh % 4, qt, (u16*)(smem + grp * 46080));
      }
    }
    }
    if (ph >= ph_lo && ph + 1 < ph_hi) xcd_barrier(xb_);
    ++ph;
    if (ph >= ph_lo && ph < ph_hi) {
    gemm8(smem, G8Gemm{LP(ox), LP(xoT), 512, 512, NTOK, 2048, 512}, G8EpiResLn{LP(X), LP(lnstat), LP(ln1_w) + l * 2048, LP(ln1_b) + l * 2048, 2048, ALPHA}, bid, nb);
    }
    if (ph >= ph_lo && ph + 1 < ph_hi) xcd_barrier(xb_);
    ++ph;
    if (ph >= ph_lo && ph < ph_hi) {
    d_ln(LP(X), LP(ln2_w) + l * 2048, LP(ln2_b) + l * 2048, LP(X), LP(xb), nullptr, NTOK, bid, nb, smem);
    if (nb != SCAN_ITEMS) {
    REP(6) d_cvt_fp4<true>(LP(peer_u) + (size_t)l * 16384 * 2048, LP(Ub), LP(usinv), 16384, bid, nb, smem);
    REP(6) d_cvt_fp4<false>(LP(peer_v) + (size_t)l * 16384 * 2048, LP(Vb), LP(vsinv), 16384, bid, nb, smem);
    }
    }
    if (ph >= ph_lo && ph + 1 < ph_hi) xcd_barrier(xb_);
    ++ph;
    if (ph >= ph_lo && ph < ph_hi) {
    REP(0) gemm8(smem, G8Gemm{LP(xb), LP(pqT), 2048, 2048, NTOK, 2048, 2048}, G8EpiBf16{LP(qp), 2048, 0}, bid, nb);
    }
    if (ph >= ph_lo && ph + 1 < ph_hi) xcd_barrier(xb_);
    ++ph;
    if (ph >= ph_lo && ph < ph_hi) {
    REP(0) {
      int base = 0;
      gemm8(smem, G8Gemm{LP(qp), LP(skb), 2048, 256, NTOK, 2048, 256, 256 * 2, 1}, G8EpiF32{LP(scores), 2048, 2048}, bid, nb);
    }
    }
    if (ph >= ph_lo && ph + 1 < ph_hi) xcd_barrier(xb_);
    ++ph;
    if (ph >= ph_lo && ph < ph_hi) {
    {
      PeerArgs a;
      a.x = LP(X); a.xb = LP(xb); a.scores = LP(scores); a.U = LP(Ub); a.V = LP(Vb); a.usinv = LP(usinv); a.vsinv = LP(vsinv);
      a.lnw = LP(ln3_w) + l * 2048; a.lnb = LP(ln3_b) + l * 2048;
      bool last = (l == DEPTH - 1);
      a.outf = last ? LP(out) : LP(X);
      a.outb = last ? nullptr : LP(xb); a.exmask = -1;
      if ((REPEAT_MASK >> 4) & 1) { PeerArgs d = a; d.outf = LP(out); d.outb = nullptr; d.exmask = PROBE_EXMASK; d_peer(d, bid, nb, smem); }
      d_peer(a, bid, nb, smem);
    }
    }
    if (l + 1 < DEPTH && ph >= ph_lo && ph + 1 < ph_hi) xcd_barrier(xb_);
    ++ph;
  }
}

static inline size_t al(size_t x) { return (x + 255) & ~(size_t)255; }

extern "C" void kernel_launch(void* const* d_in, const int* in_sizes, int n_in, void* d_out, int out_size, void* d_ws, size_t ws_size,
                              hipStream_t stream) {
  MegaParams p;
  memset(&p, 0, sizeof(p));
  p.x_in = (const float*)d_in[0]; p.mem = (const float*)d_in[1]; p.positions = (const int*)d_in[2]; p.w_in = (const float*)d_in[3];
  p.shift_mu = (const float*)d_in[4]; p.w0 = (const float*)d_in[5]; p.w_up = (const float*)d_in[6]; p.a0 = (const float*)d_in[7];
  p.a_up = (const float*)d_in[8]; p.g_up = (const float*)d_in[9]; p.k_k = (const float*)d_in[10]; p.k_a = (const float*)d_in[11];
  p.r_k = (const float*)d_in[12]; p.lnx_w = (const float*)d_in[13]; p.lnx_b = (const float*)d_in[14]; p.lam_q1 = (const float*)d_in[15];
  p.lam_k1 = (const float*)d_in[16]; p.lam_q2 = (const float*)d_in[17]; p.lam_k2 = (const float*)d_in[18]; p.subln_w = (const float*)d_in[19];
  p.w_out = (const float*)d_in[20]; p.ln1_w = (const float*)d_in[21]; p.ln1_b = (const float*)d_in[22]; p.xq = (const float*)d_in[23];
  p.xk = (const float*)d_in[24]; p.xv = (const float*)d_in[25]; p.xo = (const float*)d_in[26]; p.ln2_w = (const float*)d_in[27];
  p.ln2_b = (const float*)d_in[28]; p.pq = (const float*)d_in[29]; p.subkeys = (const float*)d_in[30]; p.peer_u = (const float*)d_in[31];
  p.peer_v = (const float*)d_in[32]; p.ln3_w = (const float*)d_in[33]; p.ln3_b = (const float*)d_in[34];
  p.out = (float*)d_out;

  char* ws = (char*)d_ws;
  size_t off = 0;
  auto carve = [&](size_t bytes) { char* q = ws + off; off += al(bytes); return q; };
  const size_t T = NTOK;
  p.bar = (unsigned*)carve(XCD_BAR_WORDS * 4);
  p.X = (float*)carve(T * 2048 * 4);
  p.lnstat = (float*)carve(T * 2 * 4);
  p.xb = (u16*)carve(T * 2048 * 2);
  p.memb = (u16*)carve((size_t)BATCH * MEM_LEN * 2048 * 2);
  p.WinT = (u16*)carve((size_t)N_IN * 2048 * 2);
  p.WoutT = (u16*)carve((size_t)2048 * 2048 * 2);
  p.xqT = (u16*)carve((size_t)512 * 2048 * 2);
  p.xkT = (u16*)carve((size_t)512 * 2048 * 2);
  p.xvT = (u16*)carve((size_t)512 * 2048 * 2);
  p.xoT = (u16*)carve((size_t)2048 * 512 * 2);
  p.pqT = (u16*)carve((size_t)2048 * 2048 * 2);
  p.loraT = (u16*)carve((size_t)3 * 1024 * 192 * 2);
  p.skb = (u16*)carve((size_t)256 * 256 * 2);
  p.cat = (u16*)carve(T * 2048 * 2);
  p.Qb = (u16*)carve(T * 1024 * 2);
  p.Kb = (u16*)carve(T * 1024 * 2);
  p.Vt = (u16*)carve((size_t)1024 * T * 2);
  p.ropetab = (float*)carve(T * 16 * 4);
  p.Ub = (unsigned char*)carve((size_t)16384 * 1024);
  p.Vb = (unsigned char*)carve((size_t)16384 * 1024);
  p.usinv = (float*)carve(16384 * 4);
  p.vsinv = (float*)carve(16384 * 4);
  const size_t S0 = off;
  p.proj = (float*)carve(T * RCOLS * 4);
  p.lin = (u16*)carve(T * LORA_LD * 2);
  p.lw = (float*)carve(T * 1024 * 4);
  p.la = (float*)carve(T * 1024 * 4);
  p.gate = (float*)carve(T * 1024 * 4);
  p.bon = (float*)carve(T * RH * 4);
  const size_t S1 = off;
  p.prec = (u16*)carve(T * RH * 320 * 2);
  p.wrec = (float*)p.xb;
  size_t peak = off;
  p.yraw = p.lw;
  off = S0;
  p.qx0 = (float*)carve(T * 512 * 4);
  p.qx1 = (float*)carve(T * 512 * 4);
  p.Kx = (u16*)carve((size_t)1024 * 512 * 2);
  p.Vxt = (u16*)carve((size_t)512 * 1024 * 2);
  p.ox = (u16*)carve(T * 512 * 2);
  if (off > peak) peak = off;
  off = S0;
  p.qp = (u16*)carve(T * 2048 * 2);
  p.scores = (float*)carve(T * 2048 * 4);
  p.experts = (int*)carve(T * 128 * 4);
  p.gates = (float*)carve(T * 128 * 4);
  if (off > peak) peak = off;

  static int grid_blocks = 0;
  if (!grid_blocks) {
    int dev = 0, cus = 0, per_cu = 0;
    (void)hipGetDevice(&dev);
    (void)hipDeviceGetAttribute(&cus, hipDeviceAttributeMultiprocessorCount, dev);
    (void)hipOccupancyMaxActiveBlocksPerMultiprocessor(&per_cu, mega, NT, 0);
    if (per_cu > 1) per_cu = 1;
    if (per_cu < 1) per_cu = 1;
    grid_blocks = cus * per_cu;
  }
  if (peak > ws_size) { fprintf(stderr, "workspace too small: need %zu have %zu\n", peak, ws_size); return; }
  {
    int lo = 0, hi = 1 << 20;
    void* args[] = {&p, &lo, &hi};
    hipError_t e = hipLaunchCooperativeKernel((const void*)mega, dim3(grid_blocks), dim3(NT), args, 0, stream);
    if (e != hipSuccess) fprintf(stderr, "cooperative launch failed: %s (grid %d)\n", hipGetErrorString(e), grid_blocks);
  }
}
```

```cpp
#include <hip/hip_runtime.h>
#include <hip/hip_bf16.h>
#include <hip/hip_cooperative_groups.h>
#include <stdint.h>
#include <stdio.h>
#include <string.h>
#include <stddef.h>
namespace cg = cooperative_groups;

typedef unsigned short u16;
typedef __attribute__((ext_vector_type(8))) short bf16x8;
typedef __attribute__((ext_vector_type(4))) float f32x4;
typedef __attribute__((ext_vector_type(2))) float f32x2;
typedef __attribute__((ext_vector_type(4))) unsigned int u32x4;

#define D_MODEL 2048
#define BATCH 4
#define SEQ 4096
#define NTOK (BATCH * SEQ)
#define DEPTH 2
#define MEM_LEN 256
#define RW 1024
#define RH 16
#define RCOLS 3360
#define N_IN 6432
#define DIFF_W 1024
#define XW 512
#define LORA_LD 320
#define REC 384
#define ALPHA 1.4142135623730951f
#define NT 512
#define NWV 8

typedef __attribute__((ext_vector_type(2))) __bf16 bf16x2_t;
typedef __attribute__((ext_vector_type(2))) float f32x2_t;
__device__ __forceinline__ uint32_t pack2(float a, float b) {
  bf16x2_t v = __builtin_convertvector((f32x2_t){a, b}, bf16x2_t);
  return __builtin_bit_cast(uint32_t, v);
}
__device__ __forceinline__ u16 f2bf(float f) { return (u16)(pack2(f, 0.f) & 0xffffu); }
__device__ __forceinline__ float bf2f(u16 h) { return __uint_as_float(((uint32_t)h) << 16); }

template <int CTRL>
__device__ __forceinline__ float dpp_f(float x) {
  return __int_as_float(__builtin_amdgcn_update_dpp(0, __float_as_int(x), CTRL, 0xf, 0xf, true));
}
__device__ __forceinline__ float row16_sum(float x) {
  x += dpp_f<0xB1>(x);
  x += dpp_f<0x4E>(x);
  x += dpp_f<0x141>(x);
  x += dpp_f<0x140>(x);
  return x;
}
__device__ __forceinline__ float row16_max(float x) {
  x = fmaxf(x, dpp_f<0xB1>(x));
  x = fmaxf(x, dpp_f<0x4E>(x));
  x = fmaxf(x, dpp_f<0x141>(x));
  x = fmaxf(x, dpp_f<0x140>(x));
  return x;
}
__device__ __forceinline__ float wave_sum(float x) {
  x = row16_sum(x);
  x += __shfl_xor(x, 16);
  x += __shfl_xor(x, 32);
  return x;
}
__device__ __forceinline__ float wave_max(float x) {
  x = row16_max(x);
  x = fmaxf(x, __shfl_xor(x, 16));
  x = fmaxf(x, __shfl_xor(x, 32));
  return x;
}


__device__ __forceinline__ int tid_fresh() { int t = threadIdx.x; asm volatile("" : "+v"(t)); return t; }
__device__ __forceinline__ int sfresh(int x) { asm volatile("" : "+s"(x)); return x; }

__device__ __forceinline__ void d_cvt(const float* __restrict__ src, u16* __restrict__ dst, size_t n8, const int bid0, const int nb0, unsigned char* smem) {
  const int bid = sfresh(bid0), nb = sfresh(nb0);
  const int tidf = tid_fresh();
  for (size_t i = (size_t)bid * NT + tidf; i < n8; i += (size_t)nb * NT) {
    float4 a = ((const float4*)src)[2 * i], b = ((const float4*)src)[2 * i + 1];
    uint4 o;
    o.x = pack2(a.x, a.y); o.y = pack2(a.z, a.w); o.z = pack2(b.x, b.y); o.w = pack2(b.z, b.w);
    ((uint4*)dst)[i] = o;
  }
}
__device__ __forceinline__ void d_cvt_t(const float* __restrict__ src, u16* __restrict__ dst, int K, int N, int ldd, const int bid0, const int nb0, unsigned char* smem) {
  const int bid = sfresh(bid0), nb = sfresh(nb0);
  const int tidf = tid_fresh();
  float (*tile)[65] = (float (*)[65])smem;
  const int ntn = (N + 63) / 64, ntk = (K + 63) / 64;
  const int r16 = tidf >> 4, c4 = (tidf & 15) * 4;
  for (int t = bid; t < ntn * ntk; t += nb) {
    const int tk = t / ntn, tn = t % ntn;
    __syncthreads();
#pragma unroll
    for (int i = 0; i < 2; ++i) {
      const int k = tk * 64 + r16 + 32 * i, n = tn * 64 + c4;
      f32x4 v = (f32x4){0.f, 0.f, 0.f, 0.f};
      if (k < K && n < N) v = *(const f32x4*)(src + (size_t)k * N + n);
      tile[r16 + 32 * i][c4] = v[0]; tile[r16 + 32 * i][c4 + 1] = v[1]; tile[r16 + 32 * i][c4 + 2] = v[2]; tile[r16 + 32 * i][c4 + 3] = v[3];
    }
    __syncthreads();
#pragma unroll
    for (int i = 0; i < 2; ++i) {
      const int n = tn * 64 + r16 + 32 * i, k = tk * 64 + c4;
      if (n < N && k < K) {
        uint2 o;
        o.x = pack2(tile[c4][r16 + 32 * i], tile[c4 + 1][r16 + 32 * i]);
        o.y = pack2(tile[c4 + 2][r16 + 32 * i], tile[c4 + 3][r16 + 32 * i]);
        *(uint2*)(dst + (size_t)n * ldd + k) = o;
      }
    }
  }
}
__device__ __forceinline__ void d_zero16(u16* p, size_t n, const int bid0, const int nb0, unsigned char* smem) {
  const int bid = sfresh(bid0), nb = sfresh(nb0);
  const int tidf = tid_fresh();
  for (size_t i = (size_t)bid * NT + tidf; i < n; i += (size_t)nb * NT) p[i] = 0;
}

#define GBM 128
#define GBN 128
#define GBK 64
#define GLS 72
struct GemmArgs {
  const u16* A; const u16* Bt; int lda, ldb; int M, N, K;
  float* Cf; u16* Cb; int ldc; const float* res; float alpha;
  const float* tab; u16* Cb2;
};
#undef GBM
#undef GBN
#undef GBK
#define GBM 256
#define GBN 256
#define GBK 32
__device__ __forceinline__ int lds_byte(int r, int c) {
  int ob = (r & 15) * 64 + c * 2;
  return (r >> 4) * 1024 + (ob ^ (((ob >> 9) & 1) << 5));
}
__device__ __forceinline__ void stage_rc(int b, int& R, int& C) {
  int st = b >> 10, sb = b & 1023, swz = sb ^ (((sb >> 9) & 1) << 5);
  R = st * 16 + swz / 64;
  C = (swz % 64) / 2;
}
#define G_A_B 16384
#define G_STAGE_B 32768
template <int EPI>
__device__ __forceinline__ void gemm_tile(const GemmArgs& g, int tm, int tn, unsigned char* shm) {
  const int tid = tid_fresh(), lane = tid & 63, wave = tid >> 6;
  const int wm = wave >> 2, wn = wave & 3;
  const int m0 = tm * GBM, n0 = tn * GBN;
  const int KT = g.K / GBK;
  f32x4 acc[8][4];
#pragma unroll
  for (int i = 0; i < 8; ++i)
#pragma unroll
    for (int j = 0; j < 4; ++j) acc[i][j] = (f32x4){0.f, 0.f, 0.f, 0.f};
  const u16* aptr[2]; const u16* bptr[2];
#pragma unroll
  for (int i = 0; i < 2; ++i) {
    int R, C;
    stage_rc((wave * 2 + i) * 1024 + lane * 16, R, C);
    aptr[i] = g.A + (size_t)min(m0 + R, g.M - 1) * g.lda + C;
    bptr[i] = g.Bt + (size_t)min(n0 + R, g.N - 1) * g.ldb + C;
  }
  const int aoff = lds_byte(wm * 128 + (lane & 15), (lane >> 4) * 8);
  const int boff = G_A_B + lds_byte(wn * 64 + (lane & 15), (lane >> 4) * 8);
#define GSTAGE(BUF, KTI) { \
    _Pragma("unroll") for (int i = 0; i < 2; ++i) { \
      __builtin_amdgcn_global_load_lds((const unsigned*)(aptr[i] + (KTI) * GBK), (unsigned*)(shm + (BUF) * G_STAGE_B + (wave * 2 + i) * 1024), 16, 0, 0); \
      __builtin_amdgcn_global_load_lds((const unsigned*)(bptr[i] + (KTI) * GBK), (unsigned*)(shm + (BUF) * G_STAGE_B + G_A_B + (wave * 2 + i) * 1024), 16, 0, 0); } }
#define GCOMPUTE(BUF) { const unsigned char* sb_ = shm + (BUF) * G_STAGE_B; bf16x8 af[8], bfr[4]; \
    _Pragma("unroll") for (int i = 0; i < 8; ++i) af[i] = *(const bf16x8*)(sb_ + aoff + i * 1024); \
    _Pragma("unroll") for (int j = 0; j < 4; ++j) bfr[j] = *(const bf16x8*)(sb_ + boff + j * 1024); \
    _Pragma("unroll") for (int i = 0; i < 8; ++i) _Pragma("unroll") for (int j = 0; j < 4; ++j) \
      acc[i][j] = __builtin_amdgcn_mfma_f32_16x16x32_bf16(af[i], bfr[j], acc[i][j], 0, 0, 0); }
#define GWAIT(NAFTER) { if ((NAFTER) >= 2) asm volatile("s_waitcnt vmcnt(8)" ::: "memory"); \
    else if ((NAFTER) == 1) asm volatile("s_waitcnt vmcnt(4)" ::: "memory"); else asm volatile("s_waitcnt vmcnt(0)" ::: "memory"); }
  __syncthreads();
  GSTAGE(0, 0);
  if (KT > 1) GSTAGE(1, 1);
  if (KT > 2) GSTAGE(2, 2);
  GWAIT(min(KT - 1, 2));
  asm volatile("s_waitcnt lgkmcnt(0)" ::: "memory");
  __builtin_amdgcn_s_barrier();
  {
    int buf = 0;
    for (int kt = 0; kt < KT; ++kt) {
      if (kt + 3 < KT) GSTAGE((buf + 3) & 3, kt + 3);
      GCOMPUTE(buf);
      GWAIT(min(KT - 1, kt + 3) - (kt + 1));
      asm volatile("s_waitcnt lgkmcnt(0)" ::: "memory");
      __builtin_amdgcn_s_barrier();
      buf = (buf + 1) & 3;
    }
  }
#undef GSTAGE
#undef GCOMPUTE
#undef GWAIT
#pragma unroll
  for (int i = 0; i < 8; ++i)
#pragma unroll
    for (int j = 0; j < 4; ++j) {
      int col = n0 + wn * 64 + j * 16 + (lane & 15);
#pragma unroll
      for (int r = 0; r < 4; ++r) {
        int row = m0 + wm * 128 + i * 16 + (lane >> 4) * 4 + r;
        if (EPI == 3) {
          float v = acc[i][j][r];
          if (j == 0) {
            float pv = dpp_f<0x128>(v);
            float cs = g.tab[(size_t)row * 16 + (lane & 7)], sn = g.tab[(size_t)row * 16 + 8 + (lane & 7)];
            v = (lane & 8) ? (v * cs + pv * sn) : (v * cs - pv * sn);
          }
          u16* dst = (col & 1024) ? g.Cb2 : g.Cb;
          dst[(size_t)row * 1024 + (col & 1023)] = f2bf(v);
        } else
        if (col < g.N && row < g.M) {
          size_t o = (size_t)row * g.ldc + col;
          float v = acc[i][j][r];
          if (EPI == 0) g.Cf[o] = v;
          else if (EPI == 1) g.Cb[o] = f2bf(v);
          else if (EPI == 4) { int oc = col & 15; g.Cb[(size_t)row * g.ldc + ((col & ~15) | (oc & 3) | ((oc & 8) >> 1) | ((oc & 4) << 1))] = f2bf(v); }
          else g.Cf[o] = g.alpha * g.res[o] + v;
        }
      }
    }
}
template <int EPI>
__device__ __forceinline__ int gemm_run(const GemmArgs& g, int base, const int bid0, const int nb0, unsigned char* smem) {
  const int bid = sfresh(bid0), nb = sfresh(nb0);
  int ntm = (g.M + GBM - 1) / GBM, ntn = (g.N + GBN - 1) / GBN;
  int nt = ntm * ntn;
  const int per = nb >> 3;
  const int mine = (bid & 7) * per + (bid >> 3);
  for (int idx = (base / nb) * nb + mine; idx < base + nt; idx += nb) {
    if (idx < base) continue;
    int t = idx - base;
    gemm_tile<EPI>(g, t / ntn, t % ntn, smem);
  }
  return base + nt;
}

#define G8_LAS __attribute__((address_space(3)))
struct G8Unit { int pm, pn; };
struct G8Gemm { const u16* A; const u16* Bt; int lda, ldb; int M, N, K; int a_pn_off; int b_shared; };
__device__ __forceinline__ int g8_lds_byte(int r, int c) { const int st = (r >> 4) * 2 + (c >> 5), rr = r & 15, cc = c & 31, ob = rr * 64 + cc * 2; return st * 1024 + (ob ^ (((ob >> 9) & 1) << 5)); }
__device__ __forceinline__ void g8_stage_rc(int b, int& R, int& C) { const int st = b / 1024, sb = b % 1024, swz = sb ^ (((sb >> 9) & 1) << 5); R = (st >> 1) * 16 + swz / 64; C = (st & 1) * 32 + (swz % 64) / 2; }
struct G8Order {
  int nM, nN, nwg, G, c;
  __device__ __forceinline__ void init(int M, int N, int G_, int c_) { nM = M / 256; nN = (N + 255) / 256; nwg = nM * nN; G = G_; c = c_; }
  __device__ __forceinline__ bool next(int i, G8Unit& u) const {
    const long L = (long)i * G + c; if (L >= nwg) return false;
    int wgid = (int)L; { const int q = nwg / 8, r = nwg % 8, xcd = wgid % 8, off = wgid / 8; wgid = (xcd < r ? xcd * (q + 1) : r * (q + 1) + (xcd - r) * q) + off; }
    const int nig = 8 * nN, gid = wgid / nig, fm = gid * 8, gsz = (nM - fm) < 8 ? (nM - fm) : 8;
    u.pm = fm + ((wgid % nig) % gsz); u.pn = (wgid % nig) / gsz; return true;
  }
};
struct G8EpiF32 { float* C; int ldc; int N;
  __device__ __forceinline__ void operator()(const f32x4 (&acc)[2][2][4][2], const G8Unit& u, int wr, int wc, int fr, int fq) const {
#pragma unroll
    for (int ai = 0; ai < 2; ++ai)
#pragma unroll
      for (int m = 0; m < 4; ++m) { float* rowp = C + (size_t)(u.pm * 256 + ai * 128 + wr * 64 + m * 16 + fr) * ldc;
#pragma unroll
        for (int bj = 0; bj < 2; ++bj)
#pragma unroll
          for (int n = 0; n < 2; ++n) { const int c0 = u.pn * 256 + bj * 128 + wc * 32 + n * 16 + 4 * fq; if (c0 < N) *(f32x4*)(rowp + c0) = acc[ai][bj][m][n]; } }
  } };
struct G8EpiResLn { float* C; const float* stats; const float* lnw; const float* lnb; int ldc; float alpha;
  __device__ __forceinline__ void operator()(const f32x4 (&acc)[2][2][4][2], const G8Unit& u, int wr, int wc, int fr, int fq) const {
#pragma unroll
    for (int bj = 0; bj < 2; ++bj)
#pragma unroll
      for (int n = 0; n < 2; ++n) { const int c0 = u.pn * 256 + bj * 128 + wc * 32 + n * 16 + 4 * fq;
        const f32x4 w4 = *(const f32x4*)(lnw + c0), b4 = *(const f32x4*)(lnb + c0);
#pragma unroll
        for (int ai = 0; ai < 2; ++ai)
#pragma unroll
          for (int m = 0; m < 4; ++m) { const size_t row = (size_t)(u.pm * 256 + ai * 128 + wr * 64 + m * 16 + fr); const size_t ro = row * ldc;
            const float2 st = *(const float2*)(stats + row * 2);
            f32x4 r4 = *(const f32x4*)(C + ro + c0);
#pragma unroll
            for (int j = 0; j < 4; ++j) r4[j] = (r4[j] - st.x) * st.y * w4[j] + b4[j];
            *(f32x4*)(C + ro + c0) = r4 * alpha + acc[ai][bj][m][n]; } }
  } };
struct G8EpiRes { float* C; const float* res; int ldc; float alpha;
  __device__ __forceinline__ void operator()(const f32x4 (&acc)[2][2][4][2], const G8Unit& u, int wr, int wc, int fr, int fq) const {
#pragma unroll
    for (int ai = 0; ai < 2; ++ai)
#pragma unroll
      for (int m = 0; m < 4; ++m) { const size_t ro = (size_t)(u.pm * 256 + ai * 128 + wr * 64 + m * 16 + fr) * ldc;
#pragma unroll
        for (int bj = 0; bj < 2; ++bj)
#pragma unroll
          for (int n = 0; n < 2; ++n) { const int c0 = u.pn * 256 + bj * 128 + wc * 32 + n * 16 + 4 * fq;
            f32x4 r4 = *(const f32x4*)(res + ro + c0); *(f32x4*)(C + ro + c0) = r4 * alpha + acc[ai][bj][m][n]; } }
  } };
struct G8EpiBf16 { u16* C; int ldc; int vperm;
  __device__ __forceinline__ void operator()(const f32x4 (&acc)[2][2][4][2], const G8Unit& u, int wr, int wc, int fr, int fq) const {
    const int pos = vperm ? (4 * (fq >> 1) + 8 * (fq & 1)) : 4 * fq;
#pragma unroll
    for (int ai = 0; ai < 2; ++ai)
#pragma unroll
      for (int m = 0; m < 4; ++m) { u16* rowp = C + (size_t)(u.pm * 256 + ai * 128 + wr * 64 + m * 16 + fr) * ldc;
#pragma unroll
        for (int bj = 0; bj < 2; ++bj)
#pragma unroll
          for (int n = 0; n < 2; ++n) { const int c0 = u.pn * 256 + bj * 128 + wc * 32 + n * 16 + pos; const f32x4 v = acc[ai][bj][m][n];
            uint2 o; o.x = pack2(v[0], v[1]); o.y = pack2(v[2], v[3]); *(uint2*)(rowp + c0) = o; } }
  } };
struct G8EpiRope { const float* tab; u16* Q; u16* Kb;
  __device__ __forceinline__ void operator()(const f32x4 (&acc)[2][2][4][2], const G8Unit& u, int wr, int wc, int fr, int fq) const {
#pragma unroll
    for (int ai = 0; ai < 2; ++ai)
#pragma unroll
      for (int m = 0; m < 4; ++m) { const size_t row = (size_t)(u.pm * 256 + ai * 128 + wr * 64 + m * 16 + fr);
#pragma unroll
        for (int bj = 0; bj < 2; ++bj)
#pragma unroll
          for (int n = 0; n < 2; ++n) { const int c0 = u.pn * 256 + bj * 128 + wc * 32 + n * 16 + 4 * fq; f32x4 v = acc[ai][bj][m][n];
            if (n == 0 && (wc & 1) == 0) {
#pragma unroll
              for (int j = 0; j < 4; ++j) {
                const float pv = __shfl_xor(v[j], 32);
                const int dd = (4 * fq + j) & 7;
                const float cs = tab[row * 16 + dd], sn = tab[row * 16 + 8 + dd];
                v[j] = (fq & 2) ? (v[j] * cs + pv * sn) : (v[j] * cs - pv * sn);
              }
            }
            u16* dst = (c0 & 1024) ? Kb : Q;
            if (!(c0 & 1024)) v *= (0.125f * 1.4426950408889634f);
            uint2 o; o.x = pack2(v[0], v[1]); o.y = pack2(v[2], v[3]); *(uint2*)(dst + row * 1024 + (c0 & 1023)) = o; } }
  } };

template <class Epi>
__device__ __forceinline__ void gemm8(unsigned char* smem, const G8Gemm g, const Epi& E, const int bid0, const int nb0) {
  constexpr int BK = 64, HALF = 128, HTB = HALF * BK * 2;
  G8_LAS unsigned char* lds = (G8_LAS unsigned char*)smem;
  G8Order S; S.init(g.M, g.N, sfresh(nb0), sfresh(bid0));
  const int tid = tid_fresh(), wid = __builtin_amdgcn_readfirstlane(tid >> 6), lane = tid & 63, wr = wid >> 2, wc = wid & 3, fr = lane & 15, fq = lane >> 4;
  const int nt = g.K / BK;
  unsigned voffA[2], voffB[2];
#pragma unroll
  for (int i = 0; i < 2; ++i) { int R, C; g8_stage_rc(tid * 16 + i * 8192, R, C); voffA[i] = (unsigned)(R * g.lda + C) * 2u; voffB[i] = (unsigned)(R * g.ldb + C) * 2u; }
  const size_t kstep = (size_t)(BK * 2);
  const size_t hstepA = (size_t)HALF * g.lda * 2, hstepB = (size_t)HALF * g.ldb * 2;
  const size_t tstepA = 2 * hstepA, tstepB = 2 * hstepB;
  const unsigned ldsw = (unsigned)wid * 1024u;
  const int aoff = g8_lds_byte(wr * 64 + fr, fq * 8), boff = g8_lds_byte(wc * 32 + fr, fq * 8);
#define PG8_SA(b, h) (((b) * 2 + (h)) * HTB)
#define PG8_SB(b, h) ((4 + (b) * 2 + (h)) * HTB)
#define PG8_STAGE(bufoff, gbase, voff) do { _Pragma("unroll") for (int _i = 0; _i < 2; ++_i) \
        __builtin_amdgcn_global_load_lds((const unsigned*)((const char*)(gbase) + (voff)[_i]), (G8_LAS unsigned*)(lds + (bufoff) + ldsw + _i * 8192), 16, 0, 0); } while (0)
#define PG8_LDA(dst, b, h) do { _Pragma("unroll") for (int m = 0; m < 4; ++m) _Pragma("unroll") for (int k = 0; k < 2; ++k) dst[m][k] = *(const G8_LAS bf16x8*)(lds + PG8_SA(b, h) + aoff + m * 2048 + k * 1024); } while (0)
#define PG8_LDB(dst, b, h) do { _Pragma("unroll") for (int n = 0; n < 2; ++n) _Pragma("unroll") for (int k = 0; k < 2; ++k) dst[n][k] = *(const G8_LAS bf16x8*)(lds + PG8_SB(b, h) + boff + n * 2048 + k * 1024); } while (0)
#define PG8_MMA(ai, bj, At, Bt) do { __builtin_amdgcn_s_setprio(1); _Pragma("unroll") for (int m = 0; m < 4; ++m) _Pragma("unroll") for (int n = 0; n < 2; ++n) _Pragma("unroll") for (int k = 0; k < 2; ++k) \
        acc[ai][bj][m][n] = __builtin_amdgcn_mfma_f32_16x16x32_bf16(Bt[n][k], At[m][k], acc[ai][bj][m][n], 0, 0, 0); __builtin_amdgcn_s_setprio(0); } while (0)
#define PG8_WAIT_V(n) asm volatile("s_waitcnt vmcnt(" #n ")" ::: "memory")
#define PG8_WAIT_L(n) asm volatile("s_waitcnt lgkmcnt(" #n ")" ::: "memory")
#define PG8_BAR __builtin_amdgcn_s_barrier()
#define PG8_SCHED __builtin_amdgcn_sched_barrier(0)
  __syncthreads();
  G8Unit cur, nxt; int ui = 0;
  if (S.next(0, cur)) {
  f32x4 acc[2][2][4][2];
#pragma unroll
  for (int a = 0; a < 2; ++a)
#pragma unroll
    for (int b = 0; b < 2; ++b)
#pragma unroll
      for (int m = 0; m < 4; ++m)
#pragma unroll
        for (int n = 0; n < 2; ++n) acc[a][b][m][n] = (f32x4){0.f, 0.f, 0.f, 0.f};
  bf16x8 At[4][2], B0[2][2], B1[2][2];
  const char* cA = (const char*)g.A + (size_t)cur.pm * tstepA + (size_t)cur.pn * g.a_pn_off; const char* cB = (const char*)g.Bt + (g.b_shared ? (size_t)0 : (size_t)cur.pn * tstepB);
  PG8_STAGE(PG8_SB(0, 0), cB, voffB); PG8_STAGE(PG8_SA(0, 0), cA, voffA); PG8_STAGE(PG8_SB(0, 1), cB + hstepB, voffB); PG8_STAGE(PG8_SA(0, 1), cA + hstepA, voffA);
  if (wr == 1) PG8_BAR;
  PG8_WAIT_V(4); PG8_BAR;
  PG8_STAGE(PG8_SB(1, 0), cB + kstep, voffB); PG8_STAGE(PG8_SA(1, 0), cA + kstep, voffA); PG8_STAGE(PG8_SB(1, 1), cB + hstepB + kstep, voffB);
  PG8_WAIT_V(6); PG8_BAR;
  for (;;) {
    const bool has_next = S.next(ui + 1, nxt);
    const char* nA = has_next ? (const char*)g.A + (size_t)nxt.pm * tstepA + (size_t)nxt.pn * g.a_pn_off : cA; const char* nB = has_next ? (const char*)g.Bt + (g.b_shared ? (size_t)0 : (size_t)nxt.pn * tstepB) : cB;
    for (int t = 0; t < nt; t += 2) {
      const bool last = (t == nt - 2);
      const char* a1 = cA + (size_t)(t + 1) * kstep;
      const char* a2 = last ? nA : cA + (size_t)(t + 2) * kstep; const char* b2 = last ? nB : cB + (size_t)(t + 2) * kstep;
      const char* a3 = a2 + kstep; const char* b3 = b2 + kstep;
      PG8_LDB(B0, 0, 0); PG8_SCHED; PG8_LDA(At, 0, 0); PG8_STAGE(PG8_SA(1, 1), a1 + hstepA, voffA);
      PG8_WAIT_L(8); PG8_BAR; PG8_WAIT_L(0); PG8_MMA(0, 0, At, B0); PG8_BAR; PG8_SCHED;
      PG8_LDB(B1, 0, 1); PG8_STAGE(PG8_SB(0, 0), b2, voffB);
      PG8_BAR; PG8_WAIT_L(0); PG8_MMA(0, 1, At, B1); PG8_BAR;
      PG8_LDA(At, 0, 1); PG8_STAGE(PG8_SA(0, 0), a2, voffA);
      PG8_BAR; PG8_WAIT_L(0); PG8_MMA(1, 0, At, B0); PG8_BAR; PG8_SCHED;
      PG8_STAGE(PG8_SB(0, 1), b2 + hstepB, voffB);
      PG8_WAIT_V(6); PG8_BAR; PG8_MMA(1, 1, At, B1); PG8_BAR;
      PG8_LDB(B0, 1, 0); PG8_SCHED; PG8_LDA(At, 1, 0); PG8_STAGE(PG8_SA(0, 1), a2 + hstepA, voffA);
      PG8_WAIT_L(8); PG8_BAR; PG8_WAIT_L(0); PG8_MMA(0, 0, At, B0); PG8_BAR; PG8_SCHED;
      PG8_LDB(B1, 1, 1); PG8_STAGE(PG8_SB(1, 0), b3, voffB);
      PG8_BAR; PG8_WAIT_L(0); PG8_MMA(0, 1, At, B1); PG8_BAR;
      PG8_LDA(At, 1, 1); PG8_STAGE(PG8_SA(1, 0), a3, voffA);
      PG8_BAR; PG8_WAIT_L(0); PG8_MMA(1, 0, At, B0); PG8_BAR; PG8_SCHED;
      PG8_STAGE(PG8_SB(1, 1), b3 + hstepB, voffB);
      PG8_WAIT_V(6); PG8_BAR; PG8_MMA(1, 1, At, B1); PG8_BAR;
    }
    E(acc, cur, wr, wc, fr, fq);
    if (!has_next) break;
#pragma unroll
    for (int a = 0; a < 2; ++a)
#pragma unroll
      for (int b = 0; b < 2; ++b)
#pragma unroll
        for (int m = 0; m < 4; ++m)
#pragma unroll
          for (int n = 0; n < 2; ++n) acc[a][b][m][n] = (f32x4){0.f, 0.f, 0.f, 0.f};
    cur = nxt; cA = nA; cB = nB; ++ui;
  }
  PG8_WAIT_V(0);
  if (wr == 0) PG8_BAR;
  PG8_BAR;
  }
#undef PG8_SA
#undef PG8_SB
#undef PG8_STAGE
#undef PG8_LDA
#undef PG8_LDB
#undef PG8_MMA
#undef PG8_WAIT_V
#undef PG8_WAIT_L
#undef PG8_BAR
#undef PG8_SCHED
  __syncthreads();
}

__device__ __forceinline__ void d_ln(const float* pre, const float* __restrict__ w, const float* __restrict__ b,
                                            float* outf, u16* __restrict__ outb, float* __restrict__ stats, int rows, const int bid0, const int nb0, unsigned char* smem) {
  const int bid = sfresh(bid0), nb = sfresh(nb0);
  const int tidf = tid_fresh();
  int lane = tidf & 63, wave = tidf >> 6;
  for (int row0 = (bid * NWV + wave) * 2; row0 < rows; row0 += nb * NWV * 2) {
    f32x4 v[2][8];
    float s[2] = {0.f, 0.f};
#pragma unroll
    for (int u = 0; u < 2; ++u) {
      const f32x4* p = (const f32x4*)(pre + (size_t)(row0 + u) * D_MODEL);
#pragma unroll
      for (int i = 0; i < 8; ++i) v[u][i] = p[lane + 64 * i];
    }
#pragma unroll
    for (int u = 0; u < 2; ++u) {
#pragma unroll
      for (int i = 0; i < 8; ++i) s[u] += (v[u][i][0] + v[u][i][1]) + (v[u][i][2] + v[u][i][3]);
    }
    float mu[2], rs[2];
#pragma unroll
    for (int u = 0; u < 2; ++u) mu[u] = wave_sum(s[u]) * (1.0f / D_MODEL);
#pragma unroll
    for (int u = 0; u < 2; ++u) {
      float q = 0.f;
#pragma unroll
      for (int i = 0; i < 8; ++i)
#pragma unroll
        for (int j = 0; j < 4; ++j) { float d = v[u][i][j] - mu[u]; q += d * d; }
      rs[u] = q;
    }
#pragma unroll
    for (int u = 0; u < 2; ++u) rs[u] = rsqrtf(wave_sum(rs[u]) * (1.0f / D_MODEL) + 1e-5f);
    if (stats && lane < 2) { float2 st; st.x = lane ? mu[1] : mu[0]; st.y = lane ? rs[1] : rs[0]; *(float2*)(stats + (size_t)(row0 + lane) * 2) = st; }
#pragma unroll
    for (int i = 0; i < 8; ++i) {
      f32x4 ww = ((const f32x4*)w)[lane + 64 * i], bb = ((const f32x4*)b)[lane + 64 * i];
#pragma unroll
      for (int u = 0; u < 2; ++u) {
        f32x4 o;
#pragma unroll
        for (int j = 0; j < 4; ++j) o[j] = (v[u][i][j] - mu[u]) * rs[u] * ww[j] + bb[j];
        if (outf) ((f32x4*)(outf + (size_t)(row0 + u) * D_MODEL))[lane + 64 * i] = o;
        uint2 ob; ob.x = pack2(o[0], o[1]); ob.y = pack2(o[2], o[3]);
        ((uint2*)(outb + (size_t)(row0 + u) * D_MODEL))[lane + 64 * i] = ob;
      }
    }
  }
}

__device__ __forceinline__ void d_rwkv_prep1(const float* __restrict__ proj, const float* __restrict__ mu, u16* __restrict__ lin, const int bid0, const int nb0, unsigned char* smem) {
  const int bid = sfresh(bid0), nb = sfresh(nb0);
  const int tidf = tid_fresh();
  const unsigned total = (unsigned)NTOK * LORA_LD;
  for (unsigned i = (unsigned)bid * NT + (unsigned)tidf; i < total; i += (unsigned)nb * NT) {
    const int t = (int)(i / (unsigned)LORA_LD), c = (int)(i % (unsigned)LORA_LD);
    float out = 0.f;
    if (c < 288) {
      int col = 3072 + c;
      float p = proj[(size_t)t * RCOLS + col];
      float pp = ((t % SEQ) == 0) ? 0.f : proj[(size_t)(t - 1) * RCOLS + col];
      float x = p + (pp - p) * mu[col];
      if (c < 64) out = 1.f - 2.f * __builtin_amdgcn_rcpf(1.f + __expf(2.f * x));
      else if (c < 128) out = x;
      else out = __builtin_amdgcn_rcpf(1.f + __expf(-x));
    }
    lin[i] = f2bf(out);
  }
}

struct Prep2Args {
  const float* proj; const float* mu; const float* lw; const float* la;
  const float* w0; const float* a0; const float* k_k; const float* k_a; const float* r_k;
  float* wrec; u16* prec; float* bon;
};
__device__ __forceinline__ void prep2_load(const Prep2Args& a, int it, int lane, float (&pr)[5], float (&pk)[5], float (&pv)[5], float (&lw)[4], float (&la)[4]) {
  const int h = it & (RH - 1), t0 = (it >> 4) * 4;
  const int s0 = t0 % SEQ;
  const int c = h * 64 + lane;
  const float* p0 = a.proj + (size_t)t0 * RCOLS;
  pr[0] = pk[0] = pv[0] = 0.f;
  if (s0 != 0) { pr[0] = p0[c - RCOLS]; pk[0] = p0[RW + c - RCOLS]; pv[0] = p0[2 * RW + c - RCOLS]; }
#pragma unroll
  for (int u = 0; u < 4; ++u) {
    pr[u + 1] = p0[(size_t)u * RCOLS + c]; pk[u + 1] = p0[(size_t)u * RCOLS + RW + c]; pv[u + 1] = p0[(size_t)u * RCOLS + 2 * RW + c];
    lw[u] = a.lw[(size_t)(t0 + u) * RW + c]; la[u] = a.la[(size_t)(t0 + u) * RW + c];
  }
}
__device__ __forceinline__ void d_rwkv_prep2(Prep2Args a, const int bid0, const int nb0, unsigned char* smem) {
  const int bid = sfresh(bid0), nb = sfresh(nb0);
  const int tidf = tid_fresh();
  int lane = tidf & 63, wave = tidf >> 6;
  constexpr int NITEM = (NTOK / 4) * RH;
  const int stride = nb * NWV;
  int it = bid * NWV + wave;
  if (it >= NITEM) return;
  float npr[5], npk[5], npv[5], nlw[4], nla[4];
  prep2_load(a, it, lane, npr, npk, npv, nlw, nla);
  for (; it < NITEM; it += stride) {
    const int h = it & (RH - 1), t0 = (it >> 4) * 4;
    const int b = t0 / SEQ, s0 = t0 % SEQ;
    const int c = h * 64 + lane;
    const float mur = a.mu[c], muk = a.mu[RW + c], muv = a.mu[2 * RW + c];
    const float w0c = a.w0[c], a0c = a.a0[c], kkc = a.k_k[c], kac = a.k_a[c], rkc = a.r_k[c];
    float pr[5], pk[5], pv[5], lw[4], la[4];
#pragma unroll
    for (int u = 0; u < 5; ++u) { pr[u] = npr[u]; pk[u] = npk[u]; pv[u] = npv[u]; }
#pragma unroll
    for (int u = 0; u < 4; ++u) { lw[u] = nlw[u]; la[u] = nla[u]; }
    { const int itn = (it + stride < NITEM) ? it + stride : it; prep2_load(a, itn, lane, npr, npk, npv, nlw, nla); }
    float r[4], k[4], v[4], decay[4], iclr[4], kk[4], nrm[4], k2[4], bonus[4];
#pragma unroll
    for (int u = 0; u < 4; ++u) {
      r[u] = pr[u + 1] + (pr[u] - pr[u + 1]) * mur;
      k[u] = pk[u + 1] + (pk[u] - pk[u + 1]) * muk;
      v[u] = pv[u + 1] + (pv[u] - pv[u + 1]) * muv;
      float nz = -(w0c + lw[u]);
      float sp = fmaxf(nz, 0.f) + __logf(1.f + __expf(-fabsf(nz)));
      decay[u] = __expf(-__expf(-sp - 0.5f));
      iclr[u] = __builtin_amdgcn_rcpf(1.f + __expf(-(a0c + la[u])));
      kk[u] = k[u] * kkc;
      nrm[u] = kk[u] * kk[u];
      k2[u] = k[u] * (1.f + (iclr[u] - 1.f) * kac);
      bonus[u] = r[u] * k2[u] * rkc;
    }
#pragma unroll
    for (int u = 0; u < 4; ++u) { nrm[u] = wave_sum(nrm[u]); bonus[u] = wave_sum(bonus[u]); }
#pragma unroll
    for (int u = 0; u < 4; ++u) {
      float kn = kk[u] * __builtin_amdgcn_rcpf(fmaxf(__builtin_amdgcn_sqrtf(nrm[u]), 1e-12f));
      size_t ri = (size_t)(b * RH + h) * SEQ + s0 + u;
      a.wrec[ri * 64 + lane] = decay[u];
      u16* pr16 = a.prec + ri * 320;
      pr16[lane] = f2bf(k2[u]);
      pr16[64 + lane] = f2bf(-kn);
      pr16[128 + lane] = f2bf(kn * iclr[u]);
      pr16[192 + lane] = f2bf(r[u]);
      pr16[256 + lane] = f2bf(v[u]);
      if (lane == 0) a.bon[(size_t)(t0 + u) * RH + h] = bonus[u];
    }
  }
}

#define SC_TC 16
__device__ __forceinline__ void scan_store_p(float* sRec, int c, u32x4 v) {
  int step = c / 40, within = c % 40;
  int arr = within >> 3, col8 = (within & 7) * 8;
  float* d = sRec + step * REC + 64 + arr * 64 + col8;
  f32x4 lo, hi;
  lo[0] = __uint_as_float(v[0] << 16); lo[1] = __uint_as_float(v[0] & 0xffff0000u);
  lo[2] = __uint_as_float(v[1] << 16); lo[3] = __uint_as_float(v[1] & 0xffff0000u);
  hi[0] = __uint_as_float(v[2] << 16); hi[1] = __uint_as_float(v[2] & 0xffff0000u);
  hi[2] = __uint_as_float(v[3] << 16); hi[3] = __uint_as_float(v[3] & 0xffff0000u);
  *(f32x4*)d = lo;
  *(f32x4*)(d + 4) = hi;
}
#define SCAN_ITEMS (BATCH * RH * 4)
#define SC_BUF (SC_TC * REC)
struct TabCvt { const float* pu; const float* pv; unsigned char* Ub; unsigned char* Vb; float* usinv; float* vsinv; };
__device__ __forceinline__ void tab_row_store(const f32x4 (&v)[8], unsigned char* dst, float* sinv, int row, bool natural, int lane) {
  float amax = 0.f;
#pragma unroll
  for (int i = 0; i < 8; ++i)
#pragma unroll
    for (int j = 0; j < 4; ++j) amax = fmaxf(amax, fabsf(v[i][j]));
  amax = wave_max(amax);
  float scale = 1.f, inv = 1.f;
  if (amax > 0.f) { scale = 6.0f / amax; inv = amax * (1.0f / 6.0f); }
  u32x4 o;
#pragma unroll
  for (int k = 0; k < 4; ++k) {
    unsigned w = 0u;
    w = __builtin_amdgcn_cvt_scalef32_pk_fp4_f32(w, v[2 * k][0] * scale, v[2 * k][1] * scale, 1.0f, 0);
    w = __builtin_amdgcn_cvt_scalef32_pk_fp4_f32(w, v[2 * k][2] * scale, v[2 * k][3] * scale, 1.0f, 1);
    w = __builtin_amdgcn_cvt_scalef32_pk_fp4_f32(w, v[2 * k + 1][0] * scale, v[2 * k + 1][1] * scale, 1.0f, 2);
    w = __builtin_amdgcn_cvt_scalef32_pk_fp4_f32(w, v[2 * k + 1][2] * scale, v[2 * k + 1][3] * scale, 1.0f, 3);
    o[k] = w;
  }
  if (natural) {
    uint2 lo; lo.x = o[0]; lo.y = o[1];
    uint2 hi; hi.x = o[2]; hi.y = o[3];
    *(uint2*)(dst + (size_t)row * (D_MODEL / 2) + lane * 8) = lo;
    *(uint2*)(dst + (size_t)row * (D_MODEL / 2) + 512 + lane * 8) = hi;
  } else {
    *(u32x4*)(dst + (size_t)row * (D_MODEL / 2) + lane * 16) = o;
  }
  if (lane == 0) sinv[row] = inv;
}
__device__ __forceinline__ void d_rwkv_scan(const float* __restrict__ wrec, const u16* __restrict__ prec, float* __restrict__ yraw, const TabCvt tc, const int bid0, const int nb0, unsigned char* smem) {
  const int bid = sfresh(bid0), nb = sfresh(nb0);
  const int tidf = tid_fresh();
  float* sRec0 = (float*)smem;
  float* sY0 = sRec0 + 2 * SC_BUF;
  const int tid = tidf, lane = tid & 63, wave = __builtin_amdgcn_readfirstlane(tid >> 6);
  const int cg = lane & 15, rg = lane >> 4;
  const bool helper = wave >= 4;
  const int ht = tid - 256;
  constexpr int NCH = SEQ / SC_TC;
  for (int item = bid; item < SCAN_ITEMS; item += nb) {
    const int bh = item >> 2, rb = item & 3;
    const int b = bh / RH, h = bh % RH;
    const f32x4* wsrc = (const f32x4*)(wrec + (size_t)bh * SEQ * 64);
    const u32x4* psrc = (const u32x4*)(prec + (size_t)bh * SEQ * 320);
    const int rowl = (wave & 3) * 4 + rg;
    const int row = rb * 16 + rowl;
    f32x2 S01 = (f32x2){0.f, 0.f}, S23 = S01;
    f32x4 pw = (f32x4){0.f, 0.f, 0.f, 0.f};
    u32x4 p0 = (u32x4){0u, 0u, 0u, 0u}, p1 = p0, p2 = p0;
    f32x4 trow[8];
#pragma unroll
    for (int i = 0; i < 8; ++i) trow[i] = (f32x4){0.f, 0.f, 0.f, 0.f};
    __syncthreads();
    if (helper) {
      pw = wsrc[ht]; p0 = psrc[ht]; p1 = psrc[ht + 256]; if (ht < 128) p2 = psrc[ht + 512];
      *(f32x4*)(sRec0 + (ht >> 4) * REC + (ht & 15) * 4) = pw;
      scan_store_p(sRec0, ht, p0); scan_store_p(sRec0, ht + 256, p1); if (ht < 128) scan_store_p(sRec0, ht + 512, p2);
      pw = wsrc[256 + ht]; { const u32x4* ps = psrc + 640; p0 = ps[ht]; p1 = ps[ht + 256]; if (ht < 128) p2 = ps[ht + 512]; }
    }
    __syncthreads();
    for (int ch = 0; ch < NCH; ++ch) {
      float* sRec = sRec0 + (ch & 1) * SC_BUF;
      float* sY = sY0 + (ch & 1) * (SC_TC * 256);
      if (!helper) {
        const float* rc0 = sRec + 4 * cg;
        const float* rv0 = sRec + 320 + row;
        f32x4 Wa[2], Ka[2], Aa[2], Ba[2], Ra[2], Wb[2], Kb[2], Ab[2], Bb[2], Rb[2];
        float va[2], vb[2];
#define SC_LOAD(W, K, A, B, R, V, G) { _Pragma("unroll") for (int u = 0; u < 2; ++u) { const float* rc = rc0 + ((G) * 2 + u) * REC; \
          W[u] = *(const f32x4*)(rc); K[u] = *(const f32x4*)(rc + 64); A[u] = *(const f32x4*)(rc + 128); B[u] = *(const f32x4*)(rc + 192); \
          R[u] = *(const f32x4*)(rc + 256); V[u] = rv0[((G) * 2 + u) * REC]; } }
#define SC_GROUP(W, K, A, B, R, V, G) { float yy[2]; \
          _Pragma("unroll") for (int u = 0; u < 2; ++u) { \
            const f32x2 v2 = (f32x2){V[u], V[u]}; \
            const f32x2 p01 = __builtin_elementwise_fma(S01, W[u].lo, K[u].lo * v2), p23 = __builtin_elementwise_fma(S23, W[u].hi, K[u].hi * v2); \
            const f32x2 t = __builtin_elementwise_fma(S23, A[u].hi, S01 * A[u].lo); \
            float sa = t[0] + t[1]; \
            sa = row16_sum(sa); \
            const f32x2 sa2 = (f32x2){sa, sa}; \
            S01 = __builtin_elementwise_fma(sa2, B[u].lo, p01); S23 = __builtin_elementwise_fma(sa2, B[u].hi, p23); \
            const f32x2 yv = __builtin_elementwise_fma(S23, R[u].hi, S01 * R[u].lo); \
            yy[u] = yv[0] + yv[1]; } \
          _Pragma("unroll") for (int u = 0; u < 2; ++u) sY[(((G) * 2 + u) * 16 + rowl) * 16 + cg] = yy[u]; }
        SC_LOAD(Wa, Ka, Aa, Ba, Ra, va, 0);
        SC_LOAD(Wb, Kb, Ab, Bb, Rb, vb, 1);
        SC_GROUP(Wa, Ka, Aa, Ba, Ra, va, 0);
        SC_LOAD(Wa, Ka, Aa, Ba, Ra, va, 2);
        SC_GROUP(Wb, Kb, Ab, Bb, Rb, vb, 1);
        SC_LOAD(Wb, Kb, Ab, Bb, Rb, vb, 3);
        SC_GROUP(Wa, Ka, Aa, Ba, Ra, va, 2);
        SC_LOAD(Wa, Ka, Aa, Ba, Ra, va, 4);
        SC_GROUP(Wb, Kb, Ab, Bb, Rb, vb, 3);
        SC_LOAD(Wb, Kb, Ab, Bb, Rb, vb, 5);
        SC_GROUP(Wa, Ka, Aa, Ba, Ra, va, 4);
        SC_LOAD(Wa, Ka, Aa, Ba, Ra, va, 6);
        SC_GROUP(Wb, Kb, Ab, Bb, Rb, vb, 5);
        SC_LOAD(Wb, Kb, Ab, Bb, Rb, vb, 7);
        SC_GROUP(Wa, Ka, Aa, Ba, Ra, va, 6);
        SC_GROUP(Wb, Kb, Ab, Bb, Rb, vb, 7);
#undef SC_LOAD
#undef SC_GROUP
      } else {
        if (tc.pu) {
          const int hw = wave - 4;
          if (ch >= 1 && ch <= 32) {
            const int sl = (ch - 1) * 4 + hw;
            const bool isv = sl >= 64;
            tab_row_store(trow, isv ? tc.Vb : tc.Ub, isv ? tc.vsinv : tc.usinv, bid * 64 + (sl & 63), !isv, lane);
          }
          if (ch < 32) {
            const int sl = ch * 4 + hw;
            const bool isv = sl >= 64;
            const f32x4* rp = (const f32x4*)((isv ? tc.pv : tc.pu) + (size_t)(bid * 64 + (sl & 63)) * D_MODEL);
#pragma unroll
            for (int q = 0; q < 2; ++q)
#pragma unroll
              for (int k = 0; k < 4; ++k) trow[q * 4 + k] = rp[q * 256 + lane * 4 + k];
          }
        }
        if (ch + 1 < NCH) {
          float* dR = sRec0 + ((ch + 1) & 1) * SC_BUF;
          *(f32x4*)(dR + (ht >> 4) * REC + (ht & 15) * 4) = pw;
          scan_store_p(dR, ht, p0); scan_store_p(dR, ht + 256, p1); if (ht < 128) scan_store_p(dR, ht + 512, p2);
          if (ch + 2 < NCH) {
            pw = wsrc[(size_t)(ch + 2) * 256 + ht];
            const u32x4* ps = psrc + (size_t)(ch + 2) * 640;
            p0 = ps[ht]; p1 = ps[ht + 256]; if (ht < 128) p2 = ps[ht + 512];
          }
        }
        if (ch >= 1) {
          const float* pY = sY0 + ((ch - 1) & 1) * (SC_TC * 256);
          const int st = ht >> 4, r = ht & 15;
          const f32x4* yp = (const f32x4*)(pY + (st * 16 + r) * 16);
          f32x4 y0 = yp[0], y1 = yp[1], y2 = yp[2], y3 = yp[3];
          yraw[((size_t)b * SEQ + (ch - 1) * SC_TC + st) * RW + h * 64 + rb * 16 + r] =
              ((y0[0] + y0[1]) + (y0[2] + y0[3])) + ((y1[0] + y1[1]) + (y1[2] + y1[3])) + (((y2[0] + y2[1]) + (y2[2] + y2[3])) + ((y3[0] + y3[1]) + (y3[2] + y3[3])));
        }
      }
      __syncthreads();
    }
    if (helper) {
      const float* pY = sY0 + ((NCH - 1) & 1) * (SC_TC * 256);
      const int st = ht >> 4, r = ht & 15;
      const f32x4* yp = (const f32x4*)(pY + (st * 16 + r) * 16);
      f32x4 y0 = yp[0], y1 = yp[1], y2 = yp[2], y3 = yp[3];
      yraw[((size_t)b * SEQ + (NCH - 1) * SC_TC + st) * RW + h * 64 + rb * 16 + r] =
          ((y0[0] + y0[1]) + (y0[2] + y0[3])) + ((y1[0] + y1[1]) + (y1[2] + y1[3])) + (((y2[0] + y2[1]) + (y2[2] + y2[3])) + ((y3[0] + y3[1]) + (y3[2] + y3[3])));
    }
  }
}

__device__ __forceinline__ void d_rwkv_post(const float* __restrict__ yraw, const float* __restrict__ proj, const float* __restrict__ mu,
                                                   const float* __restrict__ bon, const float* __restrict__ gate, const float* __restrict__ lnw,
                                                   const float* __restrict__ lnb, u16* __restrict__ cat, const int bid0, const int nb0, unsigned char* smem) {
  const int bid = sfresh(bid0), nb = sfresh(nb0);
  const int tidf = tid_fresh();
  int lane = tidf & 63, wave = tidf >> 6;
  for (int it = bid * NWV + wave; it < (NTOK / 4) * RH; it += nb * NWV) {
    const int h = it & (RH - 1), t0 = (it >> 4) * 4;
    const int s0 = t0 % SEQ;
    const int c = h * 64 + lane;
    const float muv = mu[2 * RW + c], lw_ = lnw[c], lb_ = lnb[c];
    float y[4], pv[5], g[4], bo[4];
    const float* p0 = proj + (size_t)t0 * RCOLS + 2 * RW + c;
    pv[0] = 0.f;
    if (s0 != 0) pv[0] = p0[-RCOLS];
#pragma unroll
    for (int u = 0; u < 4; ++u) {
      y[u] = yraw[(size_t)(t0 + u) * RW + c];
      pv[u + 1] = p0[(size_t)u * RCOLS];
      g[u] = gate[(size_t)(t0 + u) * RW + c];
      bo[u] = bon[(size_t)(t0 + u) * RH + h];
    }
    float mean[4], var[4];
#pragma unroll
    for (int u = 0; u < 4; ++u) { mean[u] = wave_sum(y[u]) * (1.f / 64.f); var[u] = wave_sum(y[u] * y[u]) * (1.f / 64.f); }
#pragma unroll
    for (int u = 0; u < 4; ++u) var[u] = fmaxf(var[u] - mean[u] * mean[u], 0.f);
#pragma unroll
    for (int u = 0; u < 4; ++u) {
      float yn = (y[u] - mean[u]) * __builtin_amdgcn_rsqf(var[u] + 64e-5f) * lw_ + lb_;
      float v = pv[u + 1] + (pv[u] - pv[u + 1]) * muv;
      cat[(size_t)(t0 + u) * D_MODEL + c] = f2bf((yn + bo[u] * v) * g[u]);
    }
  }
}

__device__ __forceinline__ void d_rope_table(const int* __restrict__ pos, float* __restrict__ tab, const int bid0, const int nb0, unsigned char* smem) {
  const int bid = sfresh(bid0), nb = sfresh(nb0);
  const int tidf = tid_fresh();
  for (int i = bid * NT + tidf; i < NTOK * 8; i += nb * NT) {
    int t = i >> 3, dd = i & 7;
    float inv = (dd & 4) ? ((dd & 2) ? ((dd & 1) ? 1.031338537721246e-05f : 5.3182958969449883e-05f)
                                     : ((dd & 1) ? 0.0002742481756762073f : 0.001414213562373095f))
                         : ((dd & 2) ? ((dd & 1) ? 0.0072926647372171093f : 0.037606030930863933f)
                                     : ((dd & 1) ? 0.19392274474868576f : 1.0f));
    float ang = (float)pos[t] * inv;
    float sn, cs;
    sincosf(ang, &sn, &cs);
    tab[(size_t)t * 16 + dd] = cs;
    tab[(size_t)t * 16 + 8 + dd] = sn;
  }
}

struct AttnArgs {
  const u16* Q; int ldq;
  const u16* K; int ldk;
  const u16* Vt; int ldv;
  u16* O; int ldo; int ocol0;
  int nb, nh, sq, sk;
  float scale;
  const float* lq1; const float* lk1; const float* lq2; const float* lk2; const float* subw; float lam_init;
  const float* Qf0; const float* Qf1;
};
template <int DQK, int NCOMP, bool CAUSAL>
__device__ __forceinline__ void attn_item(const AttnArgs& a, int b, int h, int qt, u16* smem) {
  constexpr int KS = DQK + 8;
  constexpr int KST = DQK / 32;
  u16* sK = smem;
  u16* sV = sK + NCOMP * 64 * KS;
  u16* sP = sV + 128 * 72;
  const int tid = tid_fresh() & 255, lane = tid & 63, wave = tid >> 6;
  const int l15 = lane & 15, l4 = lane >> 4;
  const int hq = h * (NCOMP * DQK);
  const size_t qrow0 = (size_t)b * a.sq + qt * 64 + wave * 16;
  const float sc = a.scale * 1.4426950408889634f;

  bf16x8 qf[NCOMP][KST];
#pragma unroll
  for (int c = 0; c < NCOMP; ++c)
#pragma unroll
    for (int ks = 0; ks < KST; ++ks)
    {
      if (!CAUSAL) {
        const size_t qo = (qrow0 + l15) * a.ldq + hq + c * DQK + ks * 32 + l4 * 8;
        f32x4 x0 = *(const f32x4*)(a.Qf0 + qo), x1 = *(const f32x4*)(a.Qf0 + qo + 4);
        f32x4 y0 = *(const f32x4*)(a.Qf1 + qo), y1 = *(const f32x4*)(a.Qf1 + qo + 4);
        u32x4 pk_ = (u32x4){pack2(x0[0] + y0[0], x0[1] + y0[1]), pack2(x0[2] + y0[2], x0[3] + y0[3]),
                            pack2(x1[0] + y1[0], x1[1] + y1[1]), pack2(x1[2] + y1[2], x1[3] + y1[3])};
        qf[c][ks] = __builtin_bit_cast(bf16x8, pk_);
      } else
      qf[c][ks] = *(const bf16x8*)(a.Q + (qrow0 + l15) * a.ldq + hq + c * DQK + ks * 32 + l4 * 8);
    }

  f32x4 O[NCOMP][8];
  float m[NCOMP][4], l[NCOMP][4];
#pragma unroll
  for (int c = 0; c < NCOMP; ++c) {
#pragma unroll
    for (int d = 0; d < 8; ++d) O[c][d] = (f32x4){0.f, 0.f, 0.f, 0.f};
#pragma unroll
    for (int i = 0; i < 4; ++i) { m[c][i] = -INFINITY; l[c][i] = 0.f; }
  }
  const int nkt = CAUSAL ? (qt + 1) : (a.sk / 64);
  constexpr int KCH = NCOMP * 64 * (DQK / 8) / 256;
  u32x4 rk[KCH], rv[4];
  auto gload = [&](int kt) {
#pragma unroll
    for (int i = 0; i < KCH; ++i) {
      int cidx = tid + 256 * i;
      int kc = cidx % (DQK / 8), rowc = cidx / (DQK / 8);
      int c = rowc / 64, key = rowc % 64;
      rk[i] = *(const u32x4*)(a.K + ((size_t)b * a.sk + kt * 64 + key) * a.ldk + hq + c * DQK + kc * 8);
    }
#pragma unroll
    for (int i = 0; i < 4; ++i) {
      int cidx = tid + 256 * i;
      int kc = cidx & 7, dv = cidx >> 3;
      rv[i] = *(const u32x4*)(a.Vt + (size_t)(h * 128 + dv) * a.ldv + (size_t)b * a.sk + kt * 64 + kc * 8);
    }
  };
  auto swrite = [&]() {
#pragma unroll
    for (int i = 0; i < KCH; ++i) {
      int cidx = tid + 256 * i;
      int kc = cidx % (DQK / 8), rowc = cidx / (DQK / 8);
      *(u32x4*)(sK + rowc * KS + kc * 8) = rk[i];
    }
#pragma unroll
    for (int i = 0; i < 4; ++i) {
      int cidx = tid + 256 * i;
      int kc = cidx & 7, dv = cidx >> 3;
      *(u32x4*)(sV + dv * 72 + kc * 8) = rv[i];
    }
  };
  gload(0);
  for (int kt = 0; kt < nkt; ++kt) {
    __syncthreads();
    swrite();
    __syncthreads();
    if (kt + 1 < nkt) gload(kt + 1);
#pragma unroll
    for (int c = 0; c < NCOMP; ++c) {
      f32x4 S[4];
#pragma unroll
      for (int sub = 0; sub < 4; ++sub) {
        f32x4 acc = (f32x4){0.f, 0.f, 0.f, 0.f};
#pragma unroll
        for (int ks = 0; ks < KST; ++ks) {
          bf16x8 kf = *(const bf16x8*)(sK + (c * 64 + sub * 16 + l15) * KS + ks * 32 + l4 * 8);
          acc = __builtin_amdgcn_mfma_f32_16x16x32_bf16(qf[c][ks], kf, acc, 0, 0, 0);
        }
        S[sub] = acc;
      }
#pragma unroll
      for (int sub = 0; sub < 4; ++sub)
#pragma unroll
        for (int i = 0; i < 4; ++i) {
          float sv_ = S[sub][i] * sc;
          if (CAUSAL && kt == qt) {
            int keyl = sub * 16 + l15, rowl = wave * 16 + l4 * 4 + i;
            if (keyl > rowl) sv_ = -INFINITY;
          }
          S[sub][i] = sv_;
        }
#pragma unroll
      for (int i = 0; i < 4; ++i) {
        float mx = fmaxf(fmaxf(S[0][i], S[1][i]), fmaxf(S[2][i], S[3][i]));
        mx = row16_max(mx);
        float mn = fmaxf(m[c][i], mx);
        float alpha = exp2f(m[c][i] - mn);
        m[c][i] = mn;
        float ps = 0.f;
#pragma unroll
        for (int sub = 0; sub < 4; ++sub) {
          float pe = exp2f(S[sub][i] - mn);
          S[sub][i] = pe;
          ps += pe;
        }
        l[c][i] = l[c][i] * alpha + ps;
#pragma unroll
        for (int d = 0; d < 8; ++d) O[c][d][i] *= alpha;
      }
      u16* pw = sP + wave * 16 * 72;
      __syncthreads();
#pragma unroll
      for (int sub = 0; sub < 4; ++sub)
#pragma unroll
        for (int i = 0; i < 4; ++i) pw[(l4 * 4 + i) * 72 + sub * 16 + l15] = f2bf(S[sub][i]);
      __syncthreads();
#pragma unroll
      for (int ks = 0; ks < 2; ++ks) {
        bf16x8 pf = *(const bf16x8*)(pw + l15 * 72 + ks * 32 + l4 * 8);
#pragma unroll
        for (int d = 0; d < 8; ++d) {
          bf16x8 vf = *(const bf16x8*)(sV + (d * 16 + l15) * 72 + ks * 32 + l4 * 8);
          O[c][d] = __builtin_amdgcn_mfma_f32_16x16x32_bf16(pf, vf, O[c][d], 0, 0, 0);
        }
      }
    }
  }
  float inv[NCOMP][4];
#pragma unroll
  for (int c = 0; c < NCOMP; ++c)
#pragma unroll
    for (int i = 0; i < 4; ++i) inv[c][i] = 1.f / row16_sum(l[c][i]);
  if (NCOMP == 2) {
    float s1 = 0.f, s2 = 0.f;
    for (int j = 0; j < 64; ++j) { s1 += a.lq1[j] * a.lk1[j]; s2 += a.lq2[j] * a.lk2[j]; }
    float lam = expf(s1) - expf(s2) + a.lam_init;
    float ss[4] = {0.f, 0.f, 0.f, 0.f};
#pragma unroll
    for (int d = 0; d < 8; ++d)
#pragma unroll
      for (int i = 0; i < 4; ++i) {
        float o = O[0][d][i] * inv[0][i] - lam * (O[NCOMP - 1][d][i] * inv[NCOMP - 1][i]);
        O[0][d][i] = o;
        ss[i] += o * o;
      }
#pragma unroll
    for (int i = 0; i < 4; ++i) ss[i] = rsqrtf(row16_sum(ss[i]) * (1.f / 128.f) + 1e-5f) * (1.f - a.lam_init);
#pragma unroll
    for (int d = 0; d < 8; ++d) {
      float sw = a.subw[d * 16 + l15];
#pragma unroll
      for (int i = 0; i < 4; ++i)
        a.O[(qrow0 + l4 * 4 + i) * a.ldo + a.ocol0 + h * 128 + d * 16 + l15] = f2bf(O[0][d][i] * ss[i] * sw);
    }
  } else {
#pragma unroll
    for (int d = 0; d < 8; ++d)
#pragma unroll
      for (int i = 0; i < 4; ++i)
        a.O[(qrow0 + l4 * 4 + i) * a.ldo + a.ocol0 + h * 128 + d * 16 + l15] = f2bf(O[0][d][i] * inv[0][i]);
  }
}
typedef __attribute__((ext_vector_type(16))) float f32x16;
__device__ __forceinline__ void attn2_item(const AttnArgs& a, float* u1, int b, int h, int qb, int c, unsigned char* shm) {
  const int tid = tid_fresh(), lane = tid & 63, wave = tid >> 6;
  const int q = lane & 31, hh = lane >> 5;
  const int q0 = qb * 256 + wave * 32;
  const size_t qrow = (size_t)b * SEQ + q0 + q;
  const float sc = 0.125f * 1.4426950408889634f;
  bf16x8 qf[4];
#pragma unroll
  for (int s = 0; s < 4; ++s) qf[s] = *(const bf16x8*)(a.Q + qrow * 1024 + h * 128 + c * 64 + 16 * s + 8 * hh);
  f32x16 O[4];
  float m = -INFINITY, l = 0.f;
#pragma unroll
  for (int t = 0; t < 4; ++t)
#pragma unroll
    for (int r = 0; r < 16; ++r) O[t][r] = 0.f;
  const int nkt = 4 * qb + 4;
  unsigned koff[1], voff[2];
  {
    int row = 8 * wave + (lane >> 3);
    int chunk = (lane & 7) ^ ((row >> 1) & 7);
    koff[0] = (unsigned)(row * 1024 + chunk * 8);
  }
#pragma unroll
  for (int i = 0; i < 2; ++i) {
    int row = 8 * (wave * 2 + i) + (lane >> 3);
    int chunk = (lane & 7) ^ ((row >> 1) & 7);
    voff[i] = (unsigned)(row * NTOK + chunk * 8);
  }
  const u16* kbase = a.K + (size_t)b * SEQ * 1024 + h * 128 + c * 64;
  const u16* vbase = a.Vt + (size_t)h * 128 * NTOK + (size_t)b * SEQ;
#define A2_STAGE(BUF, KT) { \
    __builtin_amdgcn_global_load_lds((const unsigned*)(kbase + (size_t)(KT) * 64 * 1024 + koff[0]), (unsigned*)(shm + (BUF) * 24576 + wave * 1024), 16, 0, 0); \
    _Pragma("unroll") for (int i = 0; i < 2; ++i) \
      __builtin_amdgcn_global_load_lds((const unsigned*)(vbase + (KT) * 64 + voff[i]), (unsigned*)(shm + (BUF) * 24576 + 8192 + (wave * 2 + i) * 1024), 16, 0, 0); }
#define A2_KFRAG(BASE, T_, s_) (*(const bf16x8*)((BASE) + (32 * (T_) + q) * 128 + (((2 * (s_) + hh) ^ (((32 * (T_) + q) >> 1) & 7)) << 4)))
#define A2_VFRAG(BASE, t_, s2_) (*(const bf16x8*)((BASE) + (32 * (t_) + q) * 128 + (((2 * (s2_) + hh) ^ (((32 * (t_) + q) >> 1) & 7)) << 4)))
#define A2_EXPQ(J) { _Pragma("unroll") for (int r_ = 0; r_ < 8; r_ += 2) { \
      float p0 = __builtin_amdgcn_exp2f(S[(J) >> 1][((J) & 1) * 8 + r_]), p1 = __builtin_amdgcn_exp2f(S[(J) >> 1][((J) & 1) * 8 + r_ + 1]); \
      ps += p0 + p1; pk[(J) >> 1][((J) & 1) * 4 + (r_ >> 1)] = pack2(p0, p1); } }
#define A2_PV(VF, J) { u32x4 pw_ = (u32x4){pk[(J) >> 1][((J) & 1) * 4 + 0], pk[(J) >> 1][((J) & 1) * 4 + 1], pk[(J) >> 1][((J) & 1) * 4 + 2], pk[(J) >> 1][((J) & 1) * 4 + 3]}; \
      bf16x8 pf = __builtin_bit_cast(bf16x8, pw_); \
      _Pragma("unroll") for (int t = 0; t < 4; ++t) O[t] = __builtin_amdgcn_mfma_f32_32x32x16_bf16(VF[t], pf, O[t], 0, 0, 0); }
#define A2_TILE(BUF, KT) { \
    const unsigned char* vim = shm + (BUF) * 24576 + 8192; const unsigned char* kimn = shm + (((BUF) + 1) & 3) * 24576; \
      \
      \
    const float negm = ((KT) == 0) ? 0.f : -m; \
    f32x16 S[2]; \
    _Pragma("unroll") for (int T = 0; T < 2; ++T) { \
      _Pragma("unroll") for (int r = 0; r < 16; ++r) S[T][r] = negm; \
      _Pragma("unroll") for (int s = 0; s < 4; ++s) S[T] = __builtin_amdgcn_mfma_f32_32x32x16_bf16(kf[T][s], qf[s], S[T], 0, 0, 0); } \
    bf16x8 vfa[4], vfb[4]; \
    _Pragma("unroll") for (int t = 0; t < 4; ++t) vfa[t] = A2_VFRAG(vim, t, 0); \
    __builtin_amdgcn_sched_barrier(0); \
    if ((KT) * 64 + 63 > q0) {     \
      _Pragma("unroll") for (int T = 0; T < 2; ++T) _Pragma("unroll") for (int r = 0; r < 16; ++r) { \
        int key = (KT) * 64 + 32 * T + 8 * (r >> 2) + 4 * hh + (r & 3); if (key > q0 + q) S[T][r] = -INFINITY; } } \
    float mx = -INFINITY; \
    _Pragma("unroll") for (int T = 0; T < 2; ++T) _Pragma("unroll") for (int r = 0; r < 16; ++r) mx = fmaxf(mx, S[T][r]); \
    mx = fmaxf(mx, __shfl_xor(mx, 32)); \
    if ((KT) == 0) {               \
      m = mx; \
      _Pragma("unroll") for (int T = 0; T < 2; ++T) _Pragma("unroll") for (int r = 0; r < 16; ++r) S[T][r] -= mx; \
    } else if (__any(mx > 6.0f)) {     \
      const float d = fmaxf(mx, 0.f); \
      const float alpha = __builtin_amdgcn_exp2f(-d); \
      m += d; l *= alpha; \
      _Pragma("unroll") for (int t = 0; t < 4; ++t) _Pragma("unroll") for (int r = 0; r < 16; ++r) O[t][r] *= alpha; \
      _Pragma("unroll") for (int T = 0; T < 2; ++T) _Pragma("unroll") for (int r = 0; r < 16; ++r) S[T][r] -= d; } \
    float ps = 0.f; \
    uint32_t pk[2][8]; \
    A2_EXPQ(0); \
    __builtin_amdgcn_sched_barrier(0); \
    _Pragma("unroll") for (int t = 0; t < 4; ++t) vfb[t] = A2_VFRAG(vim, t, 1); \
    kf[0][0] = A2_KFRAG(kimn, 0, 0); kf[0][1] = A2_KFRAG(kimn, 0, 1); \
    A2_EXPQ(1); A2_PV(vfa, 0); \
    __builtin_amdgcn_sched_barrier(0); \
    _Pragma("unroll") for (int t = 0; t < 4; ++t) vfa[t] = A2_VFRAG(vim, t, 2); \
    kf[0][2] = A2_KFRAG(kimn, 0, 2); kf[0][3] = A2_KFRAG(kimn, 0, 3); \
    A2_EXPQ(2); A2_PV(vfb, 1); \
    __builtin_amdgcn_sched_barrier(0); \
    _Pragma("unroll") for (int t = 0; t < 4; ++t) vfb[t] = A2_VFRAG(vim, t, 3); \
    kf[1][0] = A2_KFRAG(kimn, 1, 0); kf[1][1] = A2_KFRAG(kimn, 1, 1); \
    A2_EXPQ(3); A2_PV(vfa, 2); \
    __builtin_amdgcn_sched_barrier(0); \
    kf[1][2] = A2_KFRAG(kimn, 1, 2); kf[1][3] = A2_KFRAG(kimn, 1, 3); \
    A2_PV(vfb, 3); \
    __builtin_amdgcn_sched_barrier(0); \
    l += ps; }
  __syncthreads();
  A2_STAGE(0, 0);
  A2_STAGE(1, 1);
  A2_STAGE(2, 2);
  asm volatile("s_waitcnt vmcnt(3)" ::: "memory");
  asm volatile("s_waitcnt lgkmcnt(0)" ::: "memory");
  __builtin_amdgcn_s_barrier();
  {
    bf16x8 kf[2][4];
#pragma unroll
    for (int T = 0; T < 2; ++T)
#pragma unroll
      for (int s = 0; s < 4; ++s) kf[T][s] = A2_KFRAG(shm, T, s);
    int buf = 0;
    for (int kt = 0; kt < nkt; ++kt) {
      if (kt + 3 < nkt) A2_STAGE((buf + 3) & 3, kt + 3);
      A2_TILE(buf, kt);
      if (kt + 3 < nkt) asm volatile("s_waitcnt vmcnt(3)" ::: "memory"); else asm volatile("s_waitcnt vmcnt(0)" ::: "memory");
      asm volatile("s_waitcnt lgkmcnt(0)" ::: "memory");
      __builtin_amdgcn_s_barrier();
      buf = (buf + 1) & 3;
    }
  }
#undef A2_KFRAG
#undef A2_VFRAG
#undef A2_EXPQ
#undef A2_PV
#undef A2_STAGE
#undef A2_TILE
  const float inv = 1.f / (l + __shfl_xor(l, 32));
  float* urow = u1 + qrow * 1024 + h * 128;
  if (c == 0) {
#pragma unroll
    for (int t = 0; t < 4; ++t)
#pragma unroll
      for (int g = 0; g < 4; ++g) {
        const int dv = 32 * t + 8 * g + 4 * hh;
        *(f32x4*)(urow + dv) = (f32x4){O[t][4 * g] * inv, O[t][4 * g + 1] * inv, O[t][4 * g + 2] * inv, O[t][4 * g + 3] * inv};
      }
    return;
  }
  float s1 = 0.f, s2 = 0.f;
  for (int j = 0; j < 64; ++j) { s1 += a.lq1[j] * a.lk1[j]; s2 += a.lq2[j] * a.lk2[j]; }
  const float lam = expf(s1) - expf(s2) + a.lam_init;
  const float c1 = lam * inv;
  float ss = 0.f;
#pragma unroll
  for (int t = 0; t < 4; ++t)
#pragma unroll
    for (int g = 0; g < 4; ++g) {
      const int dv = 32 * t + 8 * g + 4 * hh;
      f32x4 u4 = *(const f32x4*)(urow + dv);
#pragma unroll
      for (int i = 0; i < 4; ++i) { float o = u4[i] - c1 * O[t][4 * g + i]; O[t][4 * g + i] = o; ss += o * o; }
    }
  ss += __shfl_xor(ss, 32);
  const float rn = rsqrtf(ss * (1.f / 128.f) + 1e-5f) * (1.f - a.lam_init);
  u16* orow = a.O + qrow * a.ldo + a.ocol0 + h * 128;
#pragma unroll
  for (int t = 0; t < 4; ++t)
#pragma unroll
    for (int g = 0; g < 4; ++g) {
      const int dv = 32 * t + 8 * g + 4 * hh;
      f32x4 w4 = *(const f32x4*)(a.subw + dv);
      uint2 ov;
      ov.x = pack2(O[t][4 * g + 0] * rn * w4[0], O[t][4 * g + 1] * rn * w4[1]);
      ov.y = pack2(O[t][4 * g + 2] * rn * w4[2], O[t][4 * g + 3] * rn * w4[3]);
      *(uint2*)(orow + dv) = ov;
    }
}


__device__ __forceinline__ void xattn2_item(const AttnArgs& a, int b, int h, int qb, unsigned char* shm) {
  const int tid = tid_fresh(), lane = tid & 63, wave = tid >> 6;
  const int q = lane & 31, hh = lane >> 5;
  const int q0 = qb * 256 + wave * 32;
  const size_t qrow = (size_t)b * SEQ + q0 + q;
  const float qs = 0.08838834764831845f * 1.4426950408889634f;
  f32x4 qa[8][2], qb2[8][2];
  {
    const float* q0p = a.Qf0 + qrow * 512 + h * 128 + 8 * hh;
    const float* q1p = a.Qf1 + qrow * 512 + h * 128 + 8 * hh;
#pragma unroll
    for (int s = 0; s < 8; ++s) {
      qa[s][0] = *(const f32x4*)(q0p + 16 * s); qa[s][1] = *(const f32x4*)(q0p + 16 * s + 4);
      qb2[s][0] = *(const f32x4*)(q1p + 16 * s); qb2[s][1] = *(const f32x4*)(q1p + 16 * s + 4);
    }
  }
  __syncthreads();
#pragma unroll
  for (int kt = 0; kt < 4; ++kt) {
#pragma unroll
    for (int i = 0; i < 2; ++i) {
      const int n = wave * 2 + i;
      { const int row = 4 * n + (lane >> 4), chunk = (lane & 15) ^ (row & 15);
        const u16* src = a.K + ((size_t)(b * MEM_LEN + kt * 64 + row) * 512 + h * 128 + chunk * 8);
        __builtin_amdgcn_global_load_lds((const unsigned*)src, (unsigned*)(shm + kt * 32768 + n * 1024), 16, 0, 0); }
      { const int row = 8 * n + (lane >> 3), chunk = (lane & 7) ^ ((row >> 1) & 7);
        const u16* src = a.Vt + ((size_t)(h * 128 + row) * (BATCH * MEM_LEN) + b * MEM_LEN + kt * 64 + chunk * 8);
        __builtin_amdgcn_global_load_lds((const unsigned*)src, (unsigned*)(shm + kt * 32768 + 16384 + n * 1024), 16, 0, 0); }
    }
  }
  bf16x8 qf[8];
#pragma unroll
  for (int s = 0; s < 8; ++s) {
    const f32x4 a0 = qa[s][0], a1 = qa[s][1], b0 = qb2[s][0], b1 = qb2[s][1];
    u32x4 w;
    w[0] = pack2((a0[0] + b0[0]) * qs, (a0[1] + b0[1]) * qs); w[1] = pack2((a0[2] + b0[2]) * qs, (a0[3] + b0[3]) * qs);
    w[2] = pack2((a1[0] + b1[0]) * qs, (a1[1] + b1[1]) * qs); w[3] = pack2((a1[2] + b1[2]) * qs, (a1[3] + b1[3]) * qs);
    qf[s] = __builtin_bit_cast(bf16x8, w);
  }
  f32x16 O[4];
  float m = 0.f, l = 0.f;
#pragma unroll
  for (int t = 0; t < 4; ++t)
#pragma unroll
    for (int r = 0; r < 16; ++r) O[t][r] = 0.f;
#define XA_KFRAG(BASE, T_, s_) (*(const bf16x8*)((BASE) + (32 * (T_) + q) * 256 + (((2 * (s_) + hh) ^ ((32 * (T_) + q) & 15)) << 4)))
#define XA_VFRAG(BASE, t_, s2_) (*(const bf16x8*)((BASE) + (32 * (t_) + q) * 128 + (((2 * (s2_) + hh) ^ (((32 * (t_) + q) >> 1) & 7)) << 4)))
#define XA_EXPQ(J) { _Pragma("unroll") for (int r_ = 0; r_ < 8; r_ += 2) { \
      float p0 = __builtin_amdgcn_exp2f(S[(J) >> 1][((J) & 1) * 8 + r_]), p1 = __builtin_amdgcn_exp2f(S[(J) >> 1][((J) & 1) * 8 + r_ + 1]); \
      ps += p0 + p1; pk[(J) >> 1][((J) & 1) * 4 + (r_ >> 1)] = pack2(p0, p1); } }
#define XA_PV(VF, J) { u32x4 pw_ = (u32x4){pk[(J) >> 1][((J) & 1) * 4 + 0], pk[(J) >> 1][((J) & 1) * 4 + 1], pk[(J) >> 1][((J) & 1) * 4 + 2], pk[(J) >> 1][((J) & 1) * 4 + 3]}; \
      bf16x8 pf = __builtin_bit_cast(bf16x8, pw_); \
      _Pragma("unroll") for (int t = 0; t < 4; ++t) O[t] = __builtin_amdgcn_mfma_f32_32x32x16_bf16(VF[t], pf, O[t], 0, 0, 0); }
#define XA_TILE(KT) { \
    const unsigned char* kim = shm + (KT) * 32768; const unsigned char* vim = kim + 16384; \
    const float negm = ((KT) == 0) ? 0.f : -m; \
    f32x16 S[2]; \
    _Pragma("unroll") for (int T = 0; T < 2; ++T) { \
      _Pragma("unroll") for (int r = 0; r < 16; ++r) S[T][r] = negm; \
      bf16x8 ka[4], kb[4]; \
      _Pragma("unroll") for (int s = 0; s < 4; ++s) ka[s] = XA_KFRAG(kim, T, s); \
      _Pragma("unroll") for (int s = 0; s < 4; ++s) kb[s] = XA_KFRAG(kim, T, 4 + s); \
      __builtin_amdgcn_sched_barrier(0); \
      _Pragma("unroll") for (int s = 0; s < 4; ++s) S[T] = __builtin_amdgcn_mfma_f32_32x32x16_bf16(ka[s], qf[s], S[T], 0, 0, 0); \
      _Pragma("unroll") for (int s = 0; s < 4; ++s) S[T] = __builtin_amdgcn_mfma_f32_32x32x16_bf16(kb[s], qf[4 + s], S[T], 0, 0, 0); \
      __builtin_amdgcn_sched_barrier(0); } \
    bf16x8 vfa[4], vfb[4]; \
    _Pragma("unroll") for (int t = 0; t < 4; ++t) vfa[t] = XA_VFRAG(vim, t, 0); \
    float mx = -INFINITY; \
    _Pragma("unroll") for (int T = 0; T < 2; ++T) _Pragma("unroll") for (int r = 0; r < 16; ++r) mx = fmaxf(mx, S[T][r]); \
    mx = fmaxf(mx, __shfl_xor(mx, 32)); \
    if ((KT) == 0) { \
      m = mx; \
      _Pragma("unroll") for (int T = 0; T < 2; ++T) _Pragma("unroll") for (int r = 0; r < 16; ++r) S[T][r] -= mx; \
    } else if (__any(mx > 6.0f)) { \
      const float d = fmaxf(mx, 0.f); \
      const float alpha = __builtin_amdgcn_exp2f(-d); \
      m += d; l *= alpha; \
      _Pragma("unroll") for (int t = 0; t < 4; ++t) _Pragma("unroll") for (int r = 0; r < 16; ++r) O[t][r] *= alpha; \
      _Pragma("unroll") for (int T = 0; T < 2; ++T) _Pragma("unroll") for (int r = 0; r < 16; ++r) S[T][r] -= d; } \
    float ps = 0.f; \
    uint32_t pk[2][8]; \
    XA_EXPQ(0); \
    __builtin_amdgcn_sched_barrier(0); \
    _Pragma("unroll") for (int t = 0; t < 4; ++t) vfb[t] = XA_VFRAG(vim, t, 1); \
    XA_EXPQ(1); XA_PV(vfa, 0); \
    __builtin_amdgcn_sched_barrier(0); \
    _Pragma("unroll") for (int t = 0; t < 4; ++t) vfa[t] = XA_VFRAG(vim, t, 2); \
    XA_EXPQ(2); XA_PV(vfb, 1); \
    __builtin_amdgcn_sched_barrier(0); \
    _Pragma("unroll") for (int t = 0; t < 4; ++t) vfb[t] = XA_VFRAG(vim, t, 3); \
    XA_EXPQ(3); XA_PV(vfa, 2); \
    __builtin_amdgcn_sched_barrier(0); \
    XA_PV(vfb, 3); \
    __builtin_amdgcn_sched_barrier(0); \
    l += ps; }
  asm volatile("s_waitcnt vmcnt(12)" ::: "memory"); __builtin_amdgcn_s_barrier();
  XA_TILE(0);
  asm volatile("s_waitcnt vmcnt(8)" ::: "memory"); __builtin_amdgcn_s_barrier();
  XA_TILE(1);
  asm volatile("s_waitcnt vmcnt(4)" ::: "memory"); __builtin_amdgcn_s_barrier();
  XA_TILE(2);
  asm volatile("s_waitcnt vmcnt(0)" ::: "memory"); __builtin_amdgcn_s_barrier();
  XA_TILE(3);
#undef XA_KFRAG
#undef XA_VFRAG
#undef XA_EXPQ
#undef XA_PV
#undef XA_TILE
  const float inv = 1.f / (l + __shfl_xor(l, 32));
  u16* orow = a.O + qrow * a.ldo + a.ocol0 + h * 128;
#pragma unroll
  for (int t = 0; t < 4; ++t)
#pragma unroll
    for (int g = 0; g < 4; ++g) {
      const int dv = 32 * t + 8 * g + 4 * hh;
      uint2 ov;
      ov.x = pack2(O[t][4 * g + 0] * inv, O[t][4 * g + 1] * inv);
      ov.y = pack2(O[t][4 * g + 2] * inv, O[t][4 * g + 3] * inv);
      *(uint2*)(orow + dv) = ov;
    }
}

__device__ __forceinline__ uint32_t fkey(float f) {
  uint32_t u = __float_as_uint(f);
  return (u & 0x80000000u) ? ~u : (u | 0x80000000u);
}
template <int E>
__device__ __forceinline__ void top16_select(const uint32_t (&key)[E], bool (&sel)[E], int lane) {
  uint32_t prefix = 0;
  int k = 16, R = 64 * E, b = 31;
  for (; b >= 0; --b) {
    uint32_t cand = prefix | (1u << b);
    int cnt = 0;
#pragma unroll
    for (int e = 0; e < E; ++e) cnt += __popcll(__ballot((key[e] >> b) == (cand >> b)));
    if (cnt >= k) { prefix = cand; R = cnt; } else { k -= cnt; R -= cnt; }
    if (R == k) break;
  }
  if (R == k) {
    int bb = b < 0 ? 0 : b;
#pragma unroll
    for (int e = 0; e < E; ++e) sel[e] = (key[e] >> bb) >= (prefix >> bb);
    return;
  }
  int taken = 0;
  uint64_t lt = (lane == 0) ? 0ull : (~0ull >> (64 - lane));
#pragma unroll
  for (int e = 0; e < E; ++e) {
    bool eq = key[e] == prefix;
    uint64_t bm = __ballot(eq);
    int rank = taken + __popcll(bm & lt);
    sel[e] = (key[e] > prefix) || (eq && rank < k);
    taken += __popcll(bm);
  }
}
template <int CTRL>
__device__ __forceinline__ uint32_t dpp_u(uint32_t x) { return (uint32_t)__builtin_amdgcn_update_dpp(0, (int)x, CTRL, 0xf, 0xf, true); }
__device__ __forceinline__ uint32_t wave_max_u32(uint32_t x) {
  x = max(x, dpp_u<0xB1>(x));
  x = max(x, dpp_u<0x4E>(x));
  x = max(x, dpp_u<0x141>(x));
  x = max(x, dpp_u<0x140>(x));
  const uint32_t r0 = (uint32_t)__builtin_amdgcn_readlane((int)x, 0), r1 = (uint32_t)__builtin_amdgcn_readlane((int)x, 16);
  const uint32_t r2 = (uint32_t)__builtin_amdgcn_readlane((int)x, 32), r3 = (uint32_t)__builtin_amdgcn_readlane((int)x, 48);
  return max(max(r0, r1), max(r2, r3));
}
template <int NCH, int E>
__device__ __forceinline__ void top16_select_n(const uint32_t (&key)[NCH][E], bool (&sel)[NCH][E], int lane) {
  uint32_t prefix[NCH];
  int cntp[NCH];
#pragma unroll
  for (int c = 0; c < NCH; ++c) {
    uint32_t m = key[c][0];
#pragma unroll
    for (int e = 1; e < E; ++e) m = max(m, key[c][e]);
    prefix[c] = wave_max_u32(m) & 0xFF800000u;
    cntp[c] = 0;
  }
  int need = NCH;
  for (int j = 0; j < 6 && need != 0; ++j) {
    need = 0;
#pragma unroll
    for (int c = 0; c < NCH; ++c) {
      if (cntp[c] < 16) {
        if (j != 0) prefix[c] = prefix[c] >= 0x00800000u ? prefix[c] - 0x00800000u : 0u;
        int cnt = 0;
#pragma unroll
        for (int e = 0; e < E; ++e) cnt += __popcll(__ballot(key[c][e] >= prefix[c]));
        cntp[c] = cnt;
        need += (cnt < 16);
      }
    }
  }
  uint32_t startbit = 0x00400000u;
  if (need != 0) {
#pragma unroll
    for (int c = 0; c < NCH; ++c) { prefix[c] = 0; cntp[c] = 64 * E; }
    startbit = 0x80000000u;
  }
  int tot0 = 0;
#pragma unroll
  for (int c = 0; c < NCH; ++c) tot0 += cntp[c];
  if (tot0 != 16 * NCH)
  for (uint32_t bit = startbit; bit != 0u; bit >>= 1) {
    int tot = 0;
#pragma unroll
    for (int c = 0; c < NCH; ++c) {
      const uint32_t cand = prefix[c] | bit;
      int cnt = 0;
#pragma unroll
      for (int e = 0; e < E; ++e) cnt += __popcll(__ballot(key[c][e] >= cand));
      const bool up = cnt >= 16;
      prefix[c] = up ? cand : prefix[c];
      cntp[c] = up ? cnt : cntp[c];
      tot += cntp[c];
    }
    if (tot == 16 * NCH) break;
  }
  const uint64_t lt = (lane == 0) ? 0ull : (~0ull >> (64 - lane));
#pragma unroll
  for (int c = 0; c < NCH; ++c) {
    if (cntp[c] == 16) {
#pragma unroll
      for (int e = 0; e < E; ++e) sel[c][e] = key[c][e] >= prefix[c];
    } else {
      int ngt = 0;
#pragma unroll
      for (int e = 0; e < E; ++e) ngt += __popcll(__ballot(key[c][e] > prefix[c]));
      const int kk = 16 - ngt;
      int taken = 0;
#pragma unroll
      for (int e = 0; e < E; ++e) {
        bool eq = key[c][e] == prefix[c];
        uint64_t bm = __ballot(eq);
        sel[c][e] = (key[c][e] > prefix[c]) || (eq && taken + __popcll(bm & lt) < kk);
        taken += __popcll(bm);
      }
    }
  }
}
__device__ __forceinline__ void d_peer_topk(const float* __restrict__ scores, int* __restrict__ experts, float* __restrict__ gates, const int bid0, const int nb0, unsigned char* smem) {
  const int bid = sfresh(bid0), nb = sfresh(nb0);
  const int tidf = tid_fresh();
  int lane = tidf & 63, wave = tidf >> 6;
  float (*sv)[2][16] = (float (*)[2][16])(smem + wave * 512);
  int (*si)[2][16] = (int (*)[2][16])(smem + NWV * 512 + wave * 512);
  const uint64_t lt = (lane == 0) ? 0ull : (~0ull >> (64 - lane));
  for (int it0 = (bid * NWV + wave) * 2; it0 < NTOK * 8; it0 += nb * NWV * 2) {
    float s[4][2]; uint32_t key[4][2]; bool sel[4][2];
#pragma unroll
    for (int u = 0; u < 2; ++u) {
      const int it = it0 + u, t = it >> 3, h = it & 7;
      const float* sp = scores + (size_t)t * 2048 + h * 256;
#pragma unroll
      for (int c = 0; c < 2; ++c) { s[u * 2 + c][0] = sp[c * 128 + lane]; s[u * 2 + c][1] = sp[c * 128 + 64 + lane]; }
    }
#pragma unroll
    for (int c = 0; c < 4; ++c) { key[c][0] = fkey(s[c][0]); key[c][1] = fkey(s[c][1]); }
    top16_select_n<4, 2>(key, sel, lane);
#pragma unroll
    for (int c = 0; c < 4; ++c) {
      int base = 0;
#pragma unroll
      for (int e = 0; e < 2; ++e) {
        uint64_t bm = __ballot(sel[c][e]);
        if (sel[c][e]) { int p = base + __popcll(bm & lt); sv[c >> 1][c & 1][p] = s[c][e]; si[c >> 1][c & 1][p] = lane + 64 * e; }
        base += __popcll(bm);
      }
    }
    __builtin_amdgcn_wave_barrier();
    __threadfence_block();
    float cv[2][4]; uint32_t ck[2][4]; bool csel[2][4];
#pragma unroll
    for (int u = 0; u < 2; ++u)
#pragma unroll
      for (int e = 0; e < 4; ++e) {
        int ci = e * 64 + lane;
        cv[u][e] = sv[u][0][ci >> 4] + sv[u][1][ci & 15];
        ck[u][e] = fkey(cv[u][e]);
      }
    top16_select_n<2, 4>(ck, csel, lane);
#pragma unroll
    for (int u = 0; u < 2; ++u) {
      const int it = it0 + u, t = it >> 3, h = it & 7;
      float mx = -INFINITY;
#pragma unroll
      for (int e = 0; e < 4; ++e) if (csel[u][e]) mx = fmaxf(mx, cv[u][e]);
      mx = wave_max(mx);
      float ex[4], sum = 0.f;
#pragma unroll
      for (int e = 0; e < 4; ++e) { ex[e] = csel[u][e] ? expf(cv[u][e] - mx) : 0.f; sum += ex[e]; }
      sum = wave_sum(sum);
      float rinv = 1.f / sum;
      int base = 0;
#pragma unroll
      for (int e = 0; e < 4; ++e) {
        uint64_t bm = __ballot(csel[u][e]);
        if (csel[u][e]) {
          int p = base + __popcll(bm & lt);
          int ci = e * 64 + lane;
          experts[(size_t)t * 128 + h * 16 + p] = si[u][0][ci >> 4] * 128 + si[u][1][ci & 15];
          gates[(size_t)t * 128 + h * 16 + p] = ex[e] * rinv;
        }
        base += __popcll(bm);
      }
    }
    __builtin_amdgcn_wave_barrier();
    __threadfence_block();
  }
}

typedef __attribute__((ext_vector_type(8))) int i32x8;
typedef __attribute__((ext_vector_type(4))) int i32x4;
__device__ __forceinline__ void d_cvt_fp8(const float* __restrict__ src, unsigned char* __restrict__ dst, float* __restrict__ sinv, int rows,
                                          const int bid0, const int nb0, unsigned char* smem) {
  const int bid = sfresh(bid0), nb = sfresh(nb0);
  const int tidf = tid_fresh();
  const int lane = tidf & 63, wave = tidf >> 6;
  for (int row = bid * NWV + wave; row < rows; row += nb * NWV) {
    const f32x4* p = (const f32x4*)(src + (size_t)row * D_MODEL);
    f32x4 v[8];
    float amax = 0.f;
#pragma unroll
    for (int q = 0; q < 2; ++q)
#pragma unroll
      for (int k = 0; k < 4; ++k) {
        v[q * 4 + k] = p[q * 256 + lane * 4 + k];
#pragma unroll
        for (int j = 0; j < 4; ++j) amax = fmaxf(amax, fabsf(v[q * 4 + k][j]));
      }
    amax = wave_max(amax);
    float scale = 1.f, inv = 1.f;
    if (amax > 0.f) {
      int e = 134 - (int)((__float_as_uint(amax) >> 23) & 0xff);
      e = e > 120 ? 120 : (e < -120 ? -120 : e);
      scale = __uint_as_float((uint32_t)(e + 127) << 23);
      inv = __uint_as_float((uint32_t)(127 - e) << 23);
    }
#pragma unroll
    for (int q = 0; q < 2; ++q) {
      u32x4 o;
#pragma unroll
      for (int k = 0; k < 4; ++k) {
        int w = 0;
        w = __builtin_amdgcn_cvt_pk_fp8_f32(v[q * 4 + k][0] * scale, v[q * 4 + k][1] * scale, w, false);
        w = __builtin_amdgcn_cvt_pk_fp8_f32(v[q * 4 + k][2] * scale, v[q * 4 + k][3] * scale, w, true);
        o[k] = (unsigned)w;
      }
      *(u32x4*)(dst + (size_t)row * D_MODEL + q * 1024 + lane * 16) = o;
    }
    if (lane == 0) sinv[row] = inv;
  }
}

template <bool NATURAL>
__device__ __forceinline__ void d_cvt_fp4(const float* __restrict__ src, unsigned char* __restrict__ dst, float* __restrict__ sinv, int rows,
                                          const int bid0, const int nb0, unsigned char* smem) {
  const int bid = sfresh(bid0), nb = sfresh(nb0);
  const int tidf = tid_fresh();
  const int lane = tidf & 63, wave = tidf >> 6;
  for (int row = bid * NWV + wave; row < rows; row += nb * NWV) {
    const f32x4* p = (const f32x4*)(src + (size_t)row * D_MODEL);
    f32x4 v[8];
    float amax = 0.f;
#pragma unroll
    for (int q = 0; q < 2; ++q)
#pragma unroll
      for (int k = 0; k < 4; ++k) {
        v[q * 4 + k] = p[q * 256 + lane * 4 + k];
#pragma unroll
        for (int j = 0; j < 4; ++j) amax = fmaxf(amax, fabsf(v[q * 4 + k][j]));
      }
    amax = wave_max(amax);
    float scale = 1.f, inv = 1.f;
    if (amax > 0.f) { scale = 6.0f / amax; inv = amax * (1.0f / 6.0f); }
    u32x4 o;
#pragma unroll
    for (int k = 0; k < 4; ++k) {
      unsigned w = 0u;
      w = __builtin_amdgcn_cvt_scalef32_pk_fp4_f32(w, v[2 * k][0] * scale, v[2 * k][1] * scale, 1.0f, 0);
      w = __builtin_amdgcn_cvt_scalef32_pk_fp4_f32(w, v[2 * k][2] * scale, v[2 * k][3] * scale, 1.0f, 1);
      w = __builtin_amdgcn_cvt_scalef32_pk_fp4_f32(w, v[2 * k + 1][0] * scale, v[2 * k + 1][1] * scale, 1.0f, 2);
      w = __builtin_amdgcn_cvt_scalef32_pk_fp4_f32(w, v[2 * k + 1][2] * scale, v[2 * k + 1][3] * scale, 1.0f, 3);
      o[k] = w;
    }
    if (NATURAL) {
      uint2 lo; lo.x = o[0]; lo.y = o[1];
      uint2 hi; hi.x = o[2]; hi.y = o[3];
      *(uint2*)(dst + (size_t)row * (D_MODEL / 2) + lane * 8) = lo;
      *(uint2*)(dst + (size_t)row * (D_MODEL / 2) + 512 + lane * 8) = hi;
    } else {
      *(u32x4*)(dst + (size_t)row * (D_MODEL / 2) + lane * 16) = o;
    }
    if (lane == 0) sinv[row] = inv;
  }
}

struct PeerArgs {
  const float* x;
  const u16* xb;
  const float* scores;
  const unsigned char* U; const unsigned char* V;
  const float* usinv; const float* vsinv;
  const float* lnw; const float* lnb;
  float* outf; u16* outb; int exmask;
};
__device__ __forceinline__ float wave_total(float x) {
  x = row16_sum(x);
  float r0 = __int_as_float(__builtin_amdgcn_readlane(__float_as_int(x), 0));
  float r1 = __int_as_float(__builtin_amdgcn_readlane(__float_as_int(x), 16));
  float r2 = __int_as_float(__builtin_amdgcn_readlane(__float_as_int(x), 32));
  float r3 = __int_as_float(__builtin_amdgcn_readlane(__float_as_int(x), 48));
  return (r0 + r1) + (r2 + r3);
}
__device__ __forceinline__ float erf_as(float x) {
  const float ax = fabsf(x);
  const float t = __builtin_amdgcn_rcpf(fmaf(0.3275911f, ax, 1.0f));
  float p = fmaf(1.061405429f, t, -1.453152027f);
  p = fmaf(p, t, 1.421413741f);
  p = fmaf(p, t, -0.284496736f);
  p = fmaf(p, t, 0.254829592f);
  p *= t;
  const float e = __builtin_amdgcn_exp2f(-1.4426950408889634f * ax * ax);
  const float r = fmaf(-p, e, 1.0f);
  return copysignf(r, x);
}
__device__ __forceinline__ void peer_vhalf(f32x2& a0, f32x2& a1, f32x2& a2, f32x2& a3, f32x2& a4, f32x2& a5, f32x2& a6, f32x2& a7,
                                           unsigned w0, unsigned w1, uint64_t acs) {
  f32x2 t0, t1, t2, t3;
  asm("v_cvt_scalef32_pk_f32_fp4 %8, %12, 1.0\n\t"
      "v_cvt_scalef32_pk_f32_fp4 %9, %12, 1.0 op_sel:[1,0,0]\n\t"
      "v_cvt_scalef32_pk_f32_fp4 %10, %12, 1.0 op_sel:[0,1,0]\n\t"
      "v_cvt_scalef32_pk_f32_fp4 %11, %12, 1.0 op_sel:[1,1,0]\n\t"
      "v_pk_fma_f32 %0, %14, %8, %0 op_sel_hi:[0,1,1]\n\t"
      "v_pk_fma_f32 %1, %14, %9, %1 op_sel_hi:[0,1,1]\n\t"
      "v_pk_fma_f32 %2, %14, %10, %2 op_sel_hi:[0,1,1]\n\t"
      "v_pk_fma_f32 %3, %14, %11, %3 op_sel_hi:[0,1,1]\n\t"
      "v_cvt_scalef32_pk_f32_fp4 %8, %13, 1.0\n\t"
      "v_cvt_scalef32_pk_f32_fp4 %9, %13, 1.0 op_sel:[1,0,0]\n\t"
      "v_cvt_scalef32_pk_f32_fp4 %10, %13, 1.0 op_sel:[0,1,0]\n\t"
      "v_cvt_scalef32_pk_f32_fp4 %11, %13, 1.0 op_sel:[1,1,0]\n\t"
      "v_pk_fma_f32 %4, %14, %8, %4 op_sel_hi:[0,1,1]\n\t"
      "v_pk_fma_f32 %5, %14, %9, %5 op_sel_hi:[0,1,1]\n\t"
      "v_pk_fma_f32 %6, %14, %10, %6 op_sel_hi:[0,1,1]\n\t"
      "v_pk_fma_f32 %7, %14, %11, %7 op_sel_hi:[0,1,1]"
      : "+v"(a0), "+v"(a1), "+v"(a2), "+v"(a3), "+v"(a4), "+v"(a5), "+v"(a6), "+v"(a7), "=&v"(t0), "=&v"(t1), "=&v"(t2), "=&v"(t3)
      : "v"(w0), "v"(w1), "s"(acs));
}
__device__ __forceinline__ float wave_max_total(float x) {
  x = row16_max(x);
  float r0 = __int_as_float(__builtin_amdgcn_readlane(__float_as_int(x), 0));
  float r1 = __int_as_float(__builtin_amdgcn_readlane(__float_as_int(x), 16));
  float r2 = __int_as_float(__builtin_amdgcn_readlane(__float_as_int(x), 32));
  float r3 = __int_as_float(__builtin_amdgcn_readlane(__float_as_int(x), 48));
  return fmaxf(fmaxf(r0, r1), fmaxf(r2, r3));
}
#define PEER_G 8
__device__ __forceinline__ void peer_route(const float (&s)[2][2], float* rsv, int* rsi, int* rex, float* rgt, const int lane, const uint64_t ltm, const int exmask = -1) {
  __builtin_amdgcn_wave_barrier();
  uint32_t key[2][2]; bool sel[2][2];
#pragma unroll
  for (int c = 0; c < 2; ++c) { key[c][0] = fkey(s[c][0]); key[c][1] = fkey(s[c][1]); }
  top16_select_n<2, 2>(key, sel, lane);
#pragma unroll
  for (int c = 0; c < 2; ++c) {
    int base = 0;
#pragma unroll
    for (int e = 0; e < 2; ++e) {
      uint64_t bm = __ballot(sel[c][e]);
      if (sel[c][e]) { int p = base + __popcll(bm & ltm); rsv[c * 16 + p] = s[c][e]; rsi[c * 16 + p] = lane + 64 * e; }
      base += __popcll(bm);
    }
  }
  __builtin_amdgcn_wave_barrier();
  __threadfence_block();
  float cv[1][4]; uint32_t ck[1][4]; bool csel[1][4];
#pragma unroll
  for (int e = 0; e < 4; ++e) { int ci = e * 64 + lane; cv[0][e] = rsv[ci >> 4] + rsv[16 + (ci & 15)]; ck[0][e] = fkey(cv[0][e]); }
  top16_select_n<1, 4>(ck, csel, lane);
  int exid[4];
#pragma unroll
  for (int e = 0; e < 4; ++e) { int ci = e * 64 + lane; exid[e] = (rsi[ci >> 4] * 128 + rsi[16 + (ci & 15)]) & exmask; }
  float mx = -INFINITY;
#pragma unroll
  for (int e = 0; e < 4; ++e) if (csel[0][e]) mx = fmaxf(mx, cv[0][e]);
  mx = wave_max_total(mx);
  float exv[4], sum = 0.f;
#pragma unroll
  for (int e = 0; e < 4; ++e) { exv[e] = csel[0][e] ? __expf(cv[0][e] - mx) : 0.f; sum += exv[e]; }
  sum = wave_total(sum);
  const float rinv = __builtin_amdgcn_rcpf(sum);
  int base = 0;
#pragma unroll
  for (int e = 0; e < 4; ++e) {
    uint64_t bm = __ballot(csel[0][e]);
    if (csel[0][e]) { int p = base + __popcll(bm & ltm); rex[p] = exid[e]; rgt[p] = exv[e] * rinv; }
    base += __popcll(bm);
  }
  __builtin_amdgcn_wave_barrier();
  __threadfence_block();
}

__device__ __forceinline__ void d_peer(PeerArgs a, const int bid0, const int nb0, unsigned char* smem) {
  const int bid = sfresh(bid0), nb = sfresh(nb0);
  const int tidf = tid_fresh();
  float (*sAcc)[D_MODEL] = (float (*)[D_MODEL])smem;
  float* sRed = (float*)(smem + NWV * D_MODEL * 4);
  const int tid = tidf, lane = tid & 63, wave = tid >> 6;
  float* rsv = (float*)(smem + NWV * D_MODEL * 4 + 256 + wave * 512);
  int* rsi = (int*)(rsv + 32);
  int* rexb = rsi + 32;
  float* rgtb = (float*)(rexb + 32);
  int* sX8b = (int*)(smem + NWV * D_MODEL * 4 + 256 + NWV * 512);
  const uint64_t ltm = (lane == 0) ? 0ull : (~0ull >> (64 - lane));
  const int er = lane & 15, g4 = lane >> 4;
  if (bid >= NTOK) return;

  int t = bid;
  f32x4 xcur = *(const f32x4*)(a.x + (size_t)t * D_MODEL + tid * 4);
  float sc[2][2];
  {
    const float* sp = a.scores + (size_t)t * 2048 + wave * 256;
#pragma unroll
    for (int c = 0; c < 2; ++c) { sc[c][0] = sp[c * 128 + lane]; sc[c][1] = sp[c * 128 + 64 + lane]; }
  }
  peer_route(sc, rsv, rsi, rexb, rgtb, lane, ltm, a.exmask);
  {
    int w = 0;
    w = __builtin_amdgcn_cvt_pk_fp8_f32(xcur[0], xcur[1], w, false);
    w = __builtin_amdgcn_cvt_pk_fp8_f32(xcur[2], xcur[3], w, true);
    sX8b[tid] = w;
  }
  i32x4 uu[16]; u32x4 vv[16]; f32x4 us4, vs4;
  {
    const unsigned char* up = a.U + (size_t)rexb[er] * (D_MODEL / 2) + g4 * 16;
#pragma unroll
    for (int s = 0; s < 16; ++s) uu[s] = *(const i32x4*)(up + s * 64);
#pragma unroll
    for (int e = 0; e < 16; ++e) vv[e] = *(const u32x4*)(a.V + (size_t)rexb[e] * (D_MODEL / 2) + lane * 16);
    const i32x4 ex4 = *(const i32x4*)(rexb + g4 * 4);
#pragma unroll
    for (int r = 0; r < 4; ++r) { us4[r] = a.usinv[ex4[r]]; vs4[r] = a.vsinv[ex4[r]]; }
  }
  int tn = (t + nb < NTOK) ? t + nb : t;
  f32x4 xnext = *(const f32x4*)(a.x + (size_t)tn * D_MODEL + tid * 4);
  {
    const float* sp = a.scores + (size_t)tn * 2048 + wave * 256;
#pragma unroll
    for (int c = 0; c < 2; ++c) { sc[c][0] = sp[c * 128 + lane]; sc[c][1] = sp[c * 128 + 64 + lane]; }
  }
  __syncthreads();
  int cur = 0;
  for (; t < NTOK; t += nb, cur ^= 1) {
    tn = (t + nb < NTOK) ? t + nb : t;
    const int tnn = (tn + nb < NTOK) ? tn + nb : tn;
    int* rexc = rexb + cur * 16; float* rgtc = rgtb + cur * 16;
    int* rexn = rexb + (cur ^ 1) * 16; float* rgtn = rgtb + (cur ^ 1) * 16;
    peer_route(sc, rsv, rsi, rexn, rgtn, lane, ltm, a.exmask);
    {
      int w = 0;
      w = __builtin_amdgcn_cvt_pk_fp8_f32(xnext[0], xnext[1], w, false);
      w = __builtin_amdgcn_cvt_pk_fp8_f32(xnext[2], xnext[3], w, true);
      sX8b[(cur ^ 1) * 512 + tid] = w;
    }
    {
      const float* sp = a.scores + (size_t)tnn * 2048 + wave * 256;
#pragma unroll
      for (int c = 0; c < 2; ++c) { sc[c][0] = sp[c * 128 + lane]; sc[c][1] = sp[c * 128 + 64 + lane]; }
    }
    f32x4 acv;
    {
      const f32x4 gt4 = *(const f32x4*)(rgtc + g4 * 4);
      f32x4 c0 = (f32x4){0.f, 0.f, 0.f, 0.f}, c1 = c0;
      const i32x4* xp = (const i32x4*)((const unsigned char*)(sX8b + cur * 512) + g4 * 16);
      i32x4 bq[2][4];
#define PB_LOAD(G, S0) { bq[G][0] = xp[(S0) * 8]; bq[G][1] = xp[(S0) * 8 + 4]; bq[G][2] = xp[((S0) + 1) * 8]; bq[G][3] = xp[((S0) + 1) * 8 + 4]; }
#define PB_MMA(G, S0) { \
        { const i32x8 av = (i32x8){uu[S0][0], uu[S0][1], uu[S0][2], uu[S0][3], 0, 0, 0, 0}; \
          const i32x8 bv = (i32x8){bq[G][0][0], bq[G][0][1], bq[G][0][2], bq[G][0][3], bq[G][1][0], bq[G][1][1], bq[G][1][2], bq[G][1][3]}; \
          c0 = __builtin_amdgcn_mfma_scale_f32_16x16x128_f8f6f4(av, bv, c0, 4, 0, 0, 0x7f7f7f7f, 0, 0x7f7f7f7f); } \
        { const i32x8 av = (i32x8){uu[(S0) + 1][0], uu[(S0) + 1][1], uu[(S0) + 1][2], uu[(S0) + 1][3], 0, 0, 0, 0}; \
          const i32x8 bv = (i32x8){bq[G][2][0], bq[G][2][1], bq[G][2][2], bq[G][2][3], bq[G][3][0], bq[G][3][1], bq[G][3][2], bq[G][3][3]}; \
          c1 = __builtin_amdgcn_mfma_scale_f32_16x16x128_f8f6f4(av, bv, c1, 4, 0, 0, 0x7f7f7f7f, 0, 0x7f7f7f7f); } }
      PB_LOAD(0, 0);
      __builtin_amdgcn_sched_barrier(0);
#pragma unroll
      for (int s = 0; s < 16; s += 4) {
        PB_LOAD(1, s + 2);
        PB_MMA(0, s);
        __builtin_amdgcn_sched_barrier(0);
        if (s + 4 < 16) PB_LOAD(0, s + 4);
        PB_MMA(1, s + 2);
        __builtin_amdgcn_sched_barrier(0);
      }
#undef PB_LOAD
#undef PB_MMA
#pragma unroll
      for (int r = 0; r < 4; ++r) {
        float h = (c0[r] + c1[r]) * us4[r];
        acv[r] = 0.5f * h * (1.f + erf_as(h * 0.70710678118654752f)) * gt4[r] * vs4[r];
      }
    }
    f32x2 acc[16];
#pragma unroll
    for (int i = 0; i < 16; ++i) acc[i] = (f32x2){0.f, 0.f};
    {
      __builtin_amdgcn_sched_barrier(0);
      const unsigned char* up = a.U + (size_t)rexn[er] * (D_MODEL / 2) + g4 * 16;
#pragma unroll
      for (int s = 0; s < 16; ++s) uu[s] = *(const i32x4*)(up + s * 64);
      const i32x4 ex4 = *(const i32x4*)(rexn + g4 * 4);
#pragma unroll
      for (int r = 0; r < 4; ++r) { us4[r] = a.usinv[ex4[r]]; vs4[r] = a.vsinv[ex4[r]]; }
      __builtin_amdgcn_sched_barrier(0);
    }
    int exn = rexn[0];
#pragma unroll
    for (int e = 0; e < 16; ++e) {
      const uint64_t acs = (uint64_t)(uint32_t)__builtin_amdgcn_readlane(__float_as_int(acv[e & 3]), 16 * (e >> 2));
      const u32x4 vw = vv[e];
      peer_vhalf(acc[0], acc[1], acc[2], acc[3], acc[4], acc[5], acc[6], acc[7], vw[0], vw[1], acs);
      peer_vhalf(acc[8], acc[9], acc[10], acc[11], acc[12], acc[13], acc[14], acc[15], vw[2], vw[3], acs);
      const uint32_t voff = (uint32_t)exn * (D_MODEL / 2) + (uint32_t)lane * 16u;
      if (e + 1 < 16) exn = rexn[e + 1];
      vv[e] = *(const u32x4*)(a.V + voff);
      __builtin_amdgcn_sched_barrier(0);
    }
#pragma unroll
    for (int q = 0; q < 2; ++q)
#pragma unroll
      for (int k = 0; k < 4; ++k)
        *(f32x4*)(&sAcc[wave][q * 1024 + lane * 16 + k * 4]) = (f32x4){acc[q * 8 + k * 2][0], acc[q * 8 + k * 2][1], acc[q * 8 + k * 2 + 1][0], acc[q * 8 + k * 2 + 1][1]};
    const f32x4 lw4 = *(const f32x4*)(a.lnw + tid * 4), lb4 = *(const f32x4*)(a.lnb + tid * 4);
    __syncthreads();
    float pre[4];
#pragma unroll
    for (int j = 0; j < 4; ++j) {
      float acc8 = 0.f;
#pragma unroll
      for (int w = 0; w < NWV; ++w) acc8 += sAcc[w][tid * 4 + j];
      pre[j] = ALPHA * xcur[j] + acc8;
    }
    xcur = xnext;
    xnext = *(const f32x4*)(a.x + (size_t)tnn * D_MODEL + tid * 4);
    float s = (pre[0] + pre[1]) + (pre[2] + pre[3]);
    s = wave_total(s);
    if (lane == 0) sRed[wave] = s;
    __syncthreads();
    float mu = 0.f;
#pragma unroll
    for (int w = 0; w < NWV; ++w) mu += sRed[w];
    mu *= (1.f / D_MODEL);
    float q2 = 0.f;
#pragma unroll
    for (int j = 0; j < 4; ++j) { float d = pre[j] - mu; q2 += d * d; }
    q2 = wave_total(q2);
    if (lane == 0) sRed[NWV + wave] = q2;
    __syncthreads();
    float var = 0.f;
#pragma unroll
    for (int w = 0; w < NWV; ++w) var += sRed[NWV + w];
    float rs = rsqrtf(var * (1.f / D_MODEL) + 1e-5f);
    f32x4 o;
#pragma unroll
    for (int j = 0; j < 4; ++j) o[j] = (pre[j] - mu) * rs * lw4[j] + lb4[j];
    *(f32x4*)(a.outf + (size_t)t * D_MODEL + tid * 4) = o;
    if (a.outb) {
      uint2 ob; ob.x = pack2(o[0], o[1]); ob.y = pack2(o[2], o[3]);
      *(uint2*)(a.outb + (size_t)t * D_MODEL + tid * 4) = ob;
    }
  }
}

#define XB_TMO      128
#define XB_XCNT(j)  (256  + 64 * (j))
#define XB_XSUB(j)  (1280 + 64 * (j))
#define XB_XGEN(j)  (2304 + 64 * (j))
#define XB_TOP      3328
#define XB_TOPGEN   3392
#define XB_QUEUE(j) (3456 + 64 * (j))
#define XCD_BAR_WORDS 3712
#define XB_SPIN_CAP (1u << 22)
#define LAS __attribute__((address_space(3)))
__device__ __forceinline__ unsigned xb_ld(unsigned* p)              { return __hip_atomic_load(p, __ATOMIC_RELAXED, __HIP_MEMORY_SCOPE_AGENT); }
__device__ __forceinline__ unsigned xb_add(unsigned* p, unsigned v) { return __hip_atomic_fetch_add(p, v, __ATOMIC_RELAXED, __HIP_MEMORY_SCOPE_AGENT); }
__device__ __forceinline__ unsigned xb_xcc_id() { return (unsigned)__builtin_amdgcn_s_getreg((3 << 11) | 20) & 0xFu; }
#define XB_SPIN(cond, bar) do { unsigned _sp = 0; while (cond) { __builtin_amdgcn_s_sleep(1); \
    if ((++_sp & 255u) == 0u) { if (xb_ld(&(bar)[XB_TMO])) break; if (_sp > XB_SPIN_CAP) { atomicAdd(&(bar)[XB_TMO], 1u); break; } } } } while (0)
struct XcdBarrier { unsigned* bar; unsigned x; volatile LAS unsigned* st; };
__device__ __forceinline__ XcdBarrier xcd_barrier_post(unsigned* bar, volatile LAS unsigned* st) {
  XcdBarrier b; b.bar = bar; b.x = xb_xcc_id(); b.st = st;
  if (threadIdx.x == 0) (void)xb_add(&bar[XB_XCNT(b.x)], 1u);
  return b;
}
__device__ __forceinline__ void xcd_barrier_complete(unsigned* bar, unsigned x, unsigned& nloc, unsigned& nx) {
  const unsigned G = gridDim.x * gridDim.y * gridDim.z;
  unsigned sum, cnt, mine, sp = 0u;
  for (;;) {
    sum = 0u; cnt = 0u; mine = 0u;
#pragma unroll
    for (unsigned j = 0; j < 16; ++j) { const unsigned c = xb_ld(&bar[XB_XCNT(j)]); sum += c; cnt += (c > 0u) ? 1u : 0u; mine = (j == x) ? c : mine; }
    if (sum == G) break;
    __builtin_amdgcn_s_sleep(1);
    if ((++sp & 255u) == 0u) { if (xb_ld(&bar[XB_TMO])) break; if (sp > XB_SPIN_CAP) { atomicAdd(&bar[XB_TMO], 1u); break; } }
  }
  nloc = mine > 0u ? mine : 1u; nx = cnt > 0u ? cnt : 1u;
}
__device__ __forceinline__ void xcd_barrier(const XcdBarrier& b) {
  asm volatile("s_waitcnt vmcnt(0)" ::: "memory");
  __syncthreads();
  if (threadIdx.x == 0) {
    unsigned* bar = b.bar;
    __builtin_amdgcn_s_waitcnt(0);
    unsigned nloc = b.st[0], nx = b.st[1];
    if (nloc == 0u) { xcd_barrier_complete(bar, b.x, nloc, nx); b.st[0] = nloc; b.st[1] = nx; }
    const unsigned old = xb_add(&bar[XB_XSUB(b.x)], 1u);
    const unsigned gen = old / nloc;
    if (old + 1u == (gen + 1u) * nloc) {
      __builtin_amdgcn_fence(__ATOMIC_RELEASE, "agent");
      asm volatile("s_waitcnt vmcnt(0)" ::: "memory");
      const unsigned og = xb_add(&bar[XB_TOP], 1u);
      const unsigned tg = og / nx;
      if (og + 1u == (tg + 1u) * nx) xb_add(&bar[XB_TOPGEN], 1u);
      else XB_SPIN(xb_ld(&bar[XB_TOPGEN]) == tg, bar);
      __builtin_amdgcn_fence(__ATOMIC_ACQUIRE, "agent");
      xb_add(&bar[XB_XGEN(b.x)], 1u);
      asm volatile("s_waitcnt vmcnt(0)" ::: "memory");
    } else {
      XB_SPIN(xb_ld(&bar[XB_XGEN(b.x)]) == gen, bar);
      __builtin_amdgcn_fence(__ATOMIC_ACQUIRE, "agent");
      asm volatile("s_waitcnt vmcnt(0)" ::: "memory");
    }
  }
  __syncthreads();
}

struct MegaParams {
  const float* x_in; const float* mem; const int* positions; const float* w_in; const float* shift_mu; const float* w0; const float* w_up;
  const float* a0; const float* a_up; const float* g_up; const float* k_k; const float* k_a; const float* r_k; const float* lnx_w; const float* lnx_b;
  const float* lam_q1; const float* lam_k1; const float* lam_q2; const float* lam_k2; const float* subln_w; const float* w_out;
  const float* ln1_w; const float* ln1_b; const float* xq; const float* xk; const float* xv; const float* xo; const float* ln2_w; const float* ln2_b;
  const float* pq; const float* subkeys; const float* peer_u; const float* peer_v; const float* ln3_w; const float* ln3_b;
  float* out;
  float* X; float* lnstat; u16* xb; u16* memb; u16* WinT; u16* WoutT; u16* xqT; u16* xkT; u16* xvT; u16* xoT; u16* pqT; u16* loraT; u16* skb; u16* cat;
  float* ropetab; u16* Qb; u16* Kb; u16* Vt;
  float* proj; u16* lin; float* lw; float* la; float* gate; float* wrec; u16* prec; float* bon; float* yraw;
  float* qx0; float* qx1; u16* Kx; u16* Vxt; u16* ox;
  unsigned char* Ub; unsigned char* Vb; float* usinv; float* vsinv; u16* qp; float* scores; int* experts; float* gates;
  unsigned* bar;
};

__device__ __forceinline__ GemmArgs mk_gemm(const u16* A, int lda, const u16* Bt, int ldb, int M, int N, int K, float* Cf, u16* Cb, int ldc,
                                            const float* res = nullptr, float alpha = 0.f) {
  GemmArgs g;
  g.A = A; g.Bt = Bt; g.lda = lda; g.ldb = ldb; g.M = M; g.N = N; g.K = K; g.Cf = Cf; g.Cb = Cb; g.ldc = ldc; g.res = res; g.alpha = alpha;
  g.tab = nullptr; g.Cb2 = nullptr;
  return g;
}

template <typename T, unsigned OFF>
__device__ __forceinline__ T ldarg() {
  unsigned long long v;
  asm volatile("s_load_dwordx2 %0, %1, %2\n\ts_waitcnt lgkmcnt(0)" : "=s"(v) : "s"(__builtin_amdgcn_kernarg_segment_ptr()), "i"(OFF) : "memory");
  return (T)(__attribute__((address_space(1))) void*)v;
}
#define LP(field) ldarg<decltype(MegaParams::field), (unsigned)offsetof(MegaParams, field)>()
#ifndef REPEAT_MASK
#define REPEAT_MASK 0
#endif
#ifndef PROBE_EXMASK
#define PROBE_EXMASK -1
#endif
#define REP(bit) for (int rep_ = 0; rep_ < (((REPEAT_MASK) >> (bit)) & 1) + 1; ++rep_)
#define SMEM_BYTES 131072
__global__ __launch_bounds__(NT, 2) void mega(MegaParams p, int ph_lo, int ph_hi) {
  int ph = 0;
  __shared__ __attribute__((aligned(1024))) unsigned char smem_all[SMEM_BYTES + 16];
  unsigned char* smem = smem_all;
  volatile LAS unsigned* st = (volatile LAS unsigned*)(smem_all + SMEM_BYTES);
  const int bid = blockIdx.x, nb = gridDim.x;
  if (threadIdx.x < 4) st[threadIdx.x] = 0u;
  if (bid == 0 && ph_hi - ph_lo > 1) { unsigned* bw = LP(bar); for (int i = threadIdx.x; i < XCD_BAR_WORDS; i += NT) bw[i] = 0u; }
  __syncthreads();
  XcdBarrier xb_;
  const size_t T = NTOK;

  if (ph >= ph_lo && ph < ph_hi) {
  d_cvt(LP(x_in), LP(xb), T * 2048 / 8, bid, nb, smem);
  d_cvt(LP(mem), LP(memb), (size_t)BATCH * MEM_LEN * 2048 / 8, bid, nb, smem);
  d_rope_table(LP(positions), LP(ropetab), bid, nb, smem);
  }

  for (int l = 0; l < DEPTH; ++l) {
    const float* xres = (l == 0) ? LP(x_in) : LP(X);
    u16* wupT = LP(loraT); u16* aupT = LP(loraT) + 1024 * 64; u16* gupT = LP(loraT) + 2 * 1024 * 64;
    if (ph >= ph_lo && ph < ph_hi) {
    REP(6) {
    d_cvt_t(LP(w_in) + (size_t)l * 2048 * N_IN, LP(WinT), 2048, N_IN, 2048, bid, nb, smem);
    d_cvt_t(LP(w_out) + (size_t)l * 2048 * 2048, LP(WoutT), 2048, 2048, 2048, bid, nb, smem);
    d_cvt_t(LP(xq) + (size_t)l * 2048 * 512, LP(xqT), 2048, 512, 2048, bid, nb, smem);
    d_cvt_t(LP(xk) + (size_t)l * 2048 * 512, LP(xkT), 2048, 512, 2048, bid, nb, smem);
    d_cvt_t(LP(xv) + (size_t)l * 2048 * 512, LP(xvT), 2048, 512, 2048, bid, nb, smem);
    d_cvt_t(LP(xo) + (size_t)l * 512 * 2048, LP(xoT), 512, 2048, 512, bid, nb, smem);
    d_cvt_t(LP(pq) + (size_t)l * 2048 * 2048, LP(pqT), 2048, 2048, 2048, bid, nb, smem);
    d_cvt_t(LP(w_up) + (size_t)l * 64 * 1024, wupT, 64, 1024, 64, bid, nb, smem);
    d_cvt_t(LP(a_up) + (size_t)l * 64 * 1024, aupT, 64, 1024, 64, bid, nb, smem);
    d_cvt_t(LP(g_up) + (size_t)l * 160 * 1024, gupT, 160, 1024, 192, bid, nb, smem);
    { const int tz = tid_fresh(); for (int c = sfresh(bid); c < 1024 * 32 / NT; c += nb) { const int i = c * NT + tz; gupT[(size_t)(i >> 5) * 192 + 160 + (i & 31)] = 0; } }
    { const int tz = tid_fresh(); const float* sk = LP(subkeys) + (size_t)l * 2 * 128 * 128; u16* bd = LP(skb);
      for (int c = sfresh(bid); c < 256 * 256 / NT; c += nb) {
        const int i = c * NT + tz;
        int n = i >> 8, k = i & 255;
        bd[i] = ((n >> 7) == (k >> 7)) ? f2bf(sk[(size_t)(n >> 7) * 16384 + (n & 127) * 128 + (k & 127)]) : (u16)0;
      } }
    }
    }
    if (ph >= ph_lo && ph + 1 < ph_hi) { if (l == 0) { cg::this_grid().sync(); xb_ = xcd_barrier_post(LP(bar), st); } else xcd_barrier(xb_); }
    ++ph;

    if (ph >= ph_lo && ph < ph_hi) {
    REP(0) {
      int base = 0;
      (void)base;
      gemm8(smem, G8Gemm{LP(xb), LP(WinT), 2048, 2048, NTOK, RCOLS, 2048}, G8EpiF32{LP(proj), RCOLS, RCOLS}, bid, nb);
      gemm8(smem, G8Gemm{LP(xb), LP(WinT) + (size_t)RCOLS * 2048, 2048, 2048, NTOK, 2048, 2048}, G8EpiRope{LP(ropetab), LP(Qb), LP(Kb)}, bid, nb);
      gemm8(smem, G8Gemm{LP(WinT) + (size_t)(RCOLS + 2048) * 2048, LP(xb), 2048, 2048, 1024, NTOK, 2048}, G8EpiBf16{LP(Vt), NTOK, 1}, bid, nb);
    }
    }
    if (ph >= ph_lo && ph + 1 < ph_hi) xcd_barrier(xb_);
    ++ph;
    if (ph >= ph_lo && ph < ph_hi) {
    REP(7) d_rwkv_prep1(LP(proj), LP(shift_mu) + (size_t)l * RCOLS, LP(lin), bid, nb, smem);
    }
    if (ph >= ph_lo && ph + 1 < ph_hi) xcd_barrier(xb_);
    ++ph;
    if (ph >= ph_lo && ph < ph_hi) {
    REP(0) {
      int base = 0;
      base = gemm_run<0>(mk_gemm(LP(lin), LORA_LD, wupT, 64, NTOK, 1024, 64, LP(lw), nullptr, 1024), base, bid, nb, smem);
      base = gemm_run<0>(mk_gemm(LP(lin) + 64, LORA_LD, aupT, 64, NTOK, 1024, 64, LP(la), nullptr, 1024), base, bid, nb, smem);
      base = gemm_run<0>(mk_gemm(LP(lin) + 128, LORA_LD, gupT, 192, NTOK, 1024, 192, LP(gate), nullptr, 1024), base, bid, nb, smem);
    }
    }
    if (ph >= ph_lo && ph + 1 < ph_hi) xcd_barrier(xb_);
    ++ph;
    if (ph >= ph_lo && ph < ph_hi) {
    {
      Prep2Args a;
      a.proj = LP(proj); a.mu = LP(shift_mu) + (size_t)l * RCOLS; a.lw = LP(lw); a.la = LP(la);
      a.w0 = LP(w0) + l * RW; a.a0 = LP(a0) + l * RW; a.k_k = LP(k_k) + l * RW; a.k_a = LP(k_a) + l * RW; a.r_k = LP(r_k) + l * RW;
      a.wrec = LP(wrec); a.prec = LP(prec); a.bon = LP(bon);
      REP(7) d_rwkv_prep2(a, bid, nb, smem);
    }
    }
    if (ph >= ph_lo && ph + 1 < ph_hi) xcd_barrier(xb_);
    ++ph;
    if (ph >= ph_lo && ph < ph_hi) {
    {
      TabCvt tc; tc.pu = nullptr; tc.pv = nullptr; tc.Ub = LP(Ub); tc.Vb = LP(Vb); tc.usinv = LP(usinv); tc.vsinv = LP(vsinv);
      if (nb == SCAN_ITEMS) { tc.pu = LP(peer_u) + (size_t)l * 16384 * 2048; tc.pv = LP(peer_v) + (size_t)l * 16384 * 2048; }
      REP(3) d_rwkv_scan(LP(wrec), LP(prec), LP(yraw), tc, bid, nb, smem);
    }
    }
    if (ph >= ph_lo && ph < ph_hi) {
    {
      AttnArgs a;
      a.Q = LP(Qb); a.ldq = 1024; a.K = LP(Kb); a.ldk = 1024; a.Vt = LP(Vt); a.ldv = NTOK; a.O = LP(cat); a.ldo = 2048; a.ocol0 = 1024;
      a.nb = BATCH; a.nh = 8; a.sq = SEQ; a.sk = SEQ; a.scale = 0.125f;
      a.lq1 = LP(lam_q1) + l * 64; a.lk1 = LP(lam_k1) + l * 64; a.lq2 = LP(lam_q2) + l * 64; a.lk2 = LP(lam_k2) + l * 64;
      a.subw = LP(subln_w) + l * 128; a.lam_init = (l == 0) ? 0.2f : 0.35550906759096927f; a.Qf0 = a.Qf1 = nullptr;
      if (nb == 256) {
        REP(1) {
          const int xcd = bid & 7, slot = bid >> 3;
          const int bh = xcd * 4 + (slot >> 3), g = slot & 7;
          for (int k = 1; k >= 0; --k) {
            const int qb = k ? (15 - g) : g;
            attn2_item(a, LP(la), bh / 8, bh % 8, qb, 0, smem);
            attn2_item(a, LP(la), bh / 8, bh % 8, qb, 1, smem);
          }
        }
      } else {
        REP(1) for (int i = bid; i < 512; i += nb) {
          const int qb = 15 - (i >> 5), bh = i & 31;
          attn2_item(a, LP(la), bh / 8, bh % 8, qb, 0, smem);
          attn2_item(a, LP(la), bh / 8, bh % 8, qb, 1, smem);
        }
      }
    }
    }
    if (ph >= ph_lo && ph + 1 < ph_hi) xcd_barrier(xb_);
    ++ph;
    if (ph >= ph_lo && ph < ph_hi) {
    REP(7) d_rwkv_post(LP(yraw), LP(proj), LP(shift_mu) + (size_t)l * RCOLS, LP(bon), LP(gate), LP(lnx_w) + l * RW, LP(lnx_b) + l * RW, LP(cat), bid, nb, smem);
    }
    if (ph >= ph_lo && ph + 1 < ph_hi) xcd_barrier(xb_);
    ++ph;
    if (ph >= ph_lo && ph < ph_hi) {
    gemm8(smem, G8Gemm{LP(cat), LP(WoutT), 2048, 2048, NTOK, 2048, 2048}, G8EpiRes{LP(X), xres, 2048, ALPHA}, bid, nb);
    }
    if (ph >= ph_lo && ph + 1 < ph_hi) xcd_barrier(xb_);
    ++ph;
    if (ph >= ph_lo && ph < ph_hi) {
    REP(5) d_ln(LP(X), LP(ln1_w) + l * 2048, LP(ln1_b) + l * 2048, nullptr, LP(xb), LP(lnstat), NTOK, bid, nb, smem);
    }
    if (ph >= ph_lo && ph + 1 < ph_hi) xcd_barrier(xb_);
    ++ph;
    if (ph >= ph_lo && ph < ph_hi) {
    REP(0) {
      int base = 0;
      (void)base;
      gemm8(smem, G8Gemm{LP(xb), LP(xqT), 2048, 2048, NTOK, 512, 1024}, G8EpiF32{LP(qx0), 512, 512}, bid, nb);
      gemm8(smem, G8Gemm{LP(xb) + 1024, LP(xqT) + 1024, 2048, 2048, NTOK, 512, 1024}, G8EpiF32{LP(qx1), 512, 512}, (bid + 128) % nb, nb);
      gemm8(smem, G8Gemm{LP(memb), LP(xkT), 2048, 2048, BATCH * MEM_LEN, 512, 2048}, G8EpiBf16{LP(Kx), 512, 0}, bid, nb);
      gemm8(smem, G8Gemm{LP(xvT), LP(memb), 2048, 2048, 512, BATCH * MEM_LEN, 2048}, G8EpiBf16{LP(Vxt), BATCH * MEM_LEN, nb == 256 ? 1 : 0}, (bid + 8) % nb, nb);
    }
    }
    if (ph >= ph_lo && ph + 1 < ph_hi) xcd_barrier(xb_);
    ++ph;
    if (ph >= ph_lo && ph < ph_hi) {
    {
      AttnArgs a;
      a.Q = nullptr; a.Qf0 = LP(qx0); a.Qf1 = LP(qx1); a.ldq = 512; a.K = LP(Kx); a.ldk = 512; a.Vt = LP(Vxt); a.ldv = BATCH * MEM_LEN; a.O = LP(ox); a.ldo = 512; a.ocol0 = 0;
      a.nb = BATCH; a.nh = 4; a.sq = SEQ; a.sk = MEM_LEN; a.scale = 0.08838834764831845f;
      a.lq1 = a.lk1 = a.lq2 = a.lk2 = a.subw = nullptr; a.lam_init = 0.f;
      const int nitems = BATCH * 4 * (SEQ / 64);
      const int grp = tid_fresh() >> 8;
      if (nb == 256) {
        REP(2) { const int bh = (bid & 7) * 2 + ((bid >> 3) >> 4), qb = (bid >> 3) & 15; xattn2_item(a, bh / 4, bh % 4, qb, smem); }
      } else {
      REP(2) for (int it0 = bid * 2; it0 < nitems; it0 += nb * 2) {
        int it = it0 + grp;
        int qt = it / 16, bh = it % 16;
        attn_item<128, 1, false>(a, bh / 4, bh % 4, qt, (u16*)(smem + grp * 46080));
      }
      }
    }
    }
    if (ph >= ph_lo && ph + 1 < ph_hi) xcd_barrier(xb_);
    ++ph;
    if (ph >= ph_lo && ph < ph_hi) {
    gemm8(smem, G8Gemm{LP(ox), LP(xoT), 512, 512, NTOK, 2048, 512}, G8EpiResLn{LP(X), LP(lnstat), LP(ln1_w) + l * 2048, LP(ln1_b) + l * 2048, 2048, ALPHA}, bid, nb);
    }
    if (ph >= ph_lo && ph + 1 < ph_hi) xcd_barrier(xb_);
    ++ph;
    if (ph >= ph_lo && ph < ph_hi) {
    d_ln(LP(X), LP(ln2_w) + l * 2048, LP(ln2_b) + l * 2048, LP(X), LP(xb), nullptr, NTOK, bid, nb, smem);
    if (nb != SCAN_ITEMS) {
    REP(6) d_cvt_fp4<true>(LP(peer_u) + (size_t)l * 16384 * 2048, LP(Ub), LP(usinv), 16384, bid, nb, smem);
    REP(6) d_cvt_fp4<false>(LP(peer_v) + (size_t)l * 16384 * 2048, LP(Vb), LP(vsinv), 16384, bid, nb, smem);
    }
    }
    if (ph >= ph_lo && ph + 1 < ph_hi) xcd_barrier(xb_);
    ++ph;
    if (ph >= ph_lo && ph < ph_hi) {
    REP(0) gemm8(smem, G8Gemm{LP(xb), LP(pqT), 2048, 2048, NTOK, 2048, 2048}, G8EpiBf16{LP(qp), 2048, 0}, bid, nb);
    }
    if (ph >= ph_lo && ph + 1 < ph_hi) xcd_barrier(xb_);
    ++ph;
    if (ph >= ph_lo && ph < ph_hi) {
    REP(0) {
      int base = 0;
      gemm8(smem, G8Gemm{LP(qp), LP(skb), 2048, 256, NTOK, 2048, 256, 256 * 2, 1}, G8EpiF32{LP(scores), 2048, 2048}, bid, nb);
    }
    }
    if (ph >= ph_lo && ph + 1 < ph_hi) xcd_barrier(xb_);
    ++ph;
    if (ph >= ph_lo && ph < ph_hi) {
    {
      PeerArgs a;
      a.x = LP(X); a.xb = LP(xb); a.scores = LP(scores); a.U = LP(Ub); a.V = LP(Vb); a.usinv = LP(usinv); a.vsinv = LP(vsinv);
      a.lnw = LP(ln3_w) + l * 2048; a.lnb = LP(ln3_b) + l * 2048;
      bool last = (l == DEPTH - 1);
      a.outf = last ? LP(out) : LP(X);
      a.outb = last ? nullptr : LP(xb); a.exmask = -1;
      if ((REPEAT_MASK >> 4) & 1) { PeerArgs d = a; d.outf = LP(out); d.outb = nullptr; d.exmask = PROBE_EXMASK; d_peer(d, bid, nb, smem); }
      d_peer(a, bid, nb, smem);
    }
    }
    if (l + 1 < DEPTH && ph >= ph_lo && ph + 1 < ph_hi) xcd_barrier(xb_);
    ++ph;
  }
}

static inline size_t al(size_t x) { return (x + 255) & ~(size_t)255; }

extern "C" void kernel_launch(void* const* d_in, const int* in_sizes, int n_in, void* d_out, int out_size, void* d_ws, size_t ws_size,
                              hipStream_t stream) {
  MegaParams p;
  memset(&p, 0, sizeof(p));
  p.x_in = (const float*)d_in[0]; p.mem = (const float*)d_in[1]; p.positions = (const int*)d_in[2]; p.w_in = (const float*)d_in[3];
  p.shift_mu = (const float*)d_in[4]; p.w0 = (const float*)d_in[5]; p.w_up = (const float*)d_in[6]; p.a0 = (const float*)d_in[7];
  p.a_up = (const float*)d_in[8]; p.g_up = (const float*)d_in[9]; p.k_k = (const float*)d_in[10]; p.k_a = (const float*)d_in[11];
  p.r_k = (const float*)d_in[12]; p.lnx_w = (const float*)d_in[13]; p.lnx_b = (const float*)d_in[14]; p.lam_q1 = (const float*)d_in[15];
  p.lam_k1 = (const float*)d_in[16]; p.lam_q2 = (const float*)d_in[17]; p.lam_k2 = (const float*)d_in[18]; p.subln_w = (const float*)d_in[19];
  p.w_out = (const float*)d_in[20]; p.ln1_w = (const float*)d_in[21]; p.ln1_b = (const float*)d_in[22]; p.xq = (const float*)d_in[23];
  p.xk = (const float*)d_in[24]; p.xv = (const float*)d_in[25]; p.xo = (const float*)d_in[26]; p.ln2_w = (const float*)d_in[27];
  p.ln2_b = (const float*)d_in[28]; p.pq = (const float*)d_in[29]; p.subkeys = (const float*)d_in[30]; p.peer_u = (const float*)d_in[31];
  p.peer_v = (const float*)d_in[32]; p.ln3_w = (const float*)d_in[33]; p.ln3_b = (const float*)d_in[34];
  p.out = (float*)d_out;

  char* ws = (char*)d_ws;
  size_t off = 0;
  auto carve = [&](size_t bytes) { char* q = ws + off; off += al(bytes); return q; };
  const size_t T = NTOK;
  p.bar = (unsigned*)carve(XCD_BAR_WORDS * 4);
  p.X = (float*)carve(T * 2048 * 4);
  p.lnstat = (float*)carve(T * 2 * 4);
  p.xb = (u16*)carve(T * 2048 * 2);
  p.memb = (u16*)carve((size_t)BATCH * MEM_LEN * 2048 * 2);
  p.WinT = (u16*)carve((size_t)N_IN * 2048 * 2);
  p.WoutT = (u16*)carve((size_t)2048 * 2048 * 2);
  p.xqT = (u16*)carve((size_t)512 * 2048 * 2);
  p.xkT = (u16*)carve((size_t)512 * 2048 * 2);
  p.xvT = (u16*)carve((size_t)512 * 2048 * 2);
  p.xoT = (u16*)carve((size_t)2048 * 512 * 2);
  p.pqT = (u16*)carve((size_t)2048 * 2048 * 2);
  p.loraT = (u16*)carve((size_t)3 * 1024 * 192 * 2);
  p.skb = (u16*)carve((size_t)256 * 256 * 2);
  p.cat = (u16*)carve(T * 2048 * 2);
  p.Qb = (u16*)carve(T * 1024 * 2);
  p.Kb = (u16*)carve(T * 1024 * 2);
  p.Vt = (u16*)carve((size_t)1024 * T * 2);
  p.ropetab = (float*)carve(T * 16 * 4);
  p.Ub = (unsigned char*)carve((size_t)16384 * 1024);
  p.Vb = (unsigned char*)carve((size_t)16384 * 1024);
  p.usinv = (float*)carve(16384 * 4);
  p.vsinv = (float*)carve(16384 * 4);
  const size_t S0 = off;
  p.proj = (float*)carve(T * RCOLS * 4);
  p.lin = (u16*)carve(T * LORA_LD * 2);
  p.lw = (float*)carve(T * 1024 * 4);
  p.la = (float*)carve(T * 1024 * 4);
  p.gate = (float*)carve(T * 1024 * 4);
  p.bon = (float*)carve(T * RH * 4);
  const size_t S1 = off;
  p.prec = (u16*)carve(T * RH * 320 * 2);
  p.wrec = (float*)p.xb;
  size_t peak = off;
  p.yraw = p.lw;
  off = S0;
  p.qx0 = (float*)carve(T * 512 * 4);
  p.qx1 = (float*)carve(T * 512 * 4);
  p.Kx = (u16*)carve((size_t)1024 * 512 * 2);
  p.Vxt = (u16*)carve((size_t)512 * 1024 * 2);
  p.ox = (u16*)carve(T * 512 * 2);
  if (off > peak) peak = off;
  off = S0;
  p.qp = (u16*)carve(T * 2048 * 2);
  p.scores = (float*)carve(T * 2048 * 4);
  p.experts = (int*)carve(T * 128 * 4);
  p.gates = (float*)carve(T * 128 * 4);
  if (off > peak) peak = off;

  static int grid_blocks = 0;
  if (!grid_blocks) {
    int dev = 0, cus = 0, per_cu = 0;
    (void)hipGetDevice(&dev);
    (void)hipDeviceGetAttribute(&cus, hipDeviceAttributeMultiprocessorCount, dev);
    (void)hipOccupancyMaxActiveBlocksPerMultiprocessor(&per_cu, mega, NT, 0);
    if (per_cu > 1) per_cu = 1;
    if (per_cu < 1) per_cu = 1;
    grid_blocks = cus * per_cu;
  }
  if (peak > ws_size) { fprintf(stderr, "workspace too small: need %zu have %zu\n", peak, ws_size); return; }
  {
    int lo = 0, hi = 1 << 20;
    void* args[] = {&p, &lo, &hi};
    hipError_t e = hipLaunchCooperativeKernel((const void*)mega, dim3(grid_blocks), dim3(NT), args, 0, stream);
    if (e != hipSuccess) fprintf(stderr, "cooperative launch failed: %s (grid %d)\n", hipGetErrorString(e), grid_blocks);
  }
}
```

```cpp
#include <hip/hip_runtime.h>
#include <hip/hip_bf16.h>
#include <hip/hip_cooperative_groups.h>
#include <stdint.h>
#include <stdio.h>
#include <string.h>
#include <stddef.h>
namespace cg = cooperative_groups;

typedef unsigned short u16;
typedef __attribute__((ext_vector_type(8))) short bf16x8;
typedef __attribute__((ext_vector_type(4))) float f32x4;
typedef __attribute__((ext_vector_type(2))) int i32x2;
typedef __attribute__((ext_vector_type(2))) float f32x2;
typedef __attribute__((ext_vector_type(4))) unsigned int u32x4;

#define D_MODEL 2048
#define BATCH 4
#define SEQ 4096
#define NTOK (BATCH * SEQ)
#define DEPTH 2
#define MEM_LEN 256
#define RW 1024
#define RH 16
#define RCOLS 3360
#define N_IN 6432
#define DIFF_W 1024
#define XW 512
#define LORA_LD 320
#define REC 384
#define ALPHA 1.4142135623730951f
#define NT 512
#define NWV 8

typedef __attribute__((ext_vector_type(2))) __bf16 bf16x2_t;
typedef __attribute__((ext_vector_type(2))) float f32x2_t;
__device__ __forceinline__ uint32_t pack2(float a, float b) {
  bf16x2_t v = __builtin_convertvector((f32x2_t){a, b}, bf16x2_t);
  return __builtin_bit_cast(uint32_t, v);
}
__device__ __forceinline__ u16 f2bf(float f) { return (u16)(pack2(f, 0.f) & 0xffffu); }
__device__ __forceinline__ float bf2f(u16 h) { return __uint_as_float(((uint32_t)h) << 16); }

template <int CTRL>
__device__ __forceinline__ float dpp_f(float x) {
  return __int_as_float(__builtin_amdgcn_update_dpp(0, __float_as_int(x), CTRL, 0xf, 0xf, true));
}
__device__ __forceinline__ float row16_sum(float x) {
  x += dpp_f<0xB1>(x);
  x += dpp_f<0x4E>(x);
  x += dpp_f<0x141>(x);
  x += dpp_f<0x140>(x);
  return x;
}
__device__ __forceinline__ float row16_max(float x) {
  x = fmaxf(x, dpp_f<0xB1>(x));
  x = fmaxf(x, dpp_f<0x4E>(x));
  x = fmaxf(x, dpp_f<0x141>(x));
  x = fmaxf(x, dpp_f<0x140>(x));
  return x;
}
__device__ __forceinline__ float wave_sum(float x) {
  x = row16_sum(x);
  x += __shfl_xor(x, 16);
  x += __shfl_xor(x, 32);
  return x;
}
__device__ __forceinline__ float wave_max(float x) {
  x = row16_max(x);
  x = fmaxf(x, __shfl_xor(x, 16));
  x = fmaxf(x, __shfl_xor(x, 32));
  return x;
}


__device__ __forceinline__ int tid_fresh() { int t = threadIdx.x; asm volatile("" : "+v"(t)); return t; }
__device__ __forceinline__ int sfresh(int x) { asm volatile("" : "+s"(x)); return x; }

__device__ __forceinline__ void d_cvt(const float* __restrict__ src, u16* __restrict__ dst, size_t n8, const int bid0, const int nb0, unsigned char* smem) {
  const int bid = sfresh(bid0), nb = sfresh(nb0);
  const int tidf = tid_fresh();
  for (size_t i = (size_t)bid * NT + tidf; i < n8; i += (size_t)nb * NT) {
    float4 a = ((const float4*)src)[2 * i], b = ((const float4*)src)[2 * i + 1];
    uint4 o;
    o.x = pack2(a.x, a.y); o.y = pack2(a.z, a.w); o.z = pack2(b.x, b.y); o.w = pack2(b.z, b.w);
    ((uint4*)dst)[i] = o;
  }
}
__device__ __forceinline__ void d_cvt_t(const float* __restrict__ src, u16* __restrict__ dst, int K, int N, int ldd, const int bid0, const int nb0, unsigned char* smem) {
  const int bid = sfresh(bid0), nb = sfresh(nb0);
  const int tidf = tid_fresh();
  float (*tile)[65] = (float (*)[65])smem;
  const int ntn = (N + 63) / 64, ntk = (K + 63) / 64;
  const int r16 = tidf >> 4, c4 = (tidf & 15) * 4;
  for (int t = bid; t < ntn * ntk; t += nb) {
    const int tk = t / ntn, tn = t % ntn;
    __syncthreads();
#pragma unroll
    for (int i = 0; i < 2; ++i) {
      const int k = tk * 64 + r16 + 32 * i, n = tn * 64 + c4;
      f32x4 v = (f32x4){0.f, 0.f, 0.f, 0.f};
      if (k < K && n < N) v = *(const f32x4*)(src + (size_t)k * N + n);
      tile[r16 + 32 * i][c4] = v[0]; tile[r16 + 32 * i][c4 + 1] = v[1]; tile[r16 + 32 * i][c4 + 2] = v[2]; tile[r16 + 32 * i][c4 + 3] = v[3];
    }
    __syncthreads();
#pragma unroll
    for (int i = 0; i < 2; ++i) {
      const int n = tn * 64 + r16 + 32 * i, k = tk * 64 + c4;
      if (n < N && k < K) {
        uint2 o;
        o.x = pack2(tile[c4][r16 + 32 * i], tile[c4 + 1][r16 + 32 * i]);
        o.y = pack2(tile[c4 + 2][r16 + 32 * i], tile[c4 + 3][r16 + 32 * i]);
        *(uint2*)(dst + (size_t)n * ldd + k) = o;
      }
    }
  }
}
__device__ __forceinline__ void d_zero16(u16* p, size_t n, const int bid0, const int nb0, unsigned char* smem) {
  const int bid = sfresh(bid0), nb = sfresh(nb0);
  const int tidf = tid_fresh();
  for (size_t i = (size_t)bid * NT + tidf; i < n; i += (size_t)nb * NT) p[i] = 0;
}

#define GBM 128
#define GBN 128
#define GBK 64
#define GLS 72
struct GemmArgs {
  const u16* A; const u16* Bt; int lda, ldb; int M, N, K;
  float* Cf; u16* Cb; int ldc; const float* res; float alpha;
  const float* tab; u16* Cb2;
};
#undef GBM
#undef GBN
#undef GBK
#define GBM 256
#define GBN 256
#define GBK 32
__device__ __forceinline__ int lds_byte(int r, int c) {
  int ob = (r & 15) * 64 + c * 2;
  return (r >> 4) * 1024 + (ob ^ (((ob >> 9) & 1) << 5));
}
__device__ __forceinline__ void stage_rc(int b, int& R, int& C) {
  int st = b >> 10, sb = b & 1023, swz = sb ^ (((sb >> 9) & 1) << 5);
  R = st * 16 + swz / 64;
  C = (swz % 64) / 2;
}
#define G_A_B 16384
#define G_STAGE_B 32768
template <int EPI>
__device__ __forceinline__ void gemm_tile(const GemmArgs& g, int tm, int tn, unsigned char* shm) {
  const int tid = tid_fresh(), lane = tid & 63, wave = tid >> 6;
  const int wm = wave >> 2, wn = wave & 3;
  const int m0 = tm * GBM, n0 = tn * GBN;
  const int KT = g.K / GBK;
  f32x4 acc[8][4];
#pragma unroll
  for (int i = 0; i < 8; ++i)
#pragma unroll
    for (int j = 0; j < 4; ++j) acc[i][j] = (f32x4){0.f, 0.f, 0.f, 0.f};
  const u16* aptr[2]; const u16* bptr[2];
#pragma unroll
  for (int i = 0; i < 2; ++i) {
    int R, C;
    stage_rc((wave * 2 + i) * 1024 + lane * 16, R, C);
    aptr[i] = g.A + (size_t)min(m0 + R, g.M - 1) * g.lda + C;
    bptr[i] = g.Bt + (size_t)min(n0 + R, g.N - 1) * g.ldb + C;
  }
  const int aoff = lds_byte(wm * 128 + (lane & 15), (lane >> 4) * 8);
  const int boff = G_A_B + lds_byte(wn * 64 + (lane & 15), (lane >> 4) * 8);
#define GSTAGE(BUF, KTI) { \
    _Pragma("unroll") for (int i = 0; i < 2; ++i) { \
      __builtin_amdgcn_global_load_lds((const unsigned*)(aptr[i] + (KTI) * GBK), (unsigned*)(shm + (BUF) * G_STAGE_B + (wave * 2 + i) * 1024), 16, 0, 0); \
      __builtin_amdgcn_global_load_lds((const unsigned*)(bptr[i] + (KTI) * GBK), (unsigned*)(shm + (BUF) * G_STAGE_B + G_A_B + (wave * 2 + i) * 1024), 16, 0, 0); } }
#define GCOMPUTE(BUF) { const unsigned char* sb_ = shm + (BUF) * G_STAGE_B; bf16x8 af[8], bfr[4]; \
    _Pragma("unroll") for (int i = 0; i < 8; ++i) af[i] = *(const bf16x8*)(sb_ + aoff + i * 1024); \
    _Pragma("unroll") for (int j = 0; j < 4; ++j) bfr[j] = *(const bf16x8*)(sb_ + boff + j * 1024); \
    _Pragma("unroll") for (int i = 0; i < 8; ++i) _Pragma("unroll") for (int j = 0; j < 4; ++j) \
      acc[i][j] = (EPI == 0) ? __builtin_amdgcn_mfma_f32_16x16x32_bf16(bfr[j], af[i], acc[i][j], 0, 0, 0) \
                             : __builtin_amdgcn_mfma_f32_16x16x32_bf16(af[i], bfr[j], acc[i][j], 0, 0, 0); }
#define GWAIT(NAFTER) { if ((NAFTER) >= 2) asm volatile("s_waitcnt vmcnt(8)" ::: "memory"); \
    else if ((NAFTER) == 1) asm volatile("s_waitcnt vmcnt(4)" ::: "memory"); else asm volatile("s_waitcnt vmcnt(0)" ::: "memory"); }
  __syncthreads();
  GSTAGE(0, 0);
  if (KT > 1) GSTAGE(1, 1);
  if (KT > 2) GSTAGE(2, 2);
  GWAIT(min(KT - 1, 2));
  asm volatile("s_waitcnt lgkmcnt(0)" ::: "memory");
  __builtin_amdgcn_s_barrier();
  {
    int buf = 0;
    for (int kt = 0; kt < KT; ++kt) {
      if (kt + 3 < KT) GSTAGE((buf + 3) & 3, kt + 3);
      GCOMPUTE(buf);
      GWAIT(min(KT - 1, kt + 3) - (kt + 1));
      asm volatile("s_waitcnt lgkmcnt(0)" ::: "memory");
      __builtin_amdgcn_s_barrier();
      buf = (buf + 1) & 3;
    }
  }
#undef GSTAGE
#undef GCOMPUTE
#undef GWAIT
  if (EPI == 0) {
    const int fr2 = lane >> 2, fq2 = lane & 3, src4 = (fq2 * 16 + fr2) * 4;
#pragma unroll
    for (int i = 0; i < 8; ++i)
#pragma unroll
      for (int j = 0; j < 4; ++j) {
        const int row = m0 + wm * 128 + i * 16 + fr2, col = n0 + wn * 64 + j * 16 + 4 * fq2;
        f32x4 w;
#pragma unroll
        for (int r = 0; r < 4; ++r) w[r] = __int_as_float(__builtin_amdgcn_ds_bpermute(src4, __float_as_int(acc[i][j][r])));
        if (col < g.N && row < g.M) {
          if (g.Cb) { uint2 o; o.x = pack2(w[0], w[1]); o.y = pack2(w[2], w[3]); *(uint2*)(g.Cb + (size_t)row * g.ldc + col) = o; }
          else *(f32x4*)(g.Cf + (size_t)row * g.ldc + col) = w;
        }
      }
    return;
  }
#pragma unroll
  for (int i = 0; i < 8; ++i)
#pragma unroll
    for (int j = 0; j < 4; ++j) {
      int col = n0 + wn * 64 + j * 16 + (lane & 15);
#pragma unroll
      for (int r = 0; r < 4; ++r) {
        int row = m0 + wm * 128 + i * 16 + (lane >> 4) * 4 + r;
        if (EPI == 3) {
          float v = acc[i][j][r];
          if (j == 0) {
            float pv = dpp_f<0x128>(v);
            float cs = g.tab[(size_t)row * 16 + (lane & 7)], sn = g.tab[(size_t)row * 16 + 8 + (lane & 7)];
            v = (lane & 8) ? (v * cs + pv * sn) : (v * cs - pv * sn);
          }
          u16* dst = (col & 1024) ? g.Cb2 : g.Cb;
          dst[(size_t)row * 1024 + (col & 1023)] = f2bf(v);
        } else
        if (col < g.N && row < g.M) {
          size_t o = (size_t)row * g.ldc + col;
          float v = acc[i][j][r];
          if (EPI == 0) g.Cf[o] = v;
          else if (EPI == 1) g.Cb[o] = f2bf(v);
          else if (EPI == 4) { int oc = col & 15; g.Cb[(size_t)row * g.ldc + ((col & ~15) | (oc & 3) | ((oc & 8) >> 1) | ((oc & 4) << 1))] = f2bf(v); }
          else g.Cf[o] = g.alpha * g.res[o] + v;
        }
      }
    }
}
template <int EPI>
__device__ __forceinline__ int gemm_run(const GemmArgs& g, int base, const int bid0, const int nb0, unsigned char* smem) {
  const int bid = sfresh(bid0), nb = sfresh(nb0);
  int ntm = (g.M + GBM - 1) / GBM, ntn = (g.N + GBN - 1) / GBN;
  int nt = ntm * ntn;
  const int per = nb >> 3;
  const int mine = (bid & 7) * per + (bid >> 3);
  for (int idx = (base / nb) * nb + mine; idx < base + nt; idx += nb) {
    if (idx < base) continue;
    int t = idx - base;
    gemm_tile<EPI>(g, t / ntn, t % ntn, smem);
  }
  return base + nt;
}

#define G8_LAS __attribute__((address_space(3)))
struct G8Unit { int pm, pn; };
struct G8Gemm { const u16* A; const u16* Bt; int lda, ldb; int M, N, K; int a_pn_off; int b_shared; };
__device__ __forceinline__ int g8_lds_byte(int r, int c) { const int st = (r >> 4) * 2 + (c >> 5), rr = r & 15, cc = c & 31, ob = rr * 64 + cc * 2; return st * 1024 + (ob ^ (((ob >> 9) & 1) << 5)); }
__device__ __forceinline__ void g8_stage_rc(int b, int& R, int& C) { const int st = b / 1024, sb = b % 1024, swz = sb ^ (((sb >> 9) & 1) << 5); R = (st >> 1) * 16 + swz / 64; C = (st & 1) * 32 + (swz % 64) / 2; }
struct G8Order {
  int nM, nN, nwg, G, c;
  __device__ __forceinline__ void init(int M, int N, int G_, int c_) { nM = M / 256; nN = (N + 255) / 256; nwg = nM * nN; G = G_; c = c_; }
  __device__ __forceinline__ bool next(int i, G8Unit& u) const {
    const long L = (long)i * G + c; if (L >= nwg) return false;
    int wgid = (int)L; { const int q = nwg / 8, r = nwg % 8, xcd = wgid % 8, off = wgid / 8; wgid = (xcd < r ? xcd * (q + 1) : r * (q + 1) + (xcd - r) * q) + off; }
    const int nig = 8 * nN, gid = wgid / nig, fm = gid * 8, gsz = (nM - fm) < 8 ? (nM - fm) : 8;
    u.pm = fm + ((wgid % nig) % gsz); u.pn = (wgid % nig) / gsz; return true;
  }
};
struct G8EpiF32 { float* C; int ldc; int N;
  __device__ __forceinline__ void operator()(const f32x4 (&acc)[2][2][4][2], const G8Unit& u, int wr, int wc, int fr, int fq) const {
    const int lane = fq * 16 + fr, fr2 = lane >> 2, fq2 = lane & 3, src4 = (fq2 * 16 + fr2) * 4;
#pragma unroll
    for (int ai = 0; ai < 2; ++ai)
#pragma unroll
      for (int m = 0; m < 4; ++m) { float* rowp = C + (size_t)(u.pm * 256 + ai * 128 + wr * 64 + m * 16 + fr2) * ldc;
#pragma unroll
        for (int bj = 0; bj < 2; ++bj)
#pragma unroll
          for (int n = 0; n < 2; ++n) { const int c0 = u.pn * 256 + bj * 128 + wc * 32 + n * 16 + 4 * fq2;
            f32x4 w;
#pragma unroll
            for (int j = 0; j < 4; ++j) w[j] = __int_as_float(__builtin_amdgcn_ds_bpermute(src4, __float_as_int(acc[ai][bj][m][n][j])));
            if (c0 < N) *(f32x4*)(rowp + c0) = w; } }
  } };
struct G8EpiResLn { float* C; const float* stats; const float* lnw; const float* lnb; int ldc; float alpha;
  __device__ __forceinline__ void operator()(const f32x4 (&acc)[2][2][4][2], const G8Unit& u, int wr, int wc, int fr0, int fq0) const {
    const int lane = fq0 * 16 + fr0, fr = lane >> 2, fq = lane & 3, src4 = (fq * 16 + fr) * 4;
#pragma unroll
    for (int bj = 0; bj < 2; ++bj)
#pragma unroll
      for (int n = 0; n < 2; ++n) { const int c0 = u.pn * 256 + bj * 128 + wc * 32 + n * 16 + 4 * fq;
        const f32x4 w4 = *(const f32x4*)(lnw + c0), b4 = *(const f32x4*)(lnb + c0);
#pragma unroll
        for (int ai = 0; ai < 2; ++ai)
#pragma unroll
          for (int m = 0; m < 4; ++m) { const size_t row = (size_t)(u.pm * 256 + ai * 128 + wr * 64 + m * 16 + fr); const size_t ro = row * ldc;
            const float2 st = *(const float2*)(stats + row * 2);
            f32x4 r4 = *(const f32x4*)(C + ro + c0);
            f32x4 av;
#pragma unroll
            for (int j = 0; j < 4; ++j) av[j] = __int_as_float(__builtin_amdgcn_ds_bpermute(src4, __float_as_int(acc[ai][bj][m][n][j])));
#pragma unroll
            for (int j = 0; j < 4; ++j) r4[j] = (r4[j] - st.x) * st.y * w4[j] + b4[j];
            *(f32x4*)(C + ro + c0) = r4 * alpha + av; } }
  } };
struct G8EpiRes { float* C; const float* res; int ldc; float alpha;
  __device__ __forceinline__ void operator()(const f32x4 (&acc)[2][2][4][2], const G8Unit& u, int wr, int wc, int fr0, int fq0) const {
    const int lane = fq0 * 16 + fr0, fr = lane >> 2, fq = lane & 3, src4 = (fq * 16 + fr) * 4;
#pragma unroll
    for (int ai = 0; ai < 2; ++ai)
#pragma unroll
      for (int m = 0; m < 4; ++m) { const size_t ro = (size_t)(u.pm * 256 + ai * 128 + wr * 64 + m * 16 + fr) * ldc;
#pragma unroll
        for (int bj = 0; bj < 2; ++bj)
#pragma unroll
          for (int n = 0; n < 2; ++n) { const int c0 = u.pn * 256 + bj * 128 + wc * 32 + n * 16 + 4 * fq;
            f32x4 r4 = *(const f32x4*)(res + ro + c0);
            f32x4 av;
#pragma unroll
            for (int j = 0; j < 4; ++j) av[j] = __int_as_float(__builtin_amdgcn_ds_bpermute(src4, __float_as_int(acc[ai][bj][m][n][j])));
            *(f32x4*)(C + ro + c0) = r4 * alpha + av; } }
  } };
struct G8EpiBf16 { u16* C; int ldc; int vperm; int N;
  __device__ __forceinline__ void operator()(const f32x4 (&acc)[2][2][4][2], const G8Unit& u, int wr, int wc, int fr0, int fq0) const {
    const int lane = fq0 * 16 + fr0, fr = lane >> 2, fq = lane & 3, src4 = (fq * 16 + fr) * 4;
    const int pos = vperm ? (4 * (fq >> 1) + 8 * (fq & 1)) : 4 * fq;
#pragma unroll
    for (int ai = 0; ai < 2; ++ai)
#pragma unroll
      for (int m = 0; m < 4; ++m) { u16* rowp = C + (size_t)(u.pm * 256 + ai * 128 + wr * 64 + m * 16 + fr) * ldc;
#pragma unroll
        for (int bj = 0; bj < 2; ++bj)
#pragma unroll
          for (int n = 0; n < 2; ++n) { const int c0 = u.pn * 256 + bj * 128 + wc * 32 + n * 16 + pos; const f32x4 v = acc[ai][bj][m][n];
            uint2 o; o.x = (unsigned)__builtin_amdgcn_ds_bpermute(src4, (int)pack2(v[0], v[1])); o.y = (unsigned)__builtin_amdgcn_ds_bpermute(src4, (int)pack2(v[2], v[3]));
            if (N == 0 || c0 < N) *(uint2*)(rowp + c0) = o; } }
  } };
struct G8EpiRope { const float* tab; u16* Q; u16* Kb;
  __device__ __forceinline__ void operator()(const f32x4 (&acc)[2][2][4][2], const G8Unit& u, int wr, int wc, int fr, int fq) const {
#pragma unroll
    for (int ai = 0; ai < 2; ++ai)
#pragma unroll
      for (int m = 0; m < 4; ++m) { const size_t row = (size_t)(u.pm * 256 + ai * 128 + wr * 64 + m * 16 + fr);
#pragma unroll
        for (int bj = 0; bj < 2; ++bj)
#pragma unroll
          for (int n = 0; n < 2; ++n) { const int c0 = u.pn * 256 + bj * 128 + wc * 32 + n * 16 + 4 * fq; f32x4 v = acc[ai][bj][m][n];
            if (n == 0 && (wc & 1) == 0) {
#pragma unroll
              for (int j = 0; j < 4; ++j) {
                const float pv = __shfl_xor(v[j], 32);
                const int dd = (4 * fq + j) & 7;
                const float cs = tab[row * 16 + dd], sn = tab[row * 16 + 8 + dd];
                v[j] = (fq & 2) ? (v[j] * cs + pv * sn) : (v[j] * cs - pv * sn);
              }
            }
            u16* dst = (c0 & 1024) ? Kb : Q;
            if (!(c0 & 1024)) v *= (0.125f * 1.4426950408889634f);
            const int lane = fq * 16 + fr, fr2 = lane >> 2, fq2 = lane & 3, src4 = (fq2 * 16 + fr2) * 4;
            const size_t row2 = (size_t)(u.pm * 256 + ai * 128 + wr * 64 + m * 16 + fr2);
            const int c02 = u.pn * 256 + bj * 128 + wc * 32 + n * 16 + 4 * fq2;
            uint2 o; o.x = (unsigned)__builtin_amdgcn_ds_bpermute(src4, (int)pack2(v[0], v[1])); o.y = (unsigned)__builtin_amdgcn_ds_bpermute(src4, (int)pack2(v[2], v[3]));
            *(uint2*)(dst + row2 * 1024 + (c02 & 1023)) = o; } }
  } };

template <class Epi>
__device__ __forceinline__ void gemm8(unsigned char* smem, const G8Gemm g, const Epi& E, const int bid0, const int nb0) {
  constexpr int BK = 64, HALF = 128, HTB = HALF * BK * 2;
  G8_LAS unsigned char* lds = (G8_LAS unsigned char*)smem;
  G8Order S; S.init(g.M, g.N, sfresh(nb0), sfresh(bid0));
  const int tid = tid_fresh(), wid = __builtin_amdgcn_readfirstlane(tid >> 6), lane = tid & 63, wr = wid >> 2, wc = wid & 3, fr = lane & 15, fq = lane >> 4;
  const int nt = g.K / BK;
  unsigned voffA[2], voffB[2];
#pragma unroll
  for (int i = 0; i < 2; ++i) { int R, C; g8_stage_rc(tid * 16 + i * 8192, R, C); voffA[i] = (unsigned)(R * g.lda + C) * 2u; voffB[i] = (unsigned)(R * g.ldb + C) * 2u; }
  const size_t kstep = (size_t)(BK * 2);
  const size_t hstepA = (size_t)HALF * g.lda * 2, hstepB = (size_t)HALF * g.ldb * 2;
  const size_t tstepA = 2 * hstepA, tstepB = 2 * hstepB;
  const unsigned ldsw = (unsigned)wid * 1024u;
  const int aoff = g8_lds_byte(wr * 64 + fr, fq * 8), boff = g8_lds_byte(wc * 32 + fr, fq * 8);
#define PG8_SA(b, h) (((b) * 2 + (h)) * HTB)
#define PG8_SB(b, h) ((4 + (b) * 2 + (h)) * HTB)
#define PG8_STAGE(bufoff, gbase, voff) do { _Pragma("unroll") for (int _i = 0; _i < 2; ++_i) \
        __builtin_amdgcn_global_load_lds((const unsigned*)((const char*)(gbase) + (voff)[_i]), (G8_LAS unsigned*)(lds + (bufoff) + ldsw + _i * 8192), 16, 0, 0); } while (0)
#define PG8_LDA(dst, b, h) do { _Pragma("unroll") for (int m = 0; m < 4; ++m) _Pragma("unroll") for (int k = 0; k < 2; ++k) dst[m][k] = *(const G8_LAS bf16x8*)(lds + PG8_SA(b, h) + aoff + m * 2048 + k * 1024); } while (0)
#define PG8_LDB(dst, b, h) do { _Pragma("unroll") for (int n = 0; n < 2; ++n) _Pragma("unroll") for (int k = 0; k < 2; ++k) dst[n][k] = *(const G8_LAS bf16x8*)(lds + PG8_SB(b, h) + boff + n * 2048 + k * 1024); } while (0)
#define PG8_MMA(ai, bj, At, Bt) do { __builtin_amdgcn_s_setprio(1); _Pragma("unroll") for (int m = 0; m < 4; ++m) _Pragma("unroll") for (int n = 0; n < 2; ++n) _Pragma("unroll") for (int k = 0; k < 2; ++k) \
        acc[ai][bj][m][n] = __builtin_amdgcn_mfma_f32_16x16x32_bf16(Bt[n][k], At[m][k], acc[ai][bj][m][n], 0, 0, 0); __builtin_amdgcn_s_setprio(0); } while (0)
#define PG8_WAIT_V(n) asm volatile("s_waitcnt vmcnt(" #n ")" ::: "memory")
#define PG8_WAIT_L(n) asm volatile("s_waitcnt lgkmcnt(" #n ")" ::: "memory")
#define PG8_BAR __builtin_amdgcn_s_barrier()
#define PG8_SCHED __builtin_amdgcn_sched_barrier(0)
  __syncthreads();
  G8Unit cur, nxt; int ui = 0;
  if (S.next(0, cur)) {
  f32x4 acc[2][2][4][2];
#pragma unroll
  for (int a = 0; a < 2; ++a)
#pragma unroll
    for (int b = 0; b < 2; ++b)
#pragma unroll
      for (int m = 0; m < 4; ++m)
#pragma unroll
        for (int n = 0; n < 2; ++n) acc[a][b][m][n] = (f32x4){0.f, 0.f, 0.f, 0.f};
  bf16x8 At[4][2], B0[2][2], B1[2][2];
  const char* cA = (const char*)g.A + (size_t)cur.pm * tstepA + (size_t)cur.pn * g.a_pn_off; const char* cB = (const char*)g.Bt + (g.b_shared ? (size_t)0 : (size_t)cur.pn * tstepB);
  PG8_STAGE(PG8_SB(0, 0), cB, voffB); PG8_STAGE(PG8_SA(0, 0), cA, voffA); PG8_STAGE(PG8_SB(0, 1), cB + hstepB, voffB); PG8_STAGE(PG8_SA(0, 1), cA + hstepA, voffA);
  if (wr == 1) PG8_BAR;
  PG8_WAIT_V(4); PG8_BAR;
  PG8_STAGE(PG8_SB(1, 0), cB + kstep, voffB); PG8_STAGE(PG8_SA(1, 0), cA + kstep, voffA); PG8_STAGE(PG8_SB(1, 1), cB + hstepB + kstep, voffB);
  PG8_WAIT_V(6); PG8_BAR;
  for (;;) {
    const bool has_next = S.next(ui + 1, nxt);
    const char* nA = has_next ? (const char*)g.A + (size_t)nxt.pm * tstepA + (size_t)nxt.pn * g.a_pn_off : cA; const char* nB = has_next ? (const char*)g.Bt + (g.b_shared ? (size_t)0 : (size_t)nxt.pn * tstepB) : cB;
    for (int t = 0; t < nt; t += 2) {
      const bool last = (t == nt - 2);
      const char* a1 = cA + (size_t)(t + 1) * kstep;
      const char* a2 = last ? nA : cA + (size_t)(t + 2) * kstep; const char* b2 = last ? nB : cB + (size_t)(t + 2) * kstep;
      const char* a3 = a2 + kstep; const char* b3 = b2 + kstep;
      PG8_LDB(B0, 0, 0); PG8_SCHED; PG8_LDA(At, 0, 0); PG8_STAGE(PG8_SA(1, 1), a1 + hstepA, voffA);
      PG8_WAIT_L(8); PG8_BAR; PG8_WAIT_L(0); PG8_MMA(0, 0, At, B0); PG8_BAR; PG8_SCHED;
      PG8_LDB(B1, 0, 1); PG8_STAGE(PG8_SB(0, 0), b2, voffB);
      PG8_BAR; PG8_WAIT_L(0); PG8_MMA(0, 1, At, B1); PG8_BAR;
      PG8_LDA(At, 0, 1); PG8_STAGE(PG8_SA(0, 0), a2, voffA);
      PG8_BAR; PG8_WAIT_L(0); PG8_MMA(1, 0, At, B0); PG8_BAR; PG8_SCHED;
      PG8_STAGE(PG8_SB(0, 1), b2 + hstepB, voffB);
      PG8_WAIT_V(6); PG8_BAR; PG8_MMA(1, 1, At, B1); PG8_BAR;
      PG8_LDB(B0, 1, 0); PG8_SCHED; PG8_LDA(At, 1, 0); PG8_STAGE(PG8_SA(0, 1), a2 + hstepA, voffA);
      PG8_WAIT_L(8); PG8_BAR; PG8_WAIT_L(0); PG8_MMA(0, 0, At, B0); PG8_BAR; PG8_SCHED;
      PG8_LDB(B1, 1, 1); PG8_STAGE(PG8_SB(1, 0), b3, voffB);
      PG8_BAR; PG8_WAIT_L(0); PG8_MMA(0, 1, At, B1); PG8_BAR;
      PG8_LDA(At, 1, 1); PG8_STAGE(PG8_SA(1, 0), a3, voffA);
      PG8_BAR; PG8_WAIT_L(0); PG8_MMA(1, 0, At, B0); PG8_BAR; PG8_SCHED;
      PG8_STAGE(PG8_SB(1, 1), b3 + hstepB, voffB);
      PG8_WAIT_V(6); PG8_BAR; PG8_MMA(1, 1, At, B1); PG8_BAR;
    }
    E(acc, cur, wr, wc, fr, fq);
    if (!has_next) break;
#pragma unroll
    for (int a = 0; a < 2; ++a)
#pragma unroll
      for (int b = 0; b < 2; ++b)
#pragma unroll
        for (int m = 0; m < 4; ++m)
#pragma unroll
          for (int n = 0; n < 2; ++n) acc[a][b][m][n] = (f32x4){0.f, 0.f, 0.f, 0.f};
    cur = nxt; cA = nA; cB = nB; ++ui;
  }
  PG8_WAIT_V(0);
  if (wr == 0) PG8_BAR;
  PG8_BAR;
  }
#undef PG8_SA
#undef PG8_SB
#undef PG8_STAGE
#undef PG8_LDA
#undef PG8_LDB
#undef PG8_MMA
#undef PG8_WAIT_V
#undef PG8_WAIT_L
#undef PG8_BAR
#undef PG8_SCHED
  __syncthreads();
}

__device__ __forceinline__ void d_ln(const float* pre, const float* __restrict__ w, const float* __restrict__ b,
                                            float* outf, u16* __restrict__ outb, float* __restrict__ stats, int rows, const int bid0, const int nb0, unsigned char* smem) {
  const int bid = sfresh(bid0), nb = sfresh(nb0);
  const int tidf = tid_fresh();
  int lane = tidf & 63, wave = tidf >> 6;
  for (int row0 = (bid * NWV + wave) * 2; row0 < rows; row0 += nb * NWV * 2) {
    f32x4 v[2][8];
    float s[2] = {0.f, 0.f};
#pragma unroll
    for (int u = 0; u < 2; ++u) {
      const f32x4* p = (const f32x4*)(pre + (size_t)(row0 + u) * D_MODEL);
#pragma unroll
      for (int i = 0; i < 8; ++i) v[u][i] = p[lane + 64 * i];
    }
#pragma unroll
    for (int u = 0; u < 2; ++u) {
#pragma unroll
      for (int i = 0; i < 8; ++i) s[u] += (v[u][i][0] + v[u][i][1]) + (v[u][i][2] + v[u][i][3]);
    }
    float mu[2], rs[2];
#pragma unroll
    for (int u = 0; u < 2; ++u) mu[u] = wave_sum(s[u]) * (1.0f / D_MODEL);
#pragma unroll
    for (int u = 0; u < 2; ++u) {
      float q = 0.f;
#pragma unroll
      for (int i = 0; i < 8; ++i)
#pragma unroll
        for (int j = 0; j < 4; ++j) { float d = v[u][i][j] - mu[u]; q += d * d; }
      rs[u] = q;
    }
#pragma unroll
    for (int u = 0; u < 2; ++u) rs[u] = rsqrtf(wave_sum(rs[u]) * (1.0f / D_MODEL) + 1e-5f);
    if (stats && lane < 2) { float2 st; st.x = lane ? mu[1] : mu[0]; st.y = lane ? rs[1] : rs[0]; *(float2*)(stats + (size_t)(row0 + lane) * 2) = st; }
#pragma unroll
    for (int i = 0; i < 8; ++i) {
      f32x4 ww = ((const f32x4*)w)[lane + 64 * i], bb = ((const f32x4*)b)[lane + 64 * i];
#pragma unroll
      for (int u = 0; u < 2; ++u) {
        f32x4 o;
#pragma unroll
        for (int j = 0; j < 4; ++j) o[j] = (v[u][i][j] - mu[u]) * rs[u] * ww[j] + bb[j];
        if (outf) ((f32x4*)(outf + (size_t)(row0 + u) * D_MODEL))[lane + 64 * i] = o;
        uint2 ob; ob.x = pack2(o[0], o[1]); ob.y = pack2(o[2], o[3]);
        ((uint2*)(outb + (size_t)(row0 + u) * D_MODEL))[lane + 64 * i] = ob;
      }
    }
  }
}

__device__ __forceinline__ f32x4 ld_bf4(const u16* p) {
  const uint2 v = *(const uint2*)p;
  return (f32x4){__uint_as_float(v.x << 16), __uint_as_float(v.x & 0xffff0000u), __uint_as_float(v.y << 16), __uint_as_float(v.y & 0xffff0000u)};
}
__device__ __forceinline__ void d_rwkv_prep1(const u16* __restrict__ proj, const float* __restrict__ mu, u16* __restrict__ lin, const int bid0, const int nb0, unsigned char* smem) {
  const int bid = sfresh(bid0), nb = sfresh(nb0);
  const int tidf = tid_fresh();
  const unsigned total = (unsigned)NTOK * LORA_LD;
  for (unsigned i = (unsigned)bid * NT + (unsigned)tidf; i < total; i += (unsigned)nb * NT) {
    const int t = (int)(i / (unsigned)LORA_LD), c = (int)(i % (unsigned)LORA_LD);
    float out = 0.f;
    if (c < 288) {
      int col = 3072 + c;
      float p = bf2f(proj[(size_t)t * RCOLS + col]);
      float pp = ((t % SEQ) == 0) ? 0.f : bf2f(proj[(size_t)(t - 1) * RCOLS + col]);
      float x = p + (pp - p) * mu[col];
      if (c < 64) out = 1.f - 2.f * __builtin_amdgcn_rcpf(1.f + __expf(2.f * x));
      else if (c < 128) out = x;
      else out = __builtin_amdgcn_rcpf(1.f + __expf(-x));
    }
    lin[i] = f2bf(out);
  }
}

struct Prep2Args {
  const u16* proj; const float* mu; const float* lw; const float* la;
  const float* w0; const float* a0; const float* k_k; const float* k_a; const float* r_k;
  float* wrec; u16* prec; float* bon;
};
__device__ __forceinline__ void d_rwkv_prep2(Prep2Args a, const int bid0, const int nb0, unsigned char* smem) {
  const int bid = sfresh(bid0), nb = sfresh(nb0);
  const int tidf = tid_fresh();
  const int lane = tidf & 63, wave = tidf >> 6;
  const int hq = lane >> 4, l16 = lane & 15;
  constexpr int NITEM = (NTOK / 4) * (RH / 4);
  for (int it = bid * NWV + wave; it < NITEM; it += nb * NWV) {
    const int hg = it & 3, t0 = (it >> 2) * 4;
    const int h = hg * 4 + hq;
    const int b = t0 / SEQ, s0 = t0 % SEQ;
    const int c = h * 64 + 4 * l16;
    f32x4 pr[5], pk[5], pv[5], lw[4], la[4];
    const u16* p0 = a.proj + (size_t)t0 * RCOLS + c;
    pr[0] = pk[0] = pv[0] = (f32x4){0.f, 0.f, 0.f, 0.f};
    if (s0 != 0) { pr[0] = ld_bf4(p0 - RCOLS); pk[0] = ld_bf4(p0 + RW - RCOLS); pv[0] = ld_bf4(p0 + 2 * RW - RCOLS); }
#pragma unroll
    for (int u = 0; u < 4; ++u) {
      pr[u + 1] = ld_bf4(p0 + (size_t)u * RCOLS); pk[u + 1] = ld_bf4(p0 + (size_t)u * RCOLS + RW); pv[u + 1] = ld_bf4(p0 + (size_t)u * RCOLS + 2 * RW);
      { const uint2 wv = *(const uint2*)((const u16*)a.lw + (size_t)(t0 + u) * RW + c), av = *(const uint2*)((const u16*)a.la + (size_t)(t0 + u) * RW + c);
        lw[u] = (f32x4){__uint_as_float(wv.x << 16), __uint_as_float(wv.x & 0xffff0000u), __uint_as_float(wv.y << 16), __uint_as_float(wv.y & 0xffff0000u)};
        la[u] = (f32x4){__uint_as_float(av.x << 16), __uint_as_float(av.x & 0xffff0000u), __uint_as_float(av.y << 16), __uint_as_float(av.y & 0xffff0000u)}; }
    }
    const f32x4 mur = *(const f32x4*)(a.mu + c), muk = *(const f32x4*)(a.mu + RW + c), muv = *(const f32x4*)(a.mu + 2 * RW + c);
    const f32x4 w0c = *(const f32x4*)(a.w0 + c), a0c = *(const f32x4*)(a.a0 + c), kkc = *(const f32x4*)(a.k_k + c), kac = *(const f32x4*)(a.k_a + c), rkc = *(const f32x4*)(a.r_k + c);
#pragma unroll
    for (int u = 0; u < 4; ++u) {
      f32x4 r, v, decay, iclr, kk, k2;
      float nrm = 0.f, bonus = 0.f;
#pragma unroll
      for (int j = 0; j < 4; ++j) {
        r[j] = pr[u + 1][j] + (pr[u][j] - pr[u + 1][j]) * mur[j];
        const float k = pk[u + 1][j] + (pk[u][j] - pk[u + 1][j]) * muk[j];
        v[j] = pv[u + 1][j] + (pv[u][j] - pv[u + 1][j]) * muv[j];
        const float nz = -(w0c[j] + lw[u][j]);
        const float sp = fmaxf(nz, 0.f) + __logf(1.f + __expf(-fabsf(nz)));
        decay[j] = __expf(-__expf(-sp - 0.5f));
        iclr[j] = __builtin_amdgcn_rcpf(1.f + __expf(-(a0c[j] + la[u][j])));
        kk[j] = k * kkc[j];
        nrm += kk[j] * kk[j];
        k2[j] = k * (1.f + (iclr[j] - 1.f) * kac[j]);
        bonus += r[j] * k2[j] * rkc[j];
      }
      nrm = row16_sum(nrm); bonus = row16_sum(bonus);
      const float inv = __builtin_amdgcn_rcpf(fmaxf(__builtin_amdgcn_sqrtf(nrm), 1e-12f));
      const size_t ri = (size_t)(b * RH + h) * SEQ + s0 + u;
      *(f32x4*)(a.wrec + ri * 64 + 4 * l16) = decay;
      u16* pr16 = a.prec + ri * 320 + 4 * l16;
      f32x4 kn;
#pragma unroll
      for (int j = 0; j < 4; ++j) kn[j] = kk[j] * inv;
      uint2 o;
      o.x = pack2(k2[0], k2[1]); o.y = pack2(k2[2], k2[3]); *(uint2*)(pr16) = o;
      o.x = pack2(-kn[0], -kn[1]); o.y = pack2(-kn[2], -kn[3]); *(uint2*)(pr16 + 64) = o;
      o.x = pack2(kn[0] * iclr[0], kn[1] * iclr[1]); o.y = pack2(kn[2] * iclr[2], kn[3] * iclr[3]); *(uint2*)(pr16 + 128) = o;
      o.x = pack2(r[0], r[1]); o.y = pack2(r[2], r[3]); *(uint2*)(pr16 + 192) = o;
      o.x = pack2(v[0], v[1]); o.y = pack2(v[2], v[3]); *(uint2*)(pr16 + 256) = o;
      if (l16 == 0) a.bon[(size_t)(t0 + u) * RH + h] = bonus;
    }
  }
}

#define SC_TC 16
__device__ __forceinline__ void scan_store_p(float* sRec, int c, u32x4 v) {
  int step = c / 40, within = c % 40;
  int arr = within >> 3, col8 = (within & 7) * 8;
  float* d = sRec + step * REC + 64 + arr * 64 + col8;
  f32x4 lo, hi;
  lo[0] = __uint_as_float(v[0] << 16); lo[1] = __uint_as_float(v[0] & 0xffff0000u);
  lo[2] = __uint_as_float(v[1] << 16); lo[3] = __uint_as_float(v[1] & 0xffff0000u);
  hi[0] = __uint_as_float(v[2] << 16); hi[1] = __uint_as_float(v[2] & 0xffff0000u);
  hi[2] = __uint_as_float(v[3] << 16); hi[3] = __uint_as_float(v[3] & 0xffff0000u);
  *(f32x4*)d = lo;
  *(f32x4*)(d + 4) = hi;
}
#define SCAN_ITEMS (BATCH * RH * 4)
#define SC_BUF (SC_TC * REC)
struct TabCvt { const float* pu; const float* pv; unsigned char* Ub; unsigned char* Vb; float* usinv; float* vsinv; };
__device__ __forceinline__ void tab_row_store(const f32x4 (&v)[8], unsigned char* dst, float* sinv, int row, bool natural, int lane) {
  float amax = 0.f;
#pragma unroll
  for (int i = 0; i < 8; ++i)
#pragma unroll
    for (int j = 0; j < 4; ++j) amax = fmaxf(amax, fabsf(v[i][j]));
  amax = wave_max(amax);
  float scale = 1.f, inv = 1.f;
  if (amax > 0.f) { scale = 6.0f / amax; inv = amax * (1.0f / 6.0f); }
  u32x4 o;
#pragma unroll
  for (int k = 0; k < 4; ++k) {
    unsigned w = 0u;
    w = __builtin_amdgcn_cvt_scalef32_pk_fp4_f32(w, v[2 * k][0] * scale, v[2 * k][1] * scale, 1.0f, 0);
    w = __builtin_amdgcn_cvt_scalef32_pk_fp4_f32(w, v[2 * k][2] * scale, v[2 * k][3] * scale, 1.0f, 1);
    w = __builtin_amdgcn_cvt_scalef32_pk_fp4_f32(w, v[2 * k + 1][0] * scale, v[2 * k + 1][1] * scale, 1.0f, 2);
    w = __builtin_amdgcn_cvt_scalef32_pk_fp4_f32(w, v[2 * k + 1][2] * scale, v[2 * k + 1][3] * scale, 1.0f, 3);
    o[k] = w;
  }
  if (natural) {
    uint2 lo; lo.x = o[0]; lo.y = o[1];
    uint2 hi; hi.x = o[2]; hi.y = o[3];
    *(uint2*)(dst + (size_t)row * (D_MODEL / 2) + lane * 8) = lo;
    *(uint2*)(dst + (size_t)row * (D_MODEL / 2) + 512 + lane * 8) = hi;
  } else {
    *(u32x4*)(dst + (size_t)row * (D_MODEL / 2) + lane * 16) = o;
  }
  if (lane == 0) sinv[row] = inv;
}
__device__ __forceinline__ void d_rwkv_scan(const float* __restrict__ wrec, const u16* __restrict__ prec, float* __restrict__ yraw, const TabCvt tc, const int bid0, const int nb0, unsigned char* smem) {
  const int bid = sfresh(bid0), nb = sfresh(nb0);
  const int tidf = tid_fresh();
  float* sRec0 = (float*)smem;
  float* sY0 = sRec0 + 2 * SC_BUF;
  const int tid = tidf, lane = tid & 63, wave = __builtin_amdgcn_readfirstlane(tid >> 6);
  const int cg = lane & 15, rg = lane >> 4;
  const bool helper = wave >= 4;
  const int ht = tid - 256;
  constexpr int NCH = SEQ / SC_TC;
  for (int item = bid; item < SCAN_ITEMS; item += nb) {
    const int bh = item >> 2, rb = item & 3;
    const int b = bh / RH, h = bh % RH;
    const f32x4* wsrc = (const f32x4*)(wrec + (size_t)bh * SEQ * 64);
    const u32x4* psrc = (const u32x4*)(prec + (size_t)bh * SEQ * 320);
    const int rowl = (wave & 3) * 4 + rg;
    const int row = rb * 16 + rowl;
    f32x2 S01 = (f32x2){0.f, 0.f}, S23 = S01;
    f32x4 pw = (f32x4){0.f, 0.f, 0.f, 0.f};
    u32x4 p0 = (u32x4){0u, 0u, 0u, 0u}, p1 = p0, p2 = p0;
    f32x4 trow[8];
#pragma unroll
    for (int i = 0; i < 8; ++i) trow[i] = (f32x4){0.f, 0.f, 0.f, 0.f};
    __syncthreads();
    if (helper) {
      pw = wsrc[ht]; p0 = psrc[ht]; p1 = psrc[ht + 256]; if (ht < 128) p2 = psrc[ht + 512];
      *(f32x4*)(sRec0 + (ht >> 4) * REC + (ht & 15) * 4) = pw;
      scan_store_p(sRec0, ht, p0); scan_store_p(sRec0, ht + 256, p1); if (ht < 128) scan_store_p(sRec0, ht + 512, p2);
      pw = wsrc[256 + ht]; { const u32x4* ps = psrc + 640; p0 = ps[ht]; p1 = ps[ht + 256]; if (ht < 128) p2 = ps[ht + 512]; }
    }
    __syncthreads();
    for (int ch = 0; ch < NCH; ++ch) {
      float* sRec = sRec0 + (ch & 1) * SC_BUF;
      float* sY = sY0 + (ch & 1) * (SC_TC * 256);
      if (!helper) {
        const float* rc0 = sRec + 4 * cg;
        const float* rv0 = sRec + 320 + row;
        f32x4 Wa[2], Ka[2], Aa[2], Ba[2], Ra[2], Wb[2], Kb[2], Ab[2], Bb[2], Rb[2];
        float va[2], vb[2];
#define SC_LOAD(W, K, A, B, R, V, G) { _Pragma("unroll") for (int u = 0; u < 2; ++u) { const float* rc = rc0 + ((G) * 2 + u) * REC; \
          W[u] = *(const f32x4*)(rc); K[u] = *(const f32x4*)(rc + 64); A[u] = *(const f32x4*)(rc + 128); B[u] = *(const f32x4*)(rc + 192); \
          R[u] = *(const f32x4*)(rc + 256); V[u] = rv0[((G) * 2 + u) * REC]; } }
#define SC_GROUP(W, K, A, B, R, V, G) { float yy[2]; \
          _Pragma("unroll") for (int u = 0; u < 2; ++u) { \
            const f32x2 v2 = (f32x2){V[u], V[u]}; \
            const f32x2 p01 = __builtin_elementwise_fma(S01, W[u].lo, K[u].lo * v2), p23 = __builtin_elementwise_fma(S23, W[u].hi, K[u].hi * v2); \
            const f32x2 t = __builtin_elementwise_fma(S23, A[u].hi, S01 * A[u].lo); \
            float sa = t[0] + t[1]; \
            sa = row16_sum(sa); \
            const f32x2 sa2 = (f32x2){sa, sa}; \
            S01 = __builtin_elementwise_fma(sa2, B[u].lo, p01); S23 = __builtin_elementwise_fma(sa2, B[u].hi, p23); \
            const f32x2 yv = __builtin_elementwise_fma(S23, R[u].hi, S01 * R[u].lo); \
            yy[u] = yv[0] + yv[1]; } \
          _Pragma("unroll") for (int u = 0; u < 2; ++u) sY[(((G) * 2 + u) * 16 + rowl) * 16 + cg] = yy[u]; }
        SC_LOAD(Wa, Ka, Aa, Ba, Ra, va, 0);
        SC_LOAD(Wb, Kb, Ab, Bb, Rb, vb, 1);
        SC_GROUP(Wa, Ka, Aa, Ba, Ra, va, 0);
        SC_LOAD(Wa, Ka, Aa, Ba, Ra, va, 2);
        SC_GROUP(Wb, Kb, Ab, Bb, Rb, vb, 1);
        SC_LOAD(Wb, Kb, Ab, Bb, Rb, vb, 3);
        SC_GROUP(Wa, Ka, Aa, Ba, Ra, va, 2);
        SC_LOAD(Wa, Ka, Aa, Ba, Ra, va, 4);
        SC_GROUP(Wb, Kb, Ab, Bb, Rb, vb, 3);
        SC_LOAD(Wb, Kb, Ab, Bb, Rb, vb, 5);
        SC_GROUP(Wa, Ka, Aa, Ba, Ra, va, 4);
        SC_LOAD(Wa, Ka, Aa, Ba, Ra, va, 6);
        SC_GROUP(Wb, Kb, Ab, Bb, Rb, vb, 5);
        SC_LOAD(Wb, Kb, Ab, Bb, Rb, vb, 7);
        SC_GROUP(Wa, Ka, Aa, Ba, Ra, va, 6);
        SC_GROUP(Wb, Kb, Ab, Bb, Rb, vb, 7);
#undef SC_LOAD
#undef SC_GROUP
      } else {
        if (tc.pu) {
          const int hw = wave - 4;
          if (ch >= 1 && ch <= 32) {
            const int sl = (ch - 1) * 4 + hw;
            const bool isv = sl >= 64;
            tab_row_store(trow, isv ? tc.Vb : tc.Ub, isv ? tc.vsinv : tc.usinv, bid * 64 + (sl & 63), true, lane);
          }
          if (ch < 32) {
            const int sl = ch * 4 + hw;
            const bool isv = sl >= 64;
            const f32x4* rp = (const f32x4*)((isv ? tc.pv : tc.pu) + (size_t)(bid * 64 + (sl & 63)) * D_MODEL);
#pragma unroll
            for (int q = 0; q < 2; ++q)
#pragma unroll
              for (int k = 0; k < 4; ++k) trow[q * 4 + k] = rp[q * 256 + lane * 4 + k];
          }
        }
        if (ch + 1 < NCH) {
          float* dR = sRec0 + ((ch + 1) & 1) * SC_BUF;
          *(f32x4*)(dR + (ht >> 4) * REC + (ht & 15) * 4) = pw;
          scan_store_p(dR, ht, p0); scan_store_p(dR, ht + 256, p1); if (ht < 128) scan_store_p(dR, ht + 512, p2);
          if (ch + 2 < NCH) {
            pw = wsrc[(size_t)(ch + 2) * 256 + ht];
            const u32x4* ps = psrc + (size_t)(ch + 2) * 640;
            p0 = ps[ht]; p1 = ps[ht + 256]; if (ht < 128) p2 = ps[ht + 512];
          }
        }
        if (ch >= 1) {
          const float* pY = sY0 + ((ch - 1) & 1) * (SC_TC * 256);
          const int st = ht >> 4, r = ht & 15;
          const f32x4* yp = (const f32x4*)(pY + (st * 16 + r) * 16);
          f32x4 y0 = yp[0], y1 = yp[1], y2 = yp[2], y3 = yp[3];
          yraw[((size_t)b * SEQ + (ch - 1) * SC_TC + st) * RW + h * 64 + rb * 16 + r] =
              ((y0[0] + y0[1]) + (y0[2] + y0[3])) + ((y1[0] + y1[1]) + (y1[2] + y1[3])) + (((y2[0] + y2[1]) + (y2[2] + y2[3])) + ((y3[0] + y3[1]) + (y3[2] + y3[3])));
        }
      }
      __syncthreads();
    }
    if (helper) {
      const float* pY = sY0 + ((NCH - 1) & 1) * (SC_TC * 256);
      const int st = ht >> 4, r = ht & 15;
      const f32x4* yp = (const f32x4*)(pY + (st * 16 + r) * 16);
      f32x4 y0 = yp[0], y1 = yp[1], y2 = yp[2], y3 = yp[3];
      yraw[((size_t)b * SEQ + (NCH - 1) * SC_TC + st) * RW + h * 64 + rb * 16 + r] =
          ((y0[0] + y0[1]) + (y0[2] + y0[3])) + ((y1[0] + y1[1]) + (y1[2] + y1[3])) + (((y2[0] + y2[1]) + (y2[2] + y2[3])) + ((y3[0] + y3[1]) + (y3[2] + y3[3])));
    }
  }
}

__device__ __forceinline__ void d_rwkv_post(const float* __restrict__ yraw, const u16* __restrict__ proj, const float* __restrict__ mu,
                                                   const float* __restrict__ bon, const float* __restrict__ gate_, const float* __restrict__ lnw,
                                                   const float* __restrict__ lnb, u16* __restrict__ cat, const int bid0, const int nb0, unsigned char* smem) {
  const int bid = sfresh(bid0), nb = sfresh(nb0);
  const int tidf = tid_fresh();
  const int lane = tidf & 63, wave = tidf >> 6;
  const int hq = lane >> 4, l16 = lane & 15;
  const u16* gate = (const u16*)gate_;
  constexpr int NITEM = (NTOK / 4) * (RH / 4);
  for (int it = bid * NWV + wave; it < NITEM; it += nb * NWV) {
    const int hg = it & 3, t0 = (it >> 2) * 4;
    const int h = hg * 4 + hq;
    const int s0 = t0 % SEQ;
    const int c = h * 64 + 4 * l16;
    const f32x4 muv = *(const f32x4*)(mu + 2 * RW + c), lw_ = *(const f32x4*)(lnw + c), lb_ = *(const f32x4*)(lnb + c);
    f32x4 y[4], pv[5]; uint2 g[4]; float bo[4];
    const u16* p0 = proj + (size_t)t0 * RCOLS + 2 * RW + c;
    pv[0] = (f32x4){0.f, 0.f, 0.f, 0.f};
    if (s0 != 0) pv[0] = ld_bf4(p0 - RCOLS);
#pragma unroll
    for (int u = 0; u < 4; ++u) {
      y[u] = *(const f32x4*)(yraw + (size_t)(t0 + u) * RW + c);
      pv[u + 1] = ld_bf4(p0 + (size_t)u * RCOLS);
      g[u] = *(const uint2*)(gate + (size_t)(t0 + u) * RW + c);
      bo[u] = bon[(size_t)(t0 + u) * RH + h];
    }
#pragma unroll
    for (int u = 0; u < 4; ++u) {
      float sm = (y[u][0] + y[u][1]) + (y[u][2] + y[u][3]);
      float sq = (y[u][0] * y[u][0] + y[u][1] * y[u][1]) + (y[u][2] * y[u][2] + y[u][3] * y[u][3]);
      sm = row16_sum(sm); sq = row16_sum(sq);
      const float mean = sm * (1.f / 64.f);
      const float var = fmaxf(sq * (1.f / 64.f) - mean * mean, 0.f);
      const float rs = __builtin_amdgcn_rsqf(var + 64e-5f);
      const f32x4 gf = (f32x4){__uint_as_float(g[u].x << 16), __uint_as_float(g[u].x & 0xffff0000u), __uint_as_float(g[u].y << 16), __uint_as_float(g[u].y & 0xffff0000u)};
      float o[4];
#pragma unroll
      for (int j = 0; j < 4; ++j) {
        const float yn = (y[u][j] - mean) * rs * lw_[j] + lb_[j];
        const float v = pv[u + 1][j] + (pv[u][j] - pv[u + 1][j]) * muv[j];
        o[j] = (yn + bo[u] * v) * gf[j];
      }
      uint2 ov; ov.x = pack2(o[0], o[1]); ov.y = pack2(o[2], o[3]);
      *(uint2*)(cat + (size_t)(t0 + u) * D_MODEL + c) = ov;
    }
  }
}

__device__ __forceinline__ void d_rope_table(const int* __restrict__ pos, float* __restrict__ tab, const int bid0, const int nb0, unsigned char* smem) {
  const int bid = sfresh(bid0), nb = sfresh(nb0);
  const int tidf = tid_fresh();
  for (int i = bid * NT + tidf; i < NTOK * 8; i += nb * NT) {
    int t = i >> 3, dd = i & 7;
    float inv = (dd & 4) ? ((dd & 2) ? ((dd & 1) ? 1.031338537721246e-05f : 5.3182958969449883e-05f)
                                     : ((dd & 1) ? 0.0002742481756762073f : 0.001414213562373095f))
                         : ((dd & 2) ? ((dd & 1) ? 0.0072926647372171093f : 0.037606030930863933f)
                                     : ((dd & 1) ? 0.19392274474868576f : 1.0f));
    float ang = (float)pos[t] * inv;
    float sn, cs;
    sincosf(ang, &sn, &cs);
    tab[(size_t)t * 16 + dd] = cs;
    tab[(size_t)t * 16 + 8 + dd] = sn;
  }
}

struct AttnArgs {
  const u16* Q; int ldq;
  const u16* K; int ldk;
  const u16* Vt; int ldv;
  u16* O; int ldo; int ocol0;
  int nb, nh, sq, sk;
  float scale;
  const float* lq1; const float* lk1; const float* lq2; const float* lk2; const float* subw; float lam_init;
  const float* Qf0; const float* Qf1;
};
template <int DQK, int NCOMP, bool CAUSAL>
__device__ __forceinline__ void attn_item(const AttnArgs& a, int b, int h, int qt, u16* smem) {
  constexpr int KS = DQK + 8;
  constexpr int KST = DQK / 32;
  u16* sK = smem;
  u16* sV = sK + NCOMP * 64 * KS;
  u16* sP = sV + 128 * 72;
  const int tid = tid_fresh() & 255, lane = tid & 63, wave = tid >> 6;
  const int l15 = lane & 15, l4 = lane >> 4;
  const int hq = h * (NCOMP * DQK);
  const size_t qrow0 = (size_t)b * a.sq + qt * 64 + wave * 16;
  const float sc = a.scale * 1.4426950408889634f;

  bf16x8 qf[NCOMP][KST];
#pragma unroll
  for (int c = 0; c < NCOMP; ++c)
#pragma unroll
    for (int ks = 0; ks < KST; ++ks)
    {
      if (!CAUSAL) {
        const size_t qo = (qrow0 + l15) * a.ldq + hq + c * DQK + ks * 32 + l4 * 8;
        f32x4 x0 = *(const f32x4*)(a.Qf0 + qo), x1 = *(const f32x4*)(a.Qf0 + qo + 4);
        f32x4 y0 = *(const f32x4*)(a.Qf1 + qo), y1 = *(const f32x4*)(a.Qf1 + qo + 4);
        u32x4 pk_ = (u32x4){pack2(x0[0] + y0[0], x0[1] + y0[1]), pack2(x0[2] + y0[2], x0[3] + y0[3]),
                            pack2(x1[0] + y1[0], x1[1] + y1[1]), pack2(x1[2] + y1[2], x1[3] + y1[3])};
        qf[c][ks] = __builtin_bit_cast(bf16x8, pk_);
      } else
      qf[c][ks] = *(const bf16x8*)(a.Q + (qrow0 + l15) * a.ldq + hq + c * DQK + ks * 32 + l4 * 8);
    }

  f32x4 O[NCOMP][8];
  float m[NCOMP][4], l[NCOMP][4];
#pragma unroll
  for (int c = 0; c < NCOMP; ++c) {
#pragma unroll
    for (int d = 0; d < 8; ++d) O[c][d] = (f32x4){0.f, 0.f, 0.f, 0.f};
#pragma unroll
    for (int i = 0; i < 4; ++i) { m[c][i] = -INFINITY; l[c][i] = 0.f; }
  }
  const int nkt = CAUSAL ? (qt + 1) : (a.sk / 64);
  constexpr int KCH = NCOMP * 64 * (DQK / 8) / 256;
  u32x4 rk[KCH], rv[4];
  auto gload = [&](int kt) {
#pragma unroll
    for (int i = 0; i < KCH; ++i) {
      int cidx = tid + 256 * i;
      int kc = cidx % (DQK / 8), rowc = cidx / (DQK / 8);
      int c = rowc / 64, key = rowc % 64;
      rk[i] = *(const u32x4*)(a.K + ((size_t)b * a.sk + kt * 64 + key) * a.ldk + hq + c * DQK + kc * 8);
    }
#pragma unroll
    for (int i = 0; i < 4; ++i) {
      int cidx = tid + 256 * i;
      int kc = cidx & 7, dv = cidx >> 3;
      rv[i] = *(const u32x4*)(a.Vt + (size_t)(h * 128 + dv) * a.ldv + (size_t)b * a.sk + kt * 64 + kc * 8);
    }
  };
  auto swrite = [&]() {
#pragma unroll
    for (int i = 0; i < KCH; ++i) {
      int cidx = tid + 256 * i;
      int kc = cidx % (DQK / 8), rowc = cidx / (DQK / 8);
      *(u32x4*)(sK + rowc * KS + kc * 8) = rk[i];
    }
#pragma unroll
    for (int i = 0; i < 4; ++i) {
      int cidx = tid + 256 * i;
      int kc = cidx & 7, dv = cidx >> 3;
      *(u32x4*)(sV + dv * 72 + kc * 8) = rv[i];
    }
  };
  gload(0);
  for (int kt = 0; kt < nkt; ++kt) {
    __syncthreads();
    swrite();
    __syncthreads();
    if (kt + 1 < nkt) gload(kt + 1);
#pragma unroll
    for (int c = 0; c < NCOMP; ++c) {
      f32x4 S[4];
#pragma unroll
      for (int sub = 0; sub < 4; ++sub) {
        f32x4 acc = (f32x4){0.f, 0.f, 0.f, 0.f};
#pragma unroll
        for (int ks = 0; ks < KST; ++ks) {
          bf16x8 kf = *(const bf16x8*)(sK + (c * 64 + sub * 16 + l15) * KS + ks * 32 + l4 * 8);
          acc = __builtin_amdgcn_mfma_f32_16x16x32_bf16(qf[c][ks], kf, acc, 0, 0, 0);
        }
        S[sub] = acc;
      }
#pragma unroll
      for (int sub = 0; sub < 4; ++sub)
#pragma unroll
        for (int i = 0; i < 4; ++i) {
          float sv_ = S[sub][i] * sc;
          if (CAUSAL && kt == qt) {
            int keyl = sub * 16 + l15, rowl = wave * 16 + l4 * 4 + i;
            if (keyl > rowl) sv_ = -INFINITY;
          }
          S[sub][i] = sv_;
        }
#pragma unroll
      for (int i = 0; i < 4; ++i) {
        float mx = fmaxf(fmaxf(S[0][i], S[1][i]), fmaxf(S[2][i], S[3][i]));
        mx = row16_max(mx);
        float mn = fmaxf(m[c][i], mx);
        float alpha = exp2f(m[c][i] - mn);
        m[c][i] = mn;
        float ps = 0.f;
#pragma unroll
        for (int sub = 0; sub < 4; ++sub) {
          float pe = exp2f(S[sub][i] - mn);
          S[sub][i] = pe;
          ps += pe;
        }
        l[c][i] = l[c][i] * alpha + ps;
#pragma unroll
        for (int d = 0; d < 8; ++d) O[c][d][i] *= alpha;
      }
      u16* pw = sP + wave * 16 * 72;
      __syncthreads();
#pragma unroll
      for (int sub = 0; sub < 4; ++sub)
#pragma unroll
        for (int i = 0; i < 4; ++i) pw[(l4 * 4 + i) * 72 + sub * 16 + l15] = f2bf(S[sub][i]);
      __syncthreads();
#pragma unroll
      for (int ks = 0; ks < 2; ++ks) {
        bf16x8 pf = *(const bf16x8*)(pw + l15 * 72 + ks * 32 + l4 * 8);
#pragma unroll
        for (int d = 0; d < 8; ++d) {
          bf16x8 vf = *(const bf16x8*)(sV + (d * 16 + l15) * 72 + ks * 32 + l4 * 8);
          O[c][d] = __builtin_amdgcn_mfma_f32_16x16x32_bf16(pf, vf, O[c][d], 0, 0, 0);
        }
      }
    }
  }
  float inv[NCOMP][4];
#pragma unroll
  for (int c = 0; c < NCOMP; ++c)
#pragma unroll
    for (int i = 0; i < 4; ++i) inv[c][i] = 1.f / row16_sum(l[c][i]);
  if (NCOMP == 2) {
    float s1 = 0.f, s2 = 0.f;
    for (int j = 0; j < 64; ++j) { s1 += a.lq1[j] * a.lk1[j]; s2 += a.lq2[j] * a.lk2[j]; }
    float lam = expf(s1) - expf(s2) + a.lam_init;
    float ss[4] = {0.f, 0.f, 0.f, 0.f};
#pragma unroll
    for (int d = 0; d < 8; ++d)
#pragma unroll
      for (int i = 0; i < 4; ++i) {
        float o = O[0][d][i] * inv[0][i] - lam * (O[NCOMP - 1][d][i] * inv[NCOMP - 1][i]);
        O[0][d][i] = o;
        ss[i] += o * o;
      }
#pragma unroll
    for (int i = 0; i < 4; ++i) ss[i] = rsqrtf(row16_sum(ss[i]) * (1.f / 128.f) + 1e-5f) * (1.f - a.lam_init);
#pragma unroll
    for (int d = 0; d < 8; ++d) {
      float sw = a.subw[d * 16 + l15];
#pragma unroll
      for (int i = 0; i < 4; ++i)
        a.O[(qrow0 + l4 * 4 + i) * a.ldo + a.ocol0 + h * 128 + d * 16 + l15] = f2bf(O[0][d][i] * ss[i] * sw);
    }
  } else {
#pragma unroll
    for (int d = 0; d < 8; ++d)
#pragma unroll
      for (int i = 0; i < 4; ++i)
        a.O[(qrow0 + l4 * 4 + i) * a.ldo + a.ocol0 + h * 128 + d * 16 + l15] = f2bf(O[0][d][i] * inv[0][i]);
  }
}
typedef __attribute__((ext_vector_type(16))) float f32x16;
__device__ __forceinline__ void attn2_item(const AttnArgs& a, float* u1, int b, int h, int qb, int c, unsigned char* shm) {
  const int tid = tid_fresh(), lane = tid & 63, wave = tid >> 6;
  const int q = lane & 31, hh = lane >> 5;
  const int q0 = qb * 256 + wave * 32;
  const size_t qrow = (size_t)b * SEQ + q0 + q;
  const float sc = 0.125f * 1.4426950408889634f;
  bf16x8 qf[4];
#pragma unroll
  for (int s = 0; s < 4; ++s) qf[s] = *(const bf16x8*)(a.Q + qrow * 1024 + h * 128 + c * 64 + 16 * s + 8 * hh);
  f32x16 O[4];
  float m = -INFINITY, l = 0.f;
#pragma unroll
  for (int t = 0; t < 4; ++t)
#pragma unroll
    for (int r = 0; r < 16; ++r) O[t][r] = 0.f;
  const int nkt = 4 * qb + 4;
  unsigned koff[1], voff[2];
  {
    int row = 8 * wave + (lane >> 3);
    int chunk = (lane & 7) ^ ((row >> 1) & 7);
    koff[0] = (unsigned)(row * 1024 + chunk * 8);
  }
#pragma unroll
  for (int i = 0; i < 2; ++i) {
    int row = 8 * (wave * 2 + i) + (lane >> 3);
    int chunk = (lane & 7) ^ ((row >> 1) & 7);
    voff[i] = (unsigned)(row * NTOK + chunk * 8);
  }
  const u16* kbase = a.K + (size_t)b * SEQ * 1024 + h * 128 + c * 64;
  const u16* vbase = a.Vt + (size_t)h * 128 * NTOK + (size_t)b * SEQ;
#define A2_STAGE(BUF, KT) { \
    __builtin_amdgcn_global_load_lds((const unsigned*)(kbase + (size_t)(KT) * 64 * 1024 + koff[0]), (unsigned*)(shm + (BUF) * 24576 + wave * 1024), 16, 0, 0); \
    _Pragma("unroll") for (int i = 0; i < 2; ++i) \
      __builtin_amdgcn_global_load_lds((const unsigned*)(vbase + (KT) * 64 + voff[i]), (unsigned*)(shm + (BUF) * 24576 + 8192 + (wave * 2 + i) * 1024), 16, 0, 0); }
#define A2_KFRAG(BASE, T_, s_) (*(const bf16x8*)((BASE) + (32 * (T_) + q) * 128 + (((2 * (s_) + hh) ^ (((32 * (T_) + q) >> 1) & 7)) << 4)))
#define A2_VFRAG(BASE, t_, s2_) (*(const bf16x8*)((BASE) + (32 * (t_) + q) * 128 + (((2 * (s2_) + hh) ^ (((32 * (t_) + q) >> 1) & 7)) << 4)))
#define A2_EXPQ(J) { _Pragma("unroll") for (int r_ = 0; r_ < 8; r_ += 2) { \
      float p0 = __builtin_amdgcn_exp2f(S[(J) >> 1][((J) & 1) * 8 + r_]), p1 = __builtin_amdgcn_exp2f(S[(J) >> 1][((J) & 1) * 8 + r_ + 1]); \
      ps += p0 + p1; pk[(J) >> 1][((J) & 1) * 4 + (r_ >> 1)] = pack2(p0, p1); } }
#define A2_PV(VF, J) { u32x4 pw_ = (u32x4){pk[(J) >> 1][((J) & 1) * 4 + 0], pk[(J) >> 1][((J) & 1) * 4 + 1], pk[(J) >> 1][((J) & 1) * 4 + 2], pk[(J) >> 1][((J) & 1) * 4 + 3]}; \
      bf16x8 pf = __builtin_bit_cast(bf16x8, pw_); \
      _Pragma("unroll") for (int t = 0; t < 4; ++t) O[t] = __builtin_amdgcn_mfma_f32_32x32x16_bf16(VF[t], pf, O[t], 0, 0, 0); }
#define A2_TILE(BUF, KT) { \
    const unsigned char* vim = shm + (BUF) * 24576 + 8192; const unsigned char* kimn = shm + (((BUF) + 1) & 3) * 24576; \
      \
      \
    const float negm = ((KT) == 0) ? 0.f : -m; \
    f32x16 S[2]; \
    _Pragma("unroll") for (int T = 0; T < 2; ++T) { \
      _Pragma("unroll") for (int r = 0; r < 16; ++r) S[T][r] = negm; \
      _Pragma("unroll") for (int s = 0; s < 4; ++s) S[T] = __builtin_amdgcn_mfma_f32_32x32x16_bf16(kf[T][s], qf[s], S[T], 0, 0, 0); } \
    bf16x8 vfa[4], vfb[4]; \
    _Pragma("unroll") for (int t = 0; t < 4; ++t) vfa[t] = A2_VFRAG(vim, t, 0); \
    __builtin_amdgcn_sched_barrier(0); \
    if ((KT) * 64 + 63 > q0) {     \
      _Pragma("unroll") for (int T = 0; T < 2; ++T) _Pragma("unroll") for (int r = 0; r < 16; ++r) { \
        int key = (KT) * 64 + 32 * T + 8 * (r >> 2) + 4 * hh + (r & 3); if (key > q0 + q) S[T][r] = -INFINITY; } } \
    float mx = -INFINITY; \
    _Pragma("unroll") for (int T = 0; T < 2; ++T) _Pragma("unroll") for (int r = 0; r < 16; ++r) mx = fmaxf(mx, S[T][r]); \
    mx = fmaxf(mx, __shfl_xor(mx, 32)); \
    if ((KT) == 0) {               \
      m = mx; \
      _Pragma("unroll") for (int T = 0; T < 2; ++T) _Pragma("unroll") for (int r = 0; r < 16; ++r) S[T][r] -= mx; \
    } else if (__any(mx > 6.0f)) {     \
      const float d = fmaxf(mx, 0.f); \
      const float alpha = __builtin_amdgcn_exp2f(-d); \
      m += d; l *= alpha; \
      _Pragma("unroll") for (int t = 0; t < 4; ++t) _Pragma("unroll") for (int r = 0; r < 16; ++r) O[t][r] *= alpha; \
      _Pragma("unroll") for (int T = 0; T < 2; ++T) _Pragma("unroll") for (int r = 0; r < 16; ++r) S[T][r] -= d; } \
    float ps = 0.f; \
    uint32_t pk[2][8]; \
    A2_EXPQ(0); \
    __builtin_amdgcn_sched_barrier(0); \
    _Pragma("unroll") for (int t = 0; t < 4; ++t) vfb[t] = A2_VFRAG(vim, t, 1); \
    kf[0][0] = A2_KFRAG(kimn, 0, 0); kf[0][1] = A2_KFRAG(kimn, 0, 1); \
    A2_EXPQ(1); A2_PV(vfa, 0); \
    __builtin_amdgcn_sched_barrier(0); \
    _Pragma("unroll") for (int t = 0; t < 4; ++t) vfa[t] = A2_VFRAG(vim, t, 2); \
    kf[0][2] = A2_KFRAG(kimn, 0, 2); kf[0][3] = A2_KFRAG(kimn, 0, 3); \
    A2_EXPQ(2); A2_PV(vfb, 1); \
    __builtin_amdgcn_sched_barrier(0); \
    _Pragma("unroll") for (int t = 0; t < 4; ++t) vfb[t] = A2_VFRAG(vim, t, 3); \
    kf[1][0] = A2_KFRAG(kimn, 1, 0); kf[1][1] = A2_KFRAG(kimn, 1, 1); \
    A2_EXPQ(3); A2_PV(vfa, 2); \
    __builtin_amdgcn_sched_barrier(0); \
    kf[1][2] = A2_KFRAG(kimn, 1, 2); kf[1][3] = A2_KFRAG(kimn, 1, 3); \
    A2_PV(vfb, 3); \
    __builtin_amdgcn_sched_barrier(0); \
    l += ps; }
  __syncthreads();
  A2_STAGE(0, 0);
  A2_STAGE(1, 1);
  A2_STAGE(2, 2);
  asm volatile("s_waitcnt vmcnt(3)" ::: "memory");
  asm volatile("s_waitcnt lgkmcnt(0)" ::: "memory");
  __builtin_amdgcn_s_barrier();
  {
    bf16x8 kf[2][4];
#pragma unroll
    for (int T = 0; T < 2; ++T)
#pragma unroll
      for (int s = 0; s < 4; ++s) kf[T][s] = A2_KFRAG(shm, T, s);
    int buf = 0;
    for (int kt = 0; kt < nkt; ++kt) {
      if (kt + 3 < nkt) A2_STAGE((buf + 3) & 3, kt + 3);
      A2_TILE(buf, kt);
      if (kt + 3 < nkt) asm volatile("s_waitcnt vmcnt(3)" ::: "memory"); else asm volatile("s_waitcnt vmcnt(0)" ::: "memory");
      asm volatile("s_waitcnt lgkmcnt(0)" ::: "memory");
      __builtin_amdgcn_s_barrier();
      buf = (buf + 1) & 3;
    }
  }
#undef A2_KFRAG
#undef A2_VFRAG
#undef A2_EXPQ
#undef A2_PV
#undef A2_STAGE
#undef A2_TILE
  const float inv = 1.f / (l + __shfl_xor(l, 32));
  float* urow = u1 + qrow * 1024 + h * 128;
  if (c == 0) {
#pragma unroll
    for (int t = 0; t < 4; ++t)
#pragma unroll
      for (int g = 0; g < 4; ++g) {
        const int dv = 32 * t + 8 * g + 4 * hh;
        *(f32x4*)(urow + dv) = (f32x4){O[t][4 * g] * inv, O[t][4 * g + 1] * inv, O[t][4 * g + 2] * inv, O[t][4 * g + 3] * inv};
      }
    return;
  }
  float s1 = 0.f, s2 = 0.f;
  for (int j = 0; j < 64; ++j) { s1 += a.lq1[j] * a.lk1[j]; s2 += a.lq2[j] * a.lk2[j]; }
  const float lam = expf(s1) - expf(s2) + a.lam_init;
  const float c1 = lam * inv;
  float ss = 0.f;
#pragma unroll
  for (int t = 0; t < 4; ++t)
#pragma unroll
    for (int g = 0; g < 4; ++g) {
      const int dv = 32 * t + 8 * g + 4 * hh;
      f32x4 u4 = *(const f32x4*)(urow + dv);
#pragma unroll
      for (int i = 0; i < 4; ++i) { float o = u4[i] - c1 * O[t][4 * g + i]; O[t][4 * g + i] = o; ss += o * o; }
    }
  ss += __shfl_xor(ss, 32);
  const float rn = rsqrtf(ss * (1.f / 128.f) + 1e-5f) * (1.f - a.lam_init);
  u16* orow = a.O + qrow * a.ldo + a.ocol0 + h * 128;
#pragma unroll
  for (int t = 0; t < 4; ++t)
#pragma unroll
    for (int g = 0; g < 4; ++g) {
      const int dv = 32 * t + 8 * g + 4 * hh;
      f32x4 w4 = *(const f32x4*)(a.subw + dv);
      uint2 ov;
      ov.x = pack2(O[t][4 * g + 0] * rn * w4[0], O[t][4 * g + 1] * rn * w4[1]);
      ov.y = pack2(O[t][4 * g + 2] * rn * w4[2], O[t][4 * g + 3] * rn * w4[3]);
      *(uint2*)(orow + dv) = ov;
    }
}


__device__ __forceinline__ void xattn2_item(const AttnArgs& a, int b, int h, int qb, unsigned char* shm) {
  const int tid = tid_fresh(), lane = tid & 63, wave = tid >> 6;
  const int q = lane & 31, hh = lane >> 5;
  const int q0 = qb * 256 + wave * 32;
  const size_t qrow = (size_t)b * SEQ + q0 + q;
  const float qs = 0.08838834764831845f * 1.4426950408889634f;
  f32x4 qa[8][2], qb2[8][2];
  {
    const float* q0p = a.Qf0 + qrow * 512 + h * 128 + 8 * hh;
    const float* q1p = a.Qf1 + qrow * 512 + h * 128 + 8 * hh;
#pragma unroll
    for (int s = 0; s < 8; ++s) {
      qa[s][0] = *(const f32x4*)(q0p + 16 * s); qa[s][1] = *(const f32x4*)(q0p + 16 * s + 4);
      qb2[s][0] = *(const f32x4*)(q1p + 16 * s); qb2[s][1] = *(const f32x4*)(q1p + 16 * s + 4);
    }
  }
  __syncthreads();
#pragma unroll
  for (int kt = 0; kt < 4; ++kt) {
#pragma unroll
    for (int i = 0; i < 2; ++i) {
      const int n = wave * 2 + i;
      { const int row = 4 * n + (lane >> 4), chunk = (lane & 15) ^ (row & 15);
        const u16* src = a.K + ((size_t)(b * MEM_LEN + kt * 64 + row) * 512 + h * 128 + chunk * 8);
        __builtin_amdgcn_global_load_lds((const unsigned*)src, (unsigned*)(shm + kt * 32768 + n * 1024), 16, 0, 0); }
      { const int row = 8 * n + (lane >> 3), chunk = (lane & 7) ^ ((row >> 1) & 7);
        const u16* src = a.Vt + ((size_t)(h * 128 + row) * (BATCH * MEM_LEN) + b * MEM_LEN + kt * 64 + chunk * 8);
        __builtin_amdgcn_global_load_lds((const unsigned*)src, (unsigned*)(shm + kt * 32768 + 16384 + n * 1024), 16, 0, 0); }
    }
  }
  bf16x8 qf[8];
#pragma unroll
  for (int s = 0; s < 8; ++s) {
    const f32x4 a0 = qa[s][0], a1 = qa[s][1], b0 = qb2[s][0], b1 = qb2[s][1];
    u32x4 w;
    w[0] = pack2((a0[0] + b0[0]) * qs, (a0[1] + b0[1]) * qs); w[1] = pack2((a0[2] + b0[2]) * qs, (a0[3] + b0[3]) * qs);
    w[2] = pack2((a1[0] + b1[0]) * qs, (a1[1] + b1[1]) * qs); w[3] = pack2((a1[2] + b1[2]) * qs, (a1[3] + b1[3]) * qs);
    qf[s] = __builtin_bit_cast(bf16x8, w);
  }
  f32x16 O[4];
  float m = 0.f, l = 0.f;
#pragma unroll
  for (int t = 0; t < 4; ++t)
#pragma unroll
    for (int r = 0; r < 16; ++r) O[t][r] = 0.f;
#define XA_KFRAG(BASE, T_, s_) (*(const bf16x8*)((BASE) + (32 * (T_) + q) * 256 + (((2 * (s_) + hh) ^ ((32 * (T_) + q) & 15)) << 4)))
#define XA_VFRAG(BASE, t_, s2_) (*(const bf16x8*)((BASE) + (32 * (t_) + q) * 128 + (((2 * (s2_) + hh) ^ (((32 * (t_) + q) >> 1) & 7)) << 4)))
#define XA_EXPQ(J) { _Pragma("unroll") for (int r_ = 0; r_ < 8; r_ += 2) { \
      float p0 = __builtin_amdgcn_exp2f(S[(J) >> 1][((J) & 1) * 8 + r_]), p1 = __builtin_amdgcn_exp2f(S[(J) >> 1][((J) & 1) * 8 + r_ + 1]); \
      ps += p0 + p1; pk[(J) >> 1][((J) & 1) * 4 + (r_ >> 1)] = pack2(p0, p1); } }
#define XA_PV(VF, J) { u32x4 pw_ = (u32x4){pk[(J) >> 1][((J) & 1) * 4 + 0], pk[(J) >> 1][((J) & 1) * 4 + 1], pk[(J) >> 1][((J) & 1) * 4 + 2], pk[(J) >> 1][((J) & 1) * 4 + 3]}; \
      bf16x8 pf = __builtin_bit_cast(bf16x8, pw_); \
      _Pragma("unroll") for (int t = 0; t < 4; ++t) O[t] = __builtin_amdgcn_mfma_f32_32x32x16_bf16(VF[t], pf, O[t], 0, 0, 0); }
#define XA_TILE(KT) { \
    const unsigned char* kim = shm + (KT) * 32768; const unsigned char* vim = kim + 16384; \
    const float negm = ((KT) == 0) ? 0.f : -m; \
    f32x16 S[2]; \
    _Pragma("unroll") for (int T = 0; T < 2; ++T) { \
      _Pragma("unroll") for (int r = 0; r < 16; ++r) S[T][r] = negm; \
      bf16x8 ka[4], kb[4]; \
      _Pragma("unroll") for (int s = 0; s < 4; ++s) ka[s] = XA_KFRAG(kim, T, s); \
      _Pragma("unroll") for (int s = 0; s < 4; ++s) kb[s] = XA_KFRAG(kim, T, 4 + s); \
      __builtin_amdgcn_sched_barrier(0); \
      _Pragma("unroll") for (int s = 0; s < 4; ++s) S[T] = __builtin_amdgcn_mfma_f32_32x32x16_bf16(ka[s], qf[s], S[T], 0, 0, 0); \
      _Pragma("unroll") for (int s = 0; s < 4; ++s) S[T] = __builtin_amdgcn_mfma_f32_32x32x16_bf16(kb[s], qf[4 + s], S[T], 0, 0, 0); \
      __builtin_amdgcn_sched_barrier(0); } \
    bf16x8 vfa[4], vfb[4]; \
    _Pragma("unroll") for (int t = 0; t < 4; ++t) vfa[t] = XA_VFRAG(vim, t, 0); \
    float mx = -INFINITY; \
    _Pragma("unroll") for (int T = 0; T < 2; ++T) _Pragma("unroll") for (int r = 0; r < 16; ++r) mx = fmaxf(mx, S[T][r]); \
    mx = fmaxf(mx, __shfl_xor(mx, 32)); \
    if ((KT) == 0) { \
      m = mx; \
      _Pragma("unroll") for (int T = 0; T < 2; ++T) _Pragma("unroll") for (int r = 0; r < 16; ++r) S[T][r] -= mx; \
    } else if (__any(mx > 6.0f)) { \
      const float d = fmaxf(mx, 0.f); \
      const float alpha = __builtin_amdgcn_exp2f(-d); \
      m += d; l *= alpha; \
      _Pragma("unroll") for (int t = 0; t < 4; ++t) _Pragma("unroll") for (int r = 0; r < 16; ++r) O[t][r] *= alpha; \
      _Pragma("unroll") for (int T = 0; T < 2; ++T) _Pragma("unroll") for (int r = 0; r < 16; ++r) S[T][r] -= d; } \
    float ps = 0.f; \
    uint32_t pk[2][8]; \
    XA_EXPQ(0); \
    __builtin_amdgcn_sched_barrier(0); \
    _Pragma("unroll") for (int t = 0; t < 4; ++t) vfb[t] = XA_VFRAG(vim, t, 1); \
    XA_EXPQ(1); XA_PV(vfa, 0); \
    __builtin_amdgcn_sched_barrier(0); \
    _Pragma("unroll") for (int t = 0; t < 4; ++t) vfa[t] = XA_VFRAG(vim, t, 2); \
    XA_EXPQ(2); XA_PV(vfb, 1); \
    __builtin_amdgcn_sched_barrier(0); \
    _Pragma("unroll") for (int t = 0; t < 4; ++t) vfb[t] = XA_VFRAG(vim, t, 3); \
    XA_EXPQ(3); XA_PV(vfa, 2); \
    __builtin_amdgcn_sched_barrier(0); \
    XA_PV(vfb, 3); \
    __builtin_amdgcn_sched_barrier(0); \
    l += ps; }
  asm volatile("s_waitcnt vmcnt(12)" ::: "memory"); __builtin_amdgcn_s_barrier();
  XA_TILE(0);
  asm volatile("s_waitcnt vmcnt(8)" ::: "memory"); __builtin_amdgcn_s_barrier();
  XA_TILE(1);
  asm volatile("s_waitcnt vmcnt(4)" ::: "memory"); __builtin_amdgcn_s_barrier();
  XA_TILE(2);
  asm volatile("s_waitcnt vmcnt(0)" ::: "memory"); __builtin_amdgcn_s_barrier();
  XA_TILE(3);
#undef XA_KFRAG
#undef XA_VFRAG
#undef XA_EXPQ
#undef XA_PV
#undef XA_TILE
  const float inv = 1.f / (l + __shfl_xor(l, 32));
  u16* orow = a.O + qrow * a.ldo + a.ocol0 + h * 128;
#pragma unroll
  for (int t = 0; t < 4; ++t)
#pragma unroll
    for (int g = 0; g < 4; ++g) {
      const int dv = 32 * t + 8 * g + 4 * hh;
      uint2 ov;
      ov.x = pack2(O[t][4 * g + 0] * inv, O[t][4 * g + 1] * inv);
      ov.y = pack2(O[t][4 * g + 2] * inv, O[t][4 * g + 3] * inv);
      *(uint2*)(orow + dv) = ov;
    }
}

__device__ __forceinline__ uint32_t fkey(float f) {
  uint32_t u = __float_as_uint(f);
  return (u & 0x80000000u) ? ~u : (u | 0x80000000u);
}
template <int E>
__device__ __forceinline__ void top16_select(const uint32_t (&key)[E], bool (&sel)[E], int lane) {
  uint32_t prefix = 0;
  int k = 16, R = 64 * E, b = 31;
  for (; b >= 0; --b) {
    uint32_t cand = prefix | (1u << b);
    int cnt = 0;
#pragma unroll
    for (int e = 0; e < E; ++e) cnt += __popcll(__ballot((key[e] >> b) == (cand >> b)));
    if (cnt >= k) { prefix = cand; R = cnt; } else { k -= cnt; R -= cnt; }
    if (R == k) break;
  }
  if (R == k) {
    int bb = b < 0 ? 0 : b;
#pragma unroll
    for (int e = 0; e < E; ++e) sel[e] = (key[e] >> bb) >= (prefix >> bb);
    return;
  }
  int taken = 0;
  uint64_t lt = (lane == 0) ? 0ull : (~0ull >> (64 - lane));
#pragma unroll
  for (int e = 0; e < E; ++e) {
    bool eq = key[e] == prefix;
    uint64_t bm = __ballot(eq);
    int rank = taken + __popcll(bm & lt);
    sel[e] = (key[e] > prefix) || (eq && rank < k);
    taken += __popcll(bm);
  }
}
template <int CTRL>
__device__ __forceinline__ uint32_t dpp_u(uint32_t x) { return (uint32_t)__builtin_amdgcn_update_dpp(0, (int)x, CTRL, 0xf, 0xf, true); }
__device__ __forceinline__ uint32_t wave_max_u32(uint32_t x) {
  x = max(x, dpp_u<0xB1>(x));
  x = max(x, dpp_u<0x4E>(x));
  x = max(x, dpp_u<0x141>(x));
  x = max(x, dpp_u<0x140>(x));
  const uint32_t r0 = (uint32_t)__builtin_amdgcn_readlane((int)x, 0), r1 = (uint32_t)__builtin_amdgcn_readlane((int)x, 16);
  const uint32_t r2 = (uint32_t)__builtin_amdgcn_readlane((int)x, 32), r3 = (uint32_t)__builtin_amdgcn_readlane((int)x, 48);
  return max(max(r0, r1), max(r2, r3));
}
template <int NCH, int E>
__device__ __forceinline__ void top16_select_n(const uint32_t (&key)[NCH][E], bool (&sel)[NCH][E], int lane) {
  uint32_t prefix[NCH];
  int cntp[NCH];
#pragma unroll
  for (int c = 0; c < NCH; ++c) {
    uint32_t m = key[c][0];
#pragma unroll
    for (int e = 1; e < E; ++e) m = max(m, key[c][e]);
    prefix[c] = wave_max_u32(m) & 0xFF800000u;
    cntp[c] = 0;
  }
  int need = NCH;
  for (int j = 0; j < 6 && need != 0; ++j) {
    need = 0;
#pragma unroll
    for (int c = 0; c < NCH; ++c) {
      if (cntp[c] < 16) {
        if (j != 0) prefix[c] = prefix[c] >= 0x00800000u ? prefix[c] - 0x00800000u : 0u;
        int cnt = 0;
#pragma unroll
        for (int e = 0; e < E; ++e) cnt += __popcll(__ballot(key[c][e] >= prefix[c]));
        cntp[c] = cnt;
        need += (cnt < 16);
      }
    }
  }
  uint32_t startbit = 0x00400000u;
  if (need != 0) {
#pragma unroll
    for (int c = 0; c < NCH; ++c) { prefix[c] = 0; cntp[c] = 64 * E; }
    startbit = 0x80000000u;
  }
  int tot0 = 0;
#pragma unroll
  for (int c = 0; c < NCH; ++c) tot0 += cntp[c];
  if (tot0 != 16 * NCH)
  for (uint32_t bit = startbit; bit != 0u; bit >>= 1) {
    int tot = 0;
#pragma unroll
    for (int c = 0; c < NCH; ++c) {
      const uint32_t cand = prefix[c] | bit;
      int cnt = 0;
#pragma unroll
      for (int e = 0; e < E; ++e) cnt += __popcll(__ballot(key[c][e] >= cand));
      const bool up = cnt >= 16;
      prefix[c] = up ? cand : prefix[c];
      cntp[c] = up ? cnt : cntp[c];
      tot += cntp[c];
    }
    if (tot == 16 * NCH) break;
  }
  const uint64_t lt = (lane == 0) ? 0ull : (~0ull >> (64 - lane));
#pragma unroll
  for (int c = 0; c < NCH; ++c) {
    if (cntp[c] == 16) {
#pragma unroll
      for (int e = 0; e < E; ++e) sel[c][e] = key[c][e] >= prefix[c];
    } else {
      int ngt = 0;
#pragma unroll
      for (int e = 0; e < E; ++e) ngt += __popcll(__ballot(key[c][e] > prefix[c]));
      const int kk = 16 - ngt;
      int taken = 0;
#pragma unroll
      for (int e = 0; e < E; ++e) {
        bool eq = key[c][e] == prefix[c];
        uint64_t bm = __ballot(eq);
        sel[c][e] = (key[c][e] > prefix[c]) || (eq && taken + __popcll(bm & lt) < kk);
        taken += __popcll(bm);
      }
    }
  }
}
__device__ __forceinline__ void d_peer_topk(const float* __restrict__ scores, int* __restrict__ experts, float* __restrict__ gates, const int bid0, const int nb0, unsigned char* smem) {
  const int bid = sfresh(bid0), nb = sfresh(nb0);
  const int tidf = tid_fresh();
  int lane = tidf & 63, wave = tidf >> 6;
  float (*sv)[2][16] = (float (*)[2][16])(smem + wave * 512);
  int (*si)[2][16] = (int (*)[2][16])(smem + NWV * 512 + wave * 512);
  const uint64_t lt = (lane == 0) ? 0ull : (~0ull >> (64 - lane));
  for (int it0 = (bid * NWV + wave) * 2; it0 < NTOK * 8; it0 += nb * NWV * 2) {
    float s[4][2]; uint32_t key[4][2]; bool sel[4][2];
#pragma unroll
    for (int u = 0; u < 2; ++u) {
      const int it = it0 + u, t = it >> 3, h = it & 7;
      const float* sp = scores + (size_t)t * 2048 + h * 256;
#pragma unroll
      for (int c = 0; c < 2; ++c) { s[u * 2 + c][0] = sp[c * 128 + lane]; s[u * 2 + c][1] = sp[c * 128 + 64 + lane]; }
    }
#pragma unroll
    for (int c = 0; c < 4; ++c) { key[c][0] = fkey(s[c][0]); key[c][1] = fkey(s[c][1]); }
    top16_select_n<4, 2>(key, sel, lane);
#pragma unroll
    for (int c = 0; c < 4; ++c) {
      int base = 0;
#pragma unroll
      for (int e = 0; e < 2; ++e) {
        uint64_t bm = __ballot(sel[c][e]);
        if (sel[c][e]) { int p = base + __popcll(bm & lt); sv[c >> 1][c & 1][p] = s[c][e]; si[c >> 1][c & 1][p] = lane + 64 * e; }
        base += __popcll(bm);
      }
    }
    __builtin_amdgcn_wave_barrier();
    __threadfence_block();
    float cv[2][4]; uint32_t ck[2][4]; bool csel[2][4];
#pragma unroll
    for (int u = 0; u < 2; ++u)
#pragma unroll
      for (int e = 0; e < 4; ++e) {
        int ci = e * 64 + lane;
        cv[u][e] = sv[u][0][ci >> 4] + sv[u][1][ci & 15];
        ck[u][e] = fkey(cv[u][e]);
      }
    top16_select_n<2, 4>(ck, csel, lane);
#pragma unroll
    for (int u = 0; u < 2; ++u) {
      const int it = it0 + u, t = it >> 3, h = it & 7;
      float mx = -INFINITY;
#pragma unroll
      for (int e = 0; e < 4; ++e) if (csel[u][e]) mx = fmaxf(mx, cv[u][e]);
      mx = wave_max(mx);
      float ex[4], sum = 0.f;
#pragma unroll
      for (int e = 0; e < 4; ++e) { ex[e] = csel[u][e] ? expf(cv[u][e] - mx) : 0.f; sum += ex[e]; }
      sum = wave_sum(sum);
      float rinv = 1.f / sum;
      int base = 0;
#pragma unroll
      for (int e = 0; e < 4; ++e) {
        uint64_t bm = __ballot(csel[u][e]);
        if (csel[u][e]) {
          int p = base + __popcll(bm & lt);
          int ci = e * 64 + lane;
          experts[(size_t)t * 128 + h * 16 + p] = si[u][0][ci >> 4] * 128 + si[u][1][ci & 15];
          gates[(size_t)t * 128 + h * 16 + p] = ex[e] * rinv;
        }
        base += __popcll(bm);
      }
    }
    __builtin_amdgcn_wave_barrier();
    __threadfence_block();
  }
}

typedef __attribute__((ext_vector_type(8))) int i32x8;
typedef __attribute__((ext_vector_type(4))) int i32x4;
__device__ __forceinline__ void d_cvt_fp8(const float* __restrict__ src, unsigned char* __restrict__ dst, float* __restrict__ sinv, int rows,
                                          const int bid0, const int nb0, unsigned char* smem) {
  const int bid = sfresh(bid0), nb = sfresh(nb0);
  const int tidf = tid_fresh();
  const int lane = tidf & 63, wave = tidf >> 6;
  for (int row = bid * NWV + wave; row < rows; row += nb * NWV) {
    const f32x4* p = (const f32x4*)(src + (size_t)row * D_MODEL);
    f32x4 v[8];
    float amax = 0.f;
#pragma unroll
    for (int q = 0; q < 2; ++q)
#pragma unroll
      for (int k = 0; k < 4; ++k) {
        v[q * 4 + k] = p[q * 256 + lane * 4 + k];
#pragma unroll
        for (int j = 0; j < 4; ++j) amax = fmaxf(amax, fabsf(v[q * 4 + k][j]));
      }
    amax = wave_max(amax);
    float scale = 1.f, inv = 1.f;
    if (amax > 0.f) {
      int e = 134 - (int)((__float_as_uint(amax) >> 23) & 0xff);
      e = e > 120 ? 120 : (e < -120 ? -120 : e);
      scale = __uint_as_float((uint32_t)(e + 127) << 23);
      inv = __uint_as_float((uint32_t)(127 - e) << 23);
    }
#pragma unroll
    for (int q = 0; q < 2; ++q) {
      u32x4 o;
#pragma unroll
      for (int k = 0; k < 4; ++k) {
        int w = 0;
        w = __builtin_amdgcn_cvt_pk_fp8_f32(v[q * 4 + k][0] * scale, v[q * 4 + k][1] * scale, w, false);
        w = __builtin_amdgcn_cvt_pk_fp8_f32(v[q * 4 + k][2] * scale, v[q * 4 + k][3] * scale, w, true);
        o[k] = (unsigned)w;
      }
      *(u32x4*)(dst + (size_t)row * D_MODEL + q * 1024 + lane * 16) = o;
    }
    if (lane == 0) sinv[row] = inv;
  }
}

template <bool NATURAL>
__device__ __forceinline__ void d_cvt_fp4(const float* __restrict__ src, unsigned char* __restrict__ dst, float* __restrict__ sinv, int rows,
                                          const int bid0, const int nb0, unsigned char* smem) {
  const int bid = sfresh(bid0), nb = sfresh(nb0);
  const int tidf = tid_fresh();
  const int lane = tidf & 63, wave = tidf >> 6;
  for (int row = bid * NWV + wave; row < rows; row += nb * NWV) {
    const f32x4* p = (const f32x4*)(src + (size_t)row * D_MODEL);
    f32x4 v[8];
    float amax = 0.f;
#pragma unroll
    for (int q = 0; q < 2; ++q)
#pragma unroll
      for (int k = 0; k < 4; ++k) {
        v[q * 4 + k] = p[q * 256 + lane * 4 + k];
#pragma unroll
        for (int j = 0; j < 4; ++j) amax = fmaxf(amax, fabsf(v[q * 4 + k][j]));
      }
    amax = wave_max(amax);
    float scale = 1.f, inv = 1.f;
    if (amax > 0.f) { scale = 6.0f / amax; inv = amax * (1.0f / 6.0f); }
    u32x4 o;
#pragma unroll
    for (int k = 0; k < 4; ++k) {
      unsigned w = 0u;
      w = __builtin_amdgcn_cvt_scalef32_pk_fp4_f32(w, v[2 * k][0] * scale, v[2 * k][1] * scale, 1.0f, 0);
      w = __builtin_amdgcn_cvt_scalef32_pk_fp4_f32(w, v[2 * k][2] * scale, v[2 * k][3] * scale, 1.0f, 1);
      w = __builtin_amdgcn_cvt_scalef32_pk_fp4_f32(w, v[2 * k + 1][0] * scale, v[2 * k + 1][1] * scale, 1.0f, 2);
      w = __builtin_amdgcn_cvt_scalef32_pk_fp4_f32(w, v[2 * k + 1][2] * scale, v[2 * k + 1][3] * scale, 1.0f, 3);
      o[k] = w;
    }
    if (NATURAL) {
      uint2 lo; lo.x = o[0]; lo.y = o[1];
      uint2 hi; hi.x = o[2]; hi.y = o[3];
      *(uint2*)(dst + (size_t)row * (D_MODEL / 2) + lane * 8) = lo;
      *(uint2*)(dst + (size_t)row * (D_MODEL / 2) + 512 + lane * 8) = hi;
    } else {
      *(u32x4*)(dst + (size_t)row * (D_MODEL / 2) + lane * 16) = o;
    }
    if (lane == 0) sinv[row] = inv;
  }
}

struct PeerArgs {
  const float* x;
  const u16* xb;
  const float* scores;
  const unsigned char* U; const unsigned char* V;
  const float* usinv; const float* vsinv;
  const float* lnw; const float* lnb;
  float* outf; u16* outb; int exmask;
  unsigned* queue;
};
__device__ __forceinline__ float wave_total(float x) {
  x = row16_sum(x);
  float r0 = __int_as_float(__builtin_amdgcn_readlane(__float_as_int(x), 0));
  float r1 = __int_as_float(__builtin_amdgcn_readlane(__float_as_int(x), 16));
  float r2 = __int_as_float(__builtin_amdgcn_readlane(__float_as_int(x), 32));
  float r3 = __int_as_float(__builtin_amdgcn_readlane(__float_as_int(x), 48));
  return (r0 + r1) + (r2 + r3);
}
__device__ __forceinline__ float erf_as(float x) {
  const float ax = fabsf(x);
  const float t = __builtin_amdgcn_rcpf(fmaf(0.3275911f, ax, 1.0f));
  float p = fmaf(1.061405429f, t, -1.453152027f);
  p = fmaf(p, t, 1.421413741f);
  p = fmaf(p, t, -0.284496736f);
  p = fmaf(p, t, 0.254829592f);
  p *= t;
  const float e = __builtin_amdgcn_exp2f(-1.4426950408889634f * ax * ax);
  const float r = fmaf(-p, e, 1.0f);
  return copysignf(r, x);
}
__device__ __forceinline__ void peer_vhalf(f32x2& a0, f32x2& a1, f32x2& a2, f32x2& a3, f32x2& a4, f32x2& a5, f32x2& a6, f32x2& a7,
                                           unsigned w0, unsigned w1, uint64_t acs) {
  f32x2 t0, t1, t2, t3;
  asm("v_cvt_scalef32_pk_f32_fp4 %8, %12, 1.0\n\t"
      "v_cvt_scalef32_pk_f32_fp4 %9, %12, 1.0 op_sel:[1,0,0]\n\t"
      "v_cvt_scalef32_pk_f32_fp4 %10, %12, 1.0 op_sel:[0,1,0]\n\t"
      "v_cvt_scalef32_pk_f32_fp4 %11, %12, 1.0 op_sel:[1,1,0]\n\t"
      "v_pk_fma_f32 %0, %14, %8, %0 op_sel_hi:[0,1,1]\n\t"
      "v_pk_fma_f32 %1, %14, %9, %1 op_sel_hi:[0,1,1]\n\t"
      "v_pk_fma_f32 %2, %14, %10, %2 op_sel_hi:[0,1,1]\n\t"
      "v_pk_fma_f32 %3, %14, %11, %3 op_sel_hi:[0,1,1]\n\t"
      "v_cvt_scalef32_pk_f32_fp4 %8, %13, 1.0\n\t"
      "v_cvt_scalef32_pk_f32_fp4 %9, %13, 1.0 op_sel:[1,0,0]\n\t"
      "v_cvt_scalef32_pk_f32_fp4 %10, %13, 1.0 op_sel:[0,1,0]\n\t"
      "v_cvt_scalef32_pk_f32_fp4 %11, %13, 1.0 op_sel:[1,1,0]\n\t"
      "v_pk_fma_f32 %4, %14, %8, %4 op_sel_hi:[0,1,1]\n\t"
      "v_pk_fma_f32 %5, %14, %9, %5 op_sel_hi:[0,1,1]\n\t"
      "v_pk_fma_f32 %6, %14, %10, %6 op_sel_hi:[0,1,1]\n\t"
      "v_pk_fma_f32 %7, %14, %11, %7 op_sel_hi:[0,1,1]"
      : "+v"(a0), "+v"(a1), "+v"(a2), "+v"(a3), "+v"(a4), "+v"(a5), "+v"(a6), "+v"(a7), "=&v"(t0), "=&v"(t1), "=&v"(t2), "=&v"(t3)
      : "v"(w0), "v"(w1), "s"(acs));
}
__device__ __forceinline__ float wave_max_total(float x) {
  x = row16_max(x);
  float r0 = __int_as_float(__builtin_amdgcn_readlane(__float_as_int(x), 0));
  float r1 = __int_as_float(__builtin_amdgcn_readlane(__float_as_int(x), 16));
  float r2 = __int_as_float(__builtin_amdgcn_readlane(__float_as_int(x), 32));
  float r3 = __int_as_float(__builtin_amdgcn_readlane(__float_as_int(x), 48));
  return fmaxf(fmaxf(r0, r1), fmaxf(r2, r3));
}
#define PEER_G 8
__device__ __forceinline__ void peer_route(const float (&s)[2][2], float* rsv, int* rsi, int* rex, float* rgt, const int lane, const uint64_t ltm, const int exmask = -1) {
  __builtin_amdgcn_wave_barrier();
  uint32_t key[2][2]; bool sel[2][2];
#pragma unroll
  for (int c = 0; c < 2; ++c) { key[c][0] = fkey(s[c][0]); key[c][1] = fkey(s[c][1]); }
  top16_select_n<2, 2>(key, sel, lane);
#pragma unroll
  for (int c = 0; c < 2; ++c) {
    int base = 0;
#pragma unroll
    for (int e = 0; e < 2; ++e) {
      uint64_t bm = __ballot(sel[c][e]);
      if (sel[c][e]) { int p = base + __popcll(bm & ltm); rsv[c * 16 + p] = s[c][e]; rsi[c * 16 + p] = lane + 64 * e; }
      base += __popcll(bm);
    }
  }
  __builtin_amdgcn_wave_barrier();
  asm volatile("s_waitcnt lgkmcnt(0)" ::: "memory");
  float cv[1][4]; uint32_t ck[1][4]; bool csel[1][4];
#pragma unroll
  for (int e = 0; e < 4; ++e) { int ci = e * 64 + lane; cv[0][e] = rsv[ci >> 4] + rsv[16 + (ci & 15)]; ck[0][e] = fkey(cv[0][e]); }
  top16_select_n<1, 4>(ck, csel, lane);
  int exid[4];
#pragma unroll
  for (int e = 0; e < 4; ++e) { int ci = e * 64 + lane; exid[e] = (rsi[ci >> 4] * 128 + rsi[16 + (ci & 15)]) & exmask; }
  float mx = -INFINITY;
#pragma unroll
  for (int e = 0; e < 4; ++e) if (csel[0][e]) mx = fmaxf(mx, cv[0][e]);
  mx = wave_max_total(mx);
  float exv[4], sum = 0.f;
#pragma unroll
  for (int e = 0; e < 4; ++e) { exv[e] = csel[0][e] ? __expf(cv[0][e] - mx) : 0.f; sum += exv[e]; }
  sum = wave_total(sum);
  const float rinv = __builtin_amdgcn_rcpf(sum);
  int base = 0;
#pragma unroll
  for (int e = 0; e < 4; ++e) {
    uint64_t bm = __ballot(csel[0][e]);
    if (csel[0][e]) { int p = base + __popcll(bm & ltm); rex[p] = exid[e]; rgt[p] = exv[e] * rinv; }
    base += __popcll(bm);
  }
  __builtin_amdgcn_wave_barrier();
  asm volatile("s_waitcnt lgkmcnt(0)" ::: "memory");
}

__device__ __forceinline__ f32x4 bf4_to_f32(const uint2 v) {
  return (f32x4){__uint_as_float(v.x << 16), __uint_as_float(v.x & 0xffff0000u), __uint_as_float(v.y << 16), __uint_as_float(v.y & 0xffff0000u)};
}
#define PEER_LDS_BARRIER() do { asm volatile("s_waitcnt lgkmcnt(0)" ::: "memory"); __builtin_amdgcn_s_barrier(); asm volatile("" ::: "memory"); } while (0)
#ifndef PROBE_FAKE
#define PROBE_FAKE 0
#endif
#if PROBE_FAKE
#define PEER_ROUTE(tok, rex, rgt) do { if (a.exmask == 0x3fff) { if (lane < 16) { (rex)[lane] = (int)(((((unsigned)(tok) * 2654435761u) >> 9) + wave * 1531u + lane * 977u) & 0x3fffu); (rgt)[lane] = 0.0625f; } \
    __builtin_amdgcn_wave_barrier(); asm volatile("s_waitcnt lgkmcnt(0)" ::: "memory"); } else peer_route(sc, rsv, rsi, rex, rgt, lane, ltm, a.exmask); } while (0)
#else
#define PEER_ROUTE(tok, rex, rgt) peer_route(sc, rsv, rsi, rex, rgt, lane, ltm, a.exmask)
#endif
__device__ __forceinline__ void d_peer(PeerArgs a, const int bid0, const int nb0, unsigned char* smem) {
  const int bid = sfresh(bid0), nb = sfresh(nb0);
  const int tidf = tid_fresh();
  constexpr int RSTR = 1040;
  unsigned char* sRows = smem;
  float* sOut = (float*)(smem + 128 * RSTR);
  float* sRed = (float*)(smem + 128 * RSTR + 8192);
  const int tid = tidf, lane = tid & 63, wave = tid >> 6;
  float* rsv = (float*)(smem + 128 * RSTR + 8192 + 256 + wave * 512);
  int* rsi = (int*)(rsv + 32);
  int* rexb = rsi + 32;
  float* rgtb = (float*)(rexb + 32);
  int* sX8b = (int*)(smem + 128 * RSTR + 8192 + 256 + NWV * 512);
  unsigned char* sGate = smem + 128 * RSTR + 8192 + 256 + NWV * 512 + 4096;
  const uint64_t ltm = (lane == 0) ? 0ull : (~0ull >> (64 - lane));
  const int er = lane & 15, g4 = lane >> 4;
  if (bid >= NTOK) return;
  const bool dyn = (a.queue != nullptr) && (nb == 256);
  const int NS = dyn ? 56 : (NTOK + nb - 1) / nb;
  const int nstat = dyn ? NS * nb : NTOK;
  int* qslot = (int*)(sRed + 32);
  int pos = 0;
  const bool late = __builtin_amdgcn_readfirstlane(wave) >= 4;

  int t = bid;
  float sc[2][2];
  {
    const f32x4 x0 = bf4_to_f32(*(const uint2*)(a.xb + (size_t)t * D_MODEL + tid * 4));
    const float* sp = a.scores + (size_t)t * 2048 + wave * 256;
#pragma unroll
    for (int c = 0; c < 2; ++c) { sc[c][0] = sp[c * 128 + lane]; sc[c][1] = sp[c * 128 + 64 + lane]; }
    PEER_ROUTE(t, rexb, rgtb);
    int w = 0;
    w = __builtin_amdgcn_cvt_pk_fp8_f32(x0[0], x0[1], w, false);
    w = __builtin_amdgcn_cvt_pk_fp8_f32(x0[2], x0[3], w, true);
    sX8b[tid] = w;
  }
  int tn = (bid + nb < nstat) ? bid + nb : -1;
  int tnn = (tn >= 0 && bid + 2 * nb < nstat) ? bid + 2 * nb : -1;
  const int tn0c = tn >= 0 ? tn : t;
  uint2 xnext = *(const uint2*)(a.xb + (size_t)tn0c * D_MODEL + tid * 4);
  {
    const float* sp = a.scores + (size_t)tn0c * 2048 + wave * 256;
#pragma unroll
    for (int c = 0; c < 2; ++c) { sc[c][0] = sp[c * 128 + lane]; sc[c][1] = sp[c * 128 + 64 + lane]; }
  }
  __builtin_amdgcn_sched_barrier(0);
  i32x4 uu[16]; u32x4 vv[16]; f32x4 us4, vs4;
  {
#pragma unroll
    for (int e = 0; e < 16; ++e) uu[e] = *(const i32x4*)(a.U + (size_t)rexb[e] * (D_MODEL / 2) + lane * 16);
    const i32x4 ex4 = *(const i32x4*)(rexb + g4 * 4);
#pragma unroll
    for (int r = 0; r < 4; ++r) { us4[r] = a.usinv[ex4[r]]; vs4[r] = a.vsinv[ex4[r]]; }
    __builtin_amdgcn_sched_barrier(0);
#pragma unroll
    for (int e = 0; e < 16; ++e) vv[e] = *(const u32x4*)(a.V + (size_t)rexb[e] * (D_MODEL / 2) + lane * 16);
  }
  if (late) PEER_ROUTE(tn0c, rexb + 16, rgtb + 16);
  __syncthreads();
  int cur = 0;
  for (; t >= 0; cur ^= 1) {
    int t3 = -1;
    const bool grab = dyn && (pos + 3 >= NS);
    if (!grab) { const int ts = bid + (pos + 3) * nb; t3 = (tnn >= 0 && ts < nstat) ? ts : -1; }
    else if (tid == 0) {
      int g = -1;
      if (tnn >= 0) { const unsigned qv = __hip_atomic_fetch_add(a.queue, 1u, __ATOMIC_RELAXED, __HIP_MEMORY_SCOPE_AGENT); g = (qv < (unsigned)(NTOK - nstat)) ? nstat + (int)qv : -1; }
      *qslot = g;
    }
    const int tnc = tn >= 0 ? tn : t;
    const int tnnc = tnn >= 0 ? tnn : tnc;
#define tn tnc
#define tnn tnnc
    int* rexc = rexb + cur * 16; float* rgtc = rgtb + cur * 16;
    int* rexn = rexb + (cur ^ 1) * 16; float* rgtn = rgtb + (cur ^ 1) * 16;
    if (!late) PEER_ROUTE(tn, rexn, rgtn);
#pragma unroll
    for (int e = 0; e < 16; ++e) *(i32x4*)(sRows + (wave * 16 + e) * RSTR + lane * 16) = uu[e];
    {
      int w = 0;
      const f32x4 xn = bf4_to_f32(xnext);
      w = __builtin_amdgcn_cvt_pk_fp8_f32(xn[0], xn[1], w, false);
      w = __builtin_amdgcn_cvt_pk_fp8_f32(xn[2], xn[3], w, true);
      sX8b[(cur ^ 1) * 512 + tid] = w;
    }
    {
      const float* sp = a.scores + (size_t)tnn * 2048 + wave * 256;
#pragma unroll
      for (int c = 0; c < 2; ++c) { sc[c][0] = sp[c * 128 + lane]; sc[c][1] = sp[c * 128 + 64 + lane]; }
      xnext = *(const uint2*)(a.xb + (size_t)tnn * D_MODEL + tid * 4);
    }
    i32x4 ids[4];
    {
      __builtin_amdgcn_sched_barrier(0);
#pragma unroll
      for (int e = 0; e < 4; ++e) ids[e] = *(const i32x4*)(rexn + 4 * e);
#pragma unroll
      for (int e = 0; e < 16; ++e) uu[e] = *(const i32x4*)(a.U + ((uint32_t)ids[e >> 2][e & 3] * (D_MODEL / 2) + (uint32_t)lane * 16u));
      __builtin_amdgcn_sched_barrier(0);
    }
    f32x4 acv;
    {
      const f32x4 gt4 = *(const f32x4*)(rgtc + g4 * 4);
      f32x4 c0 = (f32x4){0.f, 0.f, 0.f, 0.f}, c1 = c0;
      const i32x4* xp = (const i32x4*)((const unsigned char*)(sX8b + cur * 512) + g4 * 16);
      i32x4 bq[2][4], aq[2][2];
      const i32x4* ap = (const i32x4*)(sRows + (wave * 16 + er) * RSTR + g4 * 16);
#define PB_LOAD(G, S0) { aq[G][0] = ap[(S0) * 4]; aq[G][1] = ap[((S0) + 1) * 4]; bq[G][0] = xp[(S0) * 8]; bq[G][1] = xp[(S0) * 8 + 4]; bq[G][2] = xp[((S0) + 1) * 8]; bq[G][3] = xp[((S0) + 1) * 8 + 4]; }
#define PB_MMA(G, S0) { \
        { const i32x8 av = (i32x8){aq[G][0][0], aq[G][0][1], aq[G][0][2], aq[G][0][3], 0, 0, 0, 0}; \
          const i32x8 bv = (i32x8){bq[G][0][0], bq[G][0][1], bq[G][0][2], bq[G][0][3], bq[G][1][0], bq[G][1][1], bq[G][1][2], bq[G][1][3]}; \
          c0 = __builtin_amdgcn_mfma_scale_f32_16x16x128_f8f6f4(av, bv, c0, 4, 0, 0, 0x7f7f7f7f, 0, 0x7f7f7f7f); } \
        { const i32x8 av = (i32x8){aq[G][1][0], aq[G][1][1], aq[G][1][2], aq[G][1][3], 0, 0, 0, 0}; \
          const i32x8 bv = (i32x8){bq[G][2][0], bq[G][2][1], bq[G][2][2], bq[G][2][3], bq[G][3][0], bq[G][3][1], bq[G][3][2], bq[G][3][3]}; \
          c1 = __builtin_amdgcn_mfma_scale_f32_16x16x128_f8f6f4(av, bv, c1, 4, 0, 0, 0x7f7f7f7f, 0, 0x7f7f7f7f); } }
      PB_LOAD(0, 0);
      __builtin_amdgcn_sched_barrier(0);
#pragma unroll
      for (int s = 0; s < 16; s += 4) {
        PB_LOAD(1, s + 2);
        PB_MMA(0, s);
        __builtin_amdgcn_sched_barrier(0);
        if (s + 4 < 16) PB_LOAD(0, s + 4);
        PB_MMA(1, s + 2);
        __builtin_amdgcn_sched_barrier(0);
      }
#undef PB_LOAD
#undef PB_MMA
#pragma unroll
      for (int r = 0; r < 4; ++r) {
        float h = (c0[r] + c1[r]) * us4[r];
        acv[r] = 0.5f * h * (1.f + erf_as(h * 0.70710678118654752f)) * gt4[r] * vs4[r];
      }
    }
    {
      int gw = 0;
      gw = __builtin_amdgcn_cvt_pk_fp8_f32(acv[0] * 1024.f, acv[1] * 1024.f, gw, false);
      gw = __builtin_amdgcn_cvt_pk_fp8_f32(acv[2] * 1024.f, acv[3] * 1024.f, gw, true);
      ((int*)sGate)[wave * 4 + g4] = gw;
    }
    const uint2 xcur = *(const uint2*)(a.xb + (size_t)t * D_MODEL + tid * 4);
    const f32x4 lw4 = *(const f32x4*)(a.lnw + tid * 4), lb4 = *(const f32x4*)(a.lnb + tid * 4);
    {
      __builtin_amdgcn_sched_barrier(0);
      const i32x4 ex4 = *(const i32x4*)(rexn + g4 * 4);
#pragma unroll
      for (int r = 0; r < 4; ++r) {
        us4[r] = *(const float*)((const char*)a.usinv + ((uint32_t)ex4[r] << 2));
        vs4[r] = *(const float*)((const char*)a.vsinv + ((uint32_t)ex4[r] << 2));
      }
      __builtin_amdgcn_sched_barrier(0);
    }
#pragma unroll
    for (int e = 0; e < 16; ++e) {
      *(u32x4*)(sRows + (wave * 16 + e) * RSTR + lane * 16) = vv[e];
      const uint32_t voff = (uint32_t)ids[e >> 2][e & 3] * (D_MODEL / 2) + (uint32_t)lane * 16u;
      vv[e] = *(const u32x4*)(a.V + voff);
      __builtin_amdgcn_sched_barrier(0);
    }
    if (late) PEER_ROUTE(tnn, rexc, rgtc);
    PEER_LDS_BARRIER();
    if (grab) t3 = *qslot;
    {
      const i32x4 ga0 = *(const i32x4*)(sGate + g4 * 16), ga1 = *(const i32x4*)(sGate + 64 + g4 * 16);
      const i32x8 av = (i32x8){ga0[0], ga0[1], ga0[2], ga0[3], ga1[0], ga1[1], ga1[2], ga1[3]};
      const unsigned char* rb = sRows + (32 * g4 + (lane & 15)) * RSTR + 128 * wave;
      i32x2 tr[2][8];
#define PD_LOAD(G, M0) { _Pragma("unroll") for (int j = 0; j < 4; ++j) { \
          tr[G][2 * j] = __builtin_amdgcn_ds_read_tr4_b64_v2i32((G8_LAS i32x2*)(rb + 8 * ((M0) + j))); \
          tr[G][2 * j + 1] = __builtin_amdgcn_ds_read_tr4_b64_v2i32((G8_LAS i32x2*)(rb + 16 * RSTR + 8 * ((M0) + j))); } }
#define PD_MMA(G, M0) { f32x4 cc[4]; \
        _Pragma("unroll") for (int j = 0; j < 4; ++j) { \
          const i32x8 bv = (i32x8){tr[G][2 * j][0], tr[G][2 * j][1], tr[G][2 * j + 1][0], tr[G][2 * j + 1][1], 0, 0, 0, 0}; \
          cc[j] = __builtin_amdgcn_mfma_scale_f32_16x16x128_f8f6f4(av, bv, (f32x4){0.f, 0.f, 0.f, 0.f}, 0, 4, 0, 0x7f7f7f7f, 0, 0x7f7f7f7f); } \
        _Pragma("unroll") for (int j = 0; j < 4; ++j) sOut[256 * wave + 16 * ((M0) + j) + (lane & 15)] = cc[j][0] * (1.f / 1024.f); }
      PD_LOAD(0, 0);
      __builtin_amdgcn_sched_barrier(0);
      PD_LOAD(1, 4);  PD_MMA(0, 0);  __builtin_amdgcn_sched_barrier(0);
      PD_LOAD(0, 8);  PD_MMA(1, 4);  __builtin_amdgcn_sched_barrier(0);
      PD_LOAD(1, 12); PD_MMA(0, 8);  __builtin_amdgcn_sched_barrier(0);
      PD_MMA(1, 12);
      __builtin_amdgcn_sched_barrier(0);
#undef PD_LOAD
#undef PD_MMA
    }
    PEER_LDS_BARRIER();
    float pre[4];
    {
      const f32x4 o4 = *(const f32x4*)(sOut + tid * 4);
      const f32x4 xc = bf4_to_f32(xcur);
#pragma unroll
      for (int j = 0; j < 4; ++j) pre[j] = ALPHA * xc[j] + o4[j];
    }
    float s = (pre[0] + pre[1]) + (pre[2] + pre[3]);
    float q2 = (pre[0] * pre[0] + pre[1] * pre[1]) + (pre[2] * pre[2] + pre[3] * pre[3]);
    s = wave_total(s);
    q2 = wave_total(q2);
    if (lane == 0) { sRed[wave] = s; sRed[NWV + wave] = q2; }
    PEER_LDS_BARRIER();
    float mu = 0.f, var = 0.f;
#pragma unroll
    for (int w = 0; w < NWV; ++w) { mu += sRed[w]; var += sRed[NWV + w]; }
    mu *= (1.f / D_MODEL);
    var = fmaxf(var - mu * mu * (float)D_MODEL, 0.f);
    float rs = rsqrtf(var * (1.f / D_MODEL) + 1e-5f);
    f32x4 o;
#pragma unroll
    for (int j = 0; j < 4; ++j) o[j] = (pre[j] - mu) * rs * lw4[j] + lb4[j];
    *(f32x4*)(a.outf + (size_t)t * D_MODEL + tid * 4) = o;
    if (a.outb) {
      uint2 ob; ob.x = pack2(o[0], o[1]); ob.y = pack2(o[2], o[3]);
      *(uint2*)(a.outb + (size_t)t * D_MODEL + tid * 4) = ob;
    }
#undef tn
#undef tnn
    t = tn; tn = tnn; tnn = t3; ++pos;
  }
}

#define XB_TMO      128
#define XB_XCNT(j)  (256  + 64 * (j))
#define XB_XSUB(j)  (1280 + 64 * (j))
#define XB_XGEN(j)  (2304 + 64 * (j))
#define XB_TOP      3328
#define XB_TOPGEN   3392
#define XB_QUEUE(j) (3456 + 64 * (j))
#define XCD_BAR_WORDS 3712
#define XB_SPIN_CAP (1u << 22)
#define LAS __attribute__((address_space(3)))
__device__ __forceinline__ unsigned xb_ld(unsigned* p)              { return __hip_atomic_load(p, __ATOMIC_RELAXED, __HIP_MEMORY_SCOPE_AGENT); }
__device__ __forceinline__ unsigned xb_add(unsigned* p, unsigned v) { return __hip_atomic_fetch_add(p, v, __ATOMIC_RELAXED, __HIP_MEMORY_SCOPE_AGENT); }
__device__ __forceinline__ unsigned xb_xcc_id() { return (unsigned)__builtin_amdgcn_s_getreg((3 << 11) | 20) & 0xFu; }
#define XB_SPIN(cond, bar) do { unsigned _sp = 0; while (cond) { __builtin_amdgcn_s_sleep(1); \
    if ((++_sp & 255u) == 0u) { if (xb_ld(&(bar)[XB_TMO])) break; if (_sp > XB_SPIN_CAP) { atomicAdd(&(bar)[XB_TMO], 1u); break; } } } } while (0)
struct XcdBarrier { unsigned* bar; unsigned x; volatile LAS unsigned* st; };
__device__ __forceinline__ XcdBarrier xcd_barrier_post(unsigned* bar, volatile LAS unsigned* st) {
  XcdBarrier b; b.bar = bar; b.x = xb_xcc_id(); b.st = st;
  if (threadIdx.x == 0) (void)xb_add(&bar[XB_XCNT(b.x)], 1u);
  return b;
}
__device__ __forceinline__ void xcd_barrier_complete(unsigned* bar, unsigned x, unsigned& nloc, unsigned& nx) {
  const unsigned G = gridDim.x * gridDim.y * gridDim.z;
  unsigned sum, cnt, mine, sp = 0u;
  for (;;) {
    sum = 0u; cnt = 0u; mine = 0u;
#pragma unroll
    for (unsigned j = 0; j < 16; ++j) { const unsigned c = xb_ld(&bar[XB_XCNT(j)]); sum += c; cnt += (c > 0u) ? 1u : 0u; mine = (j == x) ? c : mine; }
    if (sum == G) break;
    __builtin_amdgcn_s_sleep(1);
    if ((++sp & 255u) == 0u) { if (xb_ld(&bar[XB_TMO])) break; if (sp > XB_SPIN_CAP) { atomicAdd(&bar[XB_TMO], 1u); break; } }
  }
  nloc = mine > 0u ? mine : 1u; nx = cnt > 0u ? cnt : 1u;
}
__device__ __forceinline__ void xcd_barrier(const XcdBarrier& b) {
  asm volatile("s_waitcnt vmcnt(0)" ::: "memory");
  __syncthreads();
  if (threadIdx.x == 0) {
    unsigned* bar = b.bar;
    __builtin_amdgcn_s_waitcnt(0);
    unsigned nloc = b.st[0], nx = b.st[1];
    if (nloc == 0u) { xcd_barrier_complete(bar, b.x, nloc, nx); b.st[0] = nloc; b.st[1] = nx; }
    const unsigned old = xb_add(&bar[XB_XSUB(b.x)], 1u);
    const unsigned gen = old / nloc;
    if (old + 1u == (gen + 1u) * nloc) {
      __builtin_amdgcn_fence(__ATOMIC_RELEASE, "agent");
      asm volatile("s_waitcnt vmcnt(0)" ::: "memory");
      const unsigned og = xb_add(&bar[XB_TOP], 1u);
      const unsigned tg = og / nx;
      if (og + 1u == (tg + 1u) * nx) xb_add(&bar[XB_TOPGEN], 1u);
      else XB_SPIN(xb_ld(&bar[XB_TOPGEN]) == tg, bar);
      __builtin_amdgcn_fence(__ATOMIC_ACQUIRE, "agent");
      xb_add(&bar[XB_XGEN(b.x)], 1u);
      asm volatile("s_waitcnt vmcnt(0)" ::: "memory");
    } else {
      XB_SPIN(xb_ld(&bar[XB_XGEN(b.x)]) == gen, bar);
      __builtin_amdgcn_fence(__ATOMIC_ACQUIRE, "agent");
      asm volatile("s_waitcnt vmcnt(0)" ::: "memory");
    }
  }
  __syncthreads();
}

struct MegaParams {
  const float* x_in; const float* mem; const int* positions; const float* w_in; const float* shift_mu; const float* w0; const float* w_up;
  const float* a0; const float* a_up; const float* g_up; const float* k_k; const float* k_a; const float* r_k; const float* lnx_w; const float* lnx_b;
  const float* lam_q1; const float* lam_k1; const float* lam_q2; const float* lam_k2; const float* subln_w; const float* w_out;
  const float* ln1_w; const float* ln1_b; const float* xq; const float* xk; const float* xv; const float* xo; const float* ln2_w; const float* ln2_b;
  const float* pq; const float* subkeys; const float* peer_u; const float* peer_v; const float* ln3_w; const float* ln3_b;
  float* out;
  float* X; float* lnstat; u16* xb; u16* memb; u16* WinT; u16* WoutT; u16* xqT; u16* xkT; u16* xvT; u16* xoT; u16* pqT; u16* loraT; u16* skb; u16* cat;
  float* ropetab; u16* Qb; u16* Kb; u16* Vt;
  u16* proj; u16* lin; float* lw; float* la; float* gate; float* wrec; u16* prec; float* bon; float* yraw;
  float* qx0; float* qx1; u16* Kx; u16* Vxt; u16* ox;
  unsigned char* Ub; unsigned char* Vb; float* usinv; float* vsinv; u16* qp; float* scores; int* experts; float* gates;
  unsigned* bar;
};

__device__ __forceinline__ GemmArgs mk_gemm(const u16* A, int lda, const u16* Bt, int ldb, int M, int N, int K, float* Cf, u16* Cb, int ldc,
                                            const float* res = nullptr, float alpha = 0.f) {
  GemmArgs g;
  g.A = A; g.Bt = Bt; g.lda = lda; g.ldb = ldb; g.M = M; g.N = N; g.K = K; g.Cf = Cf; g.Cb = Cb; g.ldc = ldc; g.res = res; g.alpha = alpha;
  g.tab = nullptr; g.Cb2 = nullptr;
  return g;
}

template <typename T, unsigned OFF>
__device__ __forceinline__ T ldarg() {
  unsigned long long v;
  asm volatile("s_load_dwordx2 %0, %1, %2\n\ts_waitcnt lgkmcnt(0)" : "=s"(v) : "s"(__builtin_amdgcn_kernarg_segment_ptr()), "i"(OFF) : "memory");
  return (T)(__attribute__((address_space(1))) void*)v;
}
#define LP(field) ldarg<decltype(MegaParams::field), (unsigned)offsetof(MegaParams, field)>()
#ifndef REPEAT_MASK
#define REPEAT_MASK 0
#endif
#ifndef PROBE_EXMASK
#define PROBE_EXMASK -1
#endif
#define REP(bit) for (int rep_ = 0; rep_ < (((REPEAT_MASK) >> (bit)) & 1) + 1; ++rep_)
#define SMEM_BYTES 163824
__global__ __launch_bounds__(NT, 2) void mega(MegaParams p, int ph_lo, int ph_hi) {
  int ph = 0;
  __shared__ __attribute__((aligned(1024))) unsigned char smem_all[SMEM_BYTES + 16];
  unsigned char* smem = smem_all;
  volatile LAS unsigned* st = (volatile LAS unsigned*)(smem_all + SMEM_BYTES);
  const int bid = blockIdx.x, nb = gridDim.x;
  if (threadIdx.x < 4) st[threadIdx.x] = 0u;
  if (bid == 0 && ph_hi - ph_lo > 1) { unsigned* bw = LP(bar); for (int i = threadIdx.x; i < XCD_BAR_WORDS; i += NT) bw[i] = 0u; }
  __syncthreads();
  XcdBarrier xb_;
  const size_t T = NTOK;

  if (ph >= ph_lo && ph < ph_hi) {
  d_cvt(LP(x_in), LP(xb), T * 2048 / 8, bid, nb, smem);
  d_cvt(LP(mem), LP(memb), (size_t)BATCH * MEM_LEN * 2048 / 8, bid, nb, smem);
  d_rope_table(LP(positions), LP(ropetab), bid, nb, smem);
  }

  for (int l = 0; l < DEPTH; ++l) {
    const float* xres = (l == 0) ? LP(x_in) : LP(X);
    u16* wupT = LP(loraT); u16* aupT = LP(loraT) + 1024 * 64; u16* gupT = LP(loraT) + 2 * 1024 * 64;
    if (ph >= ph_lo && ph < ph_hi) {
    REP(6) {
    d_cvt_t(LP(w_in) + (size_t)l * 2048 * N_IN, LP(WinT), 2048, N_IN, 2048, bid, nb, smem);
    d_cvt_t(LP(w_out) + (size_t)l * 2048 * 2048, LP(WoutT), 2048, 2048, 2048, bid, nb, smem);
    d_cvt_t(LP(xq) + (size_t)l * 2048 * 512, LP(xqT), 2048, 512, 2048, bid, nb, smem);
    d_cvt_t(LP(xk) + (size_t)l * 2048 * 512, LP(xkT), 2048, 512, 2048, bid, nb, smem);
    d_cvt_t(LP(xv) + (size_t)l * 2048 * 512, LP(xvT), 2048, 512, 2048, bid, nb, smem);
    d_cvt_t(LP(xo) + (size_t)l * 512 * 2048, LP(xoT), 512, 2048, 512, bid, nb, smem);
    d_cvt_t(LP(pq) + (size_t)l * 2048 * 2048, LP(pqT), 2048, 2048, 2048, bid, nb, smem);
    d_cvt_t(LP(w_up) + (size_t)l * 64 * 1024, wupT, 64, 1024, 64, bid, nb, smem);
    d_cvt_t(LP(a_up) + (size_t)l * 64 * 1024, aupT, 64, 1024, 64, bid, nb, smem);
    d_cvt_t(LP(g_up) + (size_t)l * 160 * 1024, gupT, 160, 1024, 192, bid, nb, smem);
    { const int tz = tid_fresh(); for (int c = sfresh(bid); c < 1024 * 32 / NT; c += nb) { const int i = c * NT + tz; gupT[(size_t)(i >> 5) * 192 + 160 + (i & 31)] = 0; } }
    { const int tz = tid_fresh(); const float* sk = LP(subkeys) + (size_t)l * 2 * 128 * 128; u16* bd = LP(skb);
      for (int c = sfresh(bid); c < 256 * 256 / NT; c += nb) {
        const int i = c * NT + tz;
        int n = i >> 8, k = i & 255;
        bd[i] = ((n >> 7) == (k >> 7)) ? f2bf(sk[(size_t)(n >> 7) * 16384 + (n & 127) * 128 + (k & 127)]) : (u16)0;
      } }
    }
    }
    if (ph >= ph_lo && ph + 1 < ph_hi) { if (l == 0) { cg::this_grid().sync(); xb_ = xcd_barrier_post(LP(bar), st); } else xcd_barrier(xb_); }
    ++ph;

    if (ph >= ph_lo && ph < ph_hi) {
    REP(0) {
      int base = 0;
      (void)base;
      gemm8(smem, G8Gemm{LP(xb), LP(WinT), 2048, 2048, NTOK, RCOLS, 2048}, G8EpiBf16{LP(proj), RCOLS, 0, RCOLS}, bid, nb);
      gemm8(smem, G8Gemm{LP(xb), LP(WinT) + (size_t)RCOLS * 2048, 2048, 2048, NTOK, 2048, 2048}, G8EpiRope{LP(ropetab), LP(Qb), LP(Kb)}, bid, nb);
      gemm8(smem, G8Gemm{LP(WinT) + (size_t)(RCOLS + 2048) * 2048, LP(xb), 2048, 2048, 1024, NTOK, 2048}, G8EpiBf16{LP(Vt), NTOK, 1}, bid, nb);
      gemm8(smem, G8Gemm{LP(memb), LP(xkT), 2048, 2048, BATCH * MEM_LEN, 512, 2048}, G8EpiBf16{LP(Kx), 512, 0}, (bid + 128) % nb, nb);
      gemm8(smem, G8Gemm{LP(xvT), LP(memb), 2048, 2048, 512, BATCH * MEM_LEN, 2048}, G8EpiBf16{LP(Vxt), BATCH * MEM_LEN, nb == 256 ? 1 : 0}, (bid + 120) % nb, nb);
    }
    }
    if (ph >= ph_lo && ph + 1 < ph_hi) xcd_barrier(xb_);
    ++ph;
    if (ph >= ph_lo && ph < ph_hi) {
    REP(7) d_rwkv_prep1(LP(proj), LP(shift_mu) + (size_t)l * RCOLS, LP(lin), bid, nb, smem);
    }
    if (ph >= ph_lo && ph + 1 < ph_hi) xcd_barrier(xb_);
    ++ph;
    if (ph >= ph_lo && ph < ph_hi) {
    REP(0) {
      int base = 0;
      base = gemm_run<0>(mk_gemm(LP(lin), LORA_LD, wupT, 64, NTOK, 1024, 64, nullptr, (u16*)LP(lw), 1024), base, bid, nb, smem);
      base = gemm_run<0>(mk_gemm(LP(lin) + 64, LORA_LD, aupT, 64, NTOK, 1024, 64, nullptr, (u16*)LP(la), 1024), base, bid, nb, smem);
      base = gemm_run<0>(mk_gemm(LP(lin) + 128, LORA_LD, gupT, 192, NTOK, 1024, 192, nullptr, (u16*)LP(gate), 1024), base, bid, nb, smem);
    }
    }
    if (ph >= ph_lo && ph + 1 < ph_hi) xcd_barrier(xb_);
    ++ph;
    if (ph >= ph_lo && ph < ph_hi) {
    {
      Prep2Args a;
      a.proj = LP(proj); a.mu = LP(shift_mu) + (size_t)l * RCOLS; a.lw = LP(lw); a.la = LP(la);
      a.w0 = LP(w0) + l * RW; a.a0 = LP(a0) + l * RW; a.k_k = LP(k_k) + l * RW; a.k_a = LP(k_a) + l * RW; a.r_k = LP(r_k) + l * RW;
      a.wrec = LP(wrec); a.prec = LP(prec); a.bon = LP(bon);
      REP(7) d_rwkv_prep2(a, bid, nb, smem);
    }
    }
    if (ph >= ph_lo && ph + 1 < ph_hi) xcd_barrier(xb_);
    ++ph;
    if (ph >= ph_lo && ph < ph_hi) {
    {
      TabCvt tc; tc.pu = nullptr; tc.pv = nullptr; tc.Ub = LP(Ub); tc.Vb = LP(Vb); tc.usinv = LP(usinv); tc.vsinv = LP(vsinv);
      if (nb == SCAN_ITEMS) { tc.pu = LP(peer_u) + (size_t)l * 16384 * 2048; tc.pv = LP(peer_v) + (size_t)l * 16384 * 2048; }
      REP(3) d_rwkv_scan(LP(wrec), LP(prec), LP(yraw), tc, bid, nb, smem);
    }
    }
    if (ph >= ph_lo && ph < ph_hi) {
    {
      AttnArgs a;
      a.Q = LP(Qb); a.ldq = 1024; a.K = LP(Kb); a.ldk = 1024; a.Vt = LP(Vt); a.ldv = NTOK; a.O = LP(cat); a.ldo = 2048; a.ocol0 = 1024;
      a.nb = BATCH; a.nh = 8; a.sq = SEQ; a.sk = SEQ; a.scale = 0.125f;
      a.lq1 = LP(lam_q1) + l * 64; a.lk1 = LP(lam_k1) + l * 64; a.lq2 = LP(lam_q2) + l * 64; a.lk2 = LP(lam_k2) + l * 64;
      a.subw = LP(subln_w) + l * 128; a.lam_init = (l == 0) ? 0.2f : 0.35550906759096927f; a.Qf0 = a.Qf1 = nullptr;
      if (nb == 256) {
        REP(1) {
          const int xcd = bid & 7, slot = bid >> 3;
          const int bh = xcd * 4 + (slot >> 3), g = slot & 7;
          for (int k = 1; k >= 0; --k) {
            const int qb = k ? (15 - g) : g;
            attn2_item(a, LP(la), bh / 8, bh % 8, qb, 0, smem);
            attn2_item(a, LP(la), bh / 8, bh % 8, qb, 1, smem);
          }
        }
      } else {
        REP(1) for (int i = bid; i < 512; i += nb) {
          const int qb = 15 - (i >> 5), bh = i & 31;
          attn2_item(a, LP(la), bh / 8, bh % 8, qb, 0, smem);
          attn2_item(a, LP(la), bh / 8, bh % 8, qb, 1, smem);
        }
      }
    }
    }
    if (ph >= ph_lo && ph + 1 < ph_hi) xcd_barrier(xb_);
    ++ph;
    if (ph >= ph_lo && ph < ph_hi) {
    REP(7) d_rwkv_post(LP(yraw), LP(proj), LP(shift_mu) + (size_t)l * RCOLS, LP(bon), LP(gate), LP(lnx_w) + l * RW, LP(lnx_b) + l * RW, LP(cat), bid, nb, smem);
    }
    if (ph >= ph_lo && ph + 1 < ph_hi) xcd_barrier(xb_);
    ++ph;
    if (ph >= ph_lo && ph < ph_hi) {
    gemm8(smem, G8Gemm{LP(cat), LP(WoutT), 2048, 2048, NTOK, 2048, 2048}, G8EpiRes{LP(X), xres, 2048, ALPHA}, bid, nb);
    }
    if (ph >= ph_lo && ph + 1 < ph_hi) xcd_barrier(xb_);
    ++ph;
    if (ph >= ph_lo && ph < ph_hi) {
    REP(5) d_ln(LP(X), LP(ln1_w) + l * 2048, LP(ln1_b) + l * 2048, nullptr, LP(xb), LP(lnstat), NTOK, bid, nb, smem);
    }
    if (ph >= ph_lo && ph + 1 < ph_hi) xcd_barrier(xb_);
    ++ph;
    if (ph >= ph_lo && ph < ph_hi) {
    REP(0) {
      int base = 0;
      (void)base;
      gemm8(smem, G8Gemm{LP(xb), LP(xqT), 2048, 2048, NTOK, 512, 1024}, G8EpiF32{LP(qx0), 512, 512}, bid, nb);
      gemm8(smem, G8Gemm{LP(xb) + 1024, LP(xqT) + 1024, 2048, 2048, NTOK, 512, 1024}, G8EpiF32{LP(qx1), 512, 512}, (bid + 128) % nb, nb);
    }
    }
    if (ph >= ph_lo && ph + 1 < ph_hi) xcd_barrier(xb_);
    ++ph;
    if (ph >= ph_lo && ph < ph_hi) {
    {
      AttnArgs a;
      a.Q = nullptr; a.Qf0 = LP(qx0); a.Qf1 = LP(qx1); a.ldq = 512; a.K = LP(Kx); a.ldk = 512; a.Vt = LP(Vxt); a.ldv = BATCH * MEM_LEN; a.O = LP(ox); a.ldo = 512; a.ocol0 = 0;
      a.nb = BATCH; a.nh = 4; a.sq = SEQ; a.sk = MEM_LEN; a.scale = 0.08838834764831845f;
      a.lq1 = a.lk1 = a.lq2 = a.lk2 = a.subw = nullptr; a.lam_init = 0.f;
      const int nitems = BATCH * 4 * (SEQ / 64);
      const int grp = tid_fresh() >> 8;
      if (nb == 256) {
        REP(2) { const int bh = (bid & 7) * 2 + ((bid >> 3) >> 4), qb = (bid >> 3) & 15; xattn2_item(a, bh / 4, bh % 4, qb, smem); }
      } else {
      REP(2) for (int it0 = bid * 2; it0 < nitems; it0 += nb * 2) {
        int it = it0 + grp;
        int qt = it / 16, bh = it % 16;
        attn_item<128, 1, false>(a, bh / 4, bh % 4, qt, (u16*)(smem + grp * 46080));
      }
      }
    }
    }
    if (ph >= ph_lo && ph + 1 < ph_hi) xcd_barrier(xb_);
    ++ph;
    if (ph >= ph_lo && ph < ph_hi) {
    gemm8(smem, G8Gemm{LP(ox), LP(xoT), 512, 512, NTOK, 2048, 512}, G8EpiResLn{LP(X), LP(lnstat), LP(ln1_w) + l * 2048, LP(ln1_b) + l * 2048, 2048, ALPHA}, bid, nb);
    }
    if (ph >= ph_lo && ph + 1 < ph_hi) xcd_barrier(xb_);
    ++ph;
    if (ph >= ph_lo && ph < ph_hi) {
    d_ln(LP(X), LP(ln2_w) + l * 2048, LP(ln2_b) + l * 2048, nullptr, LP(xb), nullptr, NTOK, bid, nb, smem);
    if (nb != SCAN_ITEMS) {
    REP(6) d_cvt_fp4<true>(LP(peer_u) + (size_t)l * 16384 * 2048, LP(Ub), LP(usinv), 16384, bid, nb, smem);
    REP(6) d_cvt_fp4<true>(LP(peer_v) + (size_t)l * 16384 * 2048, LP(Vb), LP(vsinv), 16384, bid, nb, smem);
    }
    }
    if (ph >= ph_lo && ph + 1 < ph_hi) xcd_barrier(xb_);
    ++ph;
    if (ph >= ph_lo && ph < ph_hi) {
    REP(0) gemm8(smem, G8Gemm{LP(xb), LP(pqT), 2048, 2048, NTOK, 2048, 2048}, G8EpiBf16{LP(qp), 2048, 0}, bid, nb);
    }
    if (ph >= ph_lo && ph + 1 < ph_hi) xcd_barrier(xb_);
    ++ph;
    if (ph >= ph_lo && ph < ph_hi) {
    REP(0) {
      int base = 0;
      gemm8(smem, G8Gemm{LP(qp), LP(skb), 2048, 256, NTOK, 2048, 256, 256 * 2, 1}, G8EpiF32{LP(scores), 2048, 2048}, bid, nb);
    }
    }
    if (ph >= ph_lo && ph + 1 < ph_hi) xcd_barrier(xb_);
    ++ph;
    if (ph >= ph_lo && ph < ph_hi) {
    {
      PeerArgs a;
      a.x = LP(X); a.xb = LP(xb); a.scores = LP(scores); a.U = LP(Ub); a.V = LP(Vb); a.usinv = LP(usinv); a.vsinv = LP(vsinv);
      a.lnw = LP(ln3_w) + l * 2048; a.lnb = LP(ln3_b) + l * 2048;
      bool last = (l == DEPTH - 1);
      a.outf = last ? LP(out) : LP(X);
      a.outb = last ? nullptr : LP(xb); a.exmask = -1; a.queue = LP(bar) + XB_QUEUE(l);
      if ((REPEAT_MASK >> 4) & 1) { PeerArgs d = a; d.outf = LP(out); d.outb = nullptr; d.exmask = PROBE_EXMASK; d.queue = LP(bar) + XB_QUEUE(2 + l); d_peer(d, bid, nb, smem); }
      d_peer(a, bid, nb, smem);
    }
    }
    if (l + 1 < DEPTH && ph >= ph_lo && ph + 1 < ph_hi) xcd_barrier(xb_);
    ++ph;
  }
}

static inline size_t al(size_t x) { return (x + 255) & ~(size_t)255; }

extern "C" void kernel_launch(void* const* d_in, const int* in_sizes, int n_in, void* d_out, int out_size, void* d_ws, size_t ws_size,
                              hipStream_t stream) {
  MegaParams p;
  memset(&p, 0, sizeof(p));
  p.x_in = (const float*)d_in[0]; p.mem = (const float*)d_in[1]; p.positions = (const int*)d_in[2]; p.w_in = (const float*)d_in[3];
  p.shift_mu = (const float*)d_in[4]; p.w0 = (const float*)d_in[5]; p.w_up = (const float*)d_in[6]; p.a0 = (const float*)d_in[7];
  p.a_up = (const float*)d_in[8]; p.g_up = (const float*)d_in[9]; p.k_k = (const float*)d_in[10]; p.k_a = (const float*)d_in[11];
  p.r_k = (const float*)d_in[12]; p.lnx_w = (const float*)d_in[13]; p.lnx_b = (const float*)d_in[14]; p.lam_q1 = (const float*)d_in[15];
  p.lam_k1 = (const float*)d_in[16]; p.lam_q2 = (const float*)d_in[17]; p.lam_k2 = (const float*)d_in[18]; p.subln_w = (const float*)d_in[19];
  p.w_out = (const float*)d_in[20]; p.ln1_w = (const float*)d_in[21]; p.ln1_b = (const float*)d_in[22]; p.xq = (const float*)d_in[23];
  p.xk = (const float*)d_in[24]; p.xv = (const float*)d_in[25]; p.xo = (const float*)d_in[26]; p.ln2_w = (const float*)d_in[27];
  p.ln2_b = (const float*)d_in[28]; p.pq = (const float*)d_in[29]; p.subkeys = (const float*)d_in[30]; p.peer_u = (const float*)d_in[31];
  p.peer_v = (const float*)d_in[32]; p.ln3_w = (const float*)d_in[33]; p.ln3_b = (const float*)d_in[34];
  p.out = (float*)d_out;

  char* ws = (char*)d_ws;
  size_t off = 0;
  auto carve = [&](size_t bytes) { char* q = ws + off; off += al(bytes); return q; };
  const size_t T = NTOK;
  p.bar = (unsigned*)carve(XCD_BAR_WORDS * 4);
  p.X = (float*)carve(T * 2048 * 4);
  p.lnstat = (float*)carve(T * 2 * 4);
  p.xb = (u16*)carve(T * 2048 * 2);
  p.memb = (u16*)carve((size_t)BATCH * MEM_LEN * 2048 * 2);
  p.WinT = (u16*)carve((size_t)N_IN * 2048 * 2);
  p.WoutT = (u16*)carve((size_t)2048 * 2048 * 2);
  p.xqT = (u16*)carve((size_t)512 * 2048 * 2);
  p.xkT = (u16*)carve((size_t)512 * 2048 * 2);
  p.xvT = (u16*)carve((size_t)512 * 2048 * 2);
  p.xoT = (u16*)carve((size_t)2048 * 512 * 2);
  p.pqT = (u16*)carve((size_t)2048 * 2048 * 2);
  p.loraT = (u16*)carve((size_t)3 * 1024 * 192 * 2);
  p.skb = (u16*)carve((size_t)256 * 256 * 2);
  p.cat = (u16*)carve(T * 2048 * 2);
  p.Qb = (u16*)carve(T * 1024 * 2);
  p.Kb = (u16*)carve(T * 1024 * 2);
  p.Vt = (u16*)carve((size_t)1024 * T * 2);
  p.ropetab = (float*)carve(T * 16 * 4);
  p.Kx = (u16*)carve((size_t)1024 * 512 * 2);
  p.Vxt = (u16*)carve((size_t)512 * 1024 * 2);
  p.Ub = (unsigned char*)carve((size_t)16384 * 1024);
  p.Vb = (unsigned char*)carve((size_t)16384 * 1024);
  p.usinv = (float*)carve(16384 * 4);
  p.vsinv = (float*)carve(16384 * 4);
  const size_t S0 = off;
  p.proj = (u16*)carve(T * RCOLS * 4);
  p.lin = (u16*)carve(T * LORA_LD * 2);
  p.lw = (float*)carve(T * 1024 * 4);
  p.la = (float*)carve(T * 1024 * 4);
  p.gate = (float*)carve(T * 1024 * 4);
  p.bon = (float*)carve(T * RH * 4);
  const size_t S1 = off;
  p.prec = (u16*)carve(T * RH * 320 * 2);
  p.wrec = (float*)p.xb;
  size_t peak = off;
  p.yraw = p.lw;
  off = S0;
  p.qx0 = (float*)carve(T * 512 * 4);
  p.qx1 = (float*)carve(T * 512 * 4);
  p.ox = (u16*)carve(T * 512 * 2);
  if (off > peak) peak = off;
  off = S0;
  p.qp = (u16*)carve(T * 2048 * 2);
  p.scores = (float*)carve(T * 2048 * 4);
  p.experts = (int*)carve(T * 128 * 4);
  p.gates = (float*)carve(T * 128 * 4);
  if (off > peak) peak = off;

  static int grid_blocks = 0;
  if (!grid_blocks) {
    int dev = 0, cus = 0, per_cu = 0;
    (void)hipGetDevice(&dev);
    (void)hipDeviceGetAttribute(&cus, hipDeviceAttributeMultiprocessorCount, dev);
    (void)hipOccupancyMaxActiveBlocksPerMultiprocessor(&per_cu, mega, NT, 0);
    if (per_cu > 1) per_cu = 1;
    if (per_cu < 1) per_cu = 1;
    grid_blocks = cus * per_cu;
  }
  if (peak > ws_size) { fprintf(stderr, "workspace too small: need %zu have %zu\n", peak, ws_size); return; }
  {
    int lo = 0, hi = 1 << 20;
    void* args[] = {&p, &lo, &hi};
    hipError_t e = hipLaunchCooperativeKernel((const void*)mega, dim3(grid_blocks), dim3(NT), args, 0, stream);
    if (e != hipSuccess) fprintf(stderr, "cooperative launch failed: %s (grid %d)\n", hipGetErrorString(e), grid_blocks);
  }
}
```
